# Optimizing an MI355X kernel written in HIP

```python
import math
import jax, jax.numpy as jnp
from jax import lax
import numpy as np

D_MODEL = 2048
BATCH = 1
SEQ = 8192
DEPTH = 1

GRID_W = 64
CTX_LEN = 256
EPS = 1e-6
N_MOD = 6

HY_WIDTH = D_MODEL // 2
FILT_EMB = 33
FILT_BANDS = (FILT_EMB - 1) // 2
FILT_ORDER = 64
FILT_TARGET = 1e-2
FILT_DECAY_FAST = 0.3
FILT_DECAY_SLOW = 1.5
FILT_MIN_DECAY = math.log(FILT_TARGET) / FILT_DECAY_SLOW
FILT_MAX_DECAY = math.log(FILT_TARGET) / FILT_DECAY_FAST
FILT_SHIFT = 0.05

DA_HEADS = 8
DA_HEAD_DIM = 64
DA_V_DIM = 2 * DA_HEAD_DIM
DA_WIDTH = DA_HEADS * DA_V_DIM
ROPE_BASE = 10000.0
ROPE_AXIS_DIM = DA_HEAD_DIM // 2
Q_BLOCK = 128

PEER_HEADS = 8
PEER_N_KEYS = 128
PEER_N_EXPERTS = PEER_N_KEYS * PEER_N_KEYS
PEER_TOPK = 16
PEER_DK = 256
PEER_DK_HALF = PEER_DK // 2
PEER_BLOCK = 128

DA_Q_OFF = 3 * HY_WIDTH
DA_K_OFF = DA_Q_OFF + DA_HEADS * 2 * DA_HEAD_DIM
DA_V_OFF = DA_K_OFF + DA_HEADS * 2 * DA_HEAD_DIM
GATE_OFF = DA_V_OFF + DA_WIDTH
IN_COLS = GATE_OFF + 2 * D_MODEL

kernel_name = "hyena_diffattn_peer_hybrid_block"


def rmsnorm(x, g):
    xf = x.astype(jnp.float32)
    y = xf * lax.rsqrt(jnp.mean(xf * xf, axis=-1, keepdims=True) + EPS)
    return (y * g.astype(jnp.float32)).astype(x.dtype)


def modulate(h, shift, scale):
    return h * (1 + scale) + shift


def short_conv(u, w, b):
    up = jnp.pad(u, ((0, 0), (1, 1), (0, 0)))
    return up[:, :-2] * w[0] + up[:, 1:-1] * w[1] + up[:, 2:] * w[2] + b


def hyena_filter_spectrum(L, f_w1, f_b1, f_w2, f_b2, f_w3, f_b3, f_wout, f_freq):
    f32 = jnp.float32
    t = jnp.linspace(0.0, 1.0, L, dtype=f32)[:, None]
    w = 2.0 * math.pi * jnp.arange(L, dtype=f32)[:, None] / L
    bands = jnp.linspace(1e-4, FILT_BANDS - 1, FILT_BANDS, dtype=f32)[None, :]
    z = jnp.concatenate([t, jnp.cos(bands * w), -jnp.sin(bands * w)], axis=-1).astype(f_w1.dtype)
    h = jnp.sin(f_freq * (z @ f_w1 + f_b1))
    h = jnp.sin(f_freq * (h @ f_w2 + f_b2))
    h = jnp.sin(f_freq * (h @ f_w3 + f_b3))
    h = (h @ f_wout).astype(f32)
    deltas = jnp.abs(jnp.linspace(FILT_MIN_DECAY, FILT_MAX_DECAY, HY_WIDTH, dtype=f32))
    window = jnp.exp(-t * deltas[None, :]) + FILT_SHIFT
    h_fwd = h[:, :HY_WIDTH] * window
    h_bwd = h[:, HY_WIDTH:] * window
    k = jnp.concatenate([h_fwd, jnp.zeros((1, HY_WIDTH), f32), h_bwd[1:][::-1]], axis=0)
    return jnp.fft.rfft(k, axis=0)


def fft_long_conv(u, k_spec, bias):
    L = u.shape[1]
    uf = jnp.fft.rfft(u.astype(jnp.float32), n=2 * L, axis=1)
    y = jnp.fft.irfft(uf * k_spec[None], n=2 * L, axis=1)[:, :L]
    return (y + u.astype(jnp.float32) * bias.astype(jnp.float32)).astype(u.dtype)


def hyena_mix(p_hy, conv_w, conv_b, f_w1, f_b1, f_w2, f_b2, f_w3, f_b3, f_wout, f_freq, bias):
    L = p_hy.shape[1]
    z = short_conv(p_hy, conv_w, conv_b)
    v, x1, x0 = jnp.split(z, 3, axis=-1)
    k_spec = hyena_filter_spectrum(L, f_w1, f_b1, f_w2, f_b2, f_w3, f_b3, f_wout, f_freq)
    return x0 * fft_long_conv(v * x1, k_spec, bias)


def split_qkv(p):
    B, L, _ = p.shape
    q = p[..., DA_Q_OFF:DA_K_OFF].reshape(B, L, DA_HEADS, 2, DA_HEAD_DIM)
    k = p[..., DA_K_OFF:DA_V_OFF].reshape(B, L, DA_HEADS, 2, DA_HEAD_DIM)
    v = p[..., DA_V_OFF:GATE_OFF].reshape(B, L, DA_HEADS, DA_V_DIM)
    return q, k, v


def rope_axis(xa, pos):
    half = ROPE_AXIS_DIM // 2
    inv = ROPE_BASE ** (-jnp.arange(0, half, dtype=jnp.float32) / half)
    ang = pos.astype(jnp.float32)[:, None] * inv[None, :]
    cos = jnp.cos(ang)[None, :, None, None, :].astype(xa.dtype)
    sin = jnp.sin(ang)[None, :, None, None, :].astype(xa.dtype)
    x1, x2 = xa[..., :half], xa[..., half:]
    return jnp.concatenate([x1 * cos - x2 * sin, x2 * cos + x1 * sin], axis=-1)


def rope2d(x, row_pos, col_pos):
    return jnp.concatenate([rope_axis(x[..., :ROPE_AXIS_DIM], row_pos),
                            rope_axis(x[..., ROPE_AXIS_DIM:], col_pos)], axis=-1)


def diff_attend(q, k, v, lam):
    s = jnp.einsum('bqhcd,bkhcd->bhcqk', q, k).astype(jnp.float32) * (DA_HEAD_DIM ** -0.5)
    p = jax.nn.softmax(s, axis=-1)
    a = (p[:, :, 0] - lam * p[:, :, 1]).astype(v.dtype)
    return jnp.einsum('bhqk,bkhe->bqhe', a, v)


def diff_head_out(o, subln, lam_init):
    B, L = o.shape[:2]
    return (rmsnorm(o, subln) * (1.0 - lam_init)).reshape(B, L, DA_WIDTH)


def merge_branches(y_hy, y_da, gates, w_hy_out, w_da_out, w_o):
    g_hy, g_da = jnp.split(gates, 2, axis=-1)
    m = jax.nn.sigmoid(g_hy) * (y_hy @ w_hy_out) + jax.nn.sigmoid(g_da) * (y_da @ w_da_out)
    return m @ w_o


def peer(h, w_q, keys, u_tab, v_tab):
    B, L, D = h.shape
    hb = h.reshape(-1, PEER_BLOCK, D)

    def block(hx):
        n = hx.shape[0]
        q = (hx @ w_q).reshape(n, PEER_HEADS, 2, PEER_DK_HALF)
        s = jnp.einsum('nhpd,phkd->nhpk', q, keys)
        sv, si = lax.top_k(s, PEER_TOPK)
        cand_s = (sv[:, :, 0, :, None] + sv[:, :, 1, None, :]).reshape(n, PEER_HEADS, PEER_TOPK * PEER_TOPK)
        cand_i = (si[:, :, 0, :, None] * PEER_N_KEYS + si[:, :, 1, None, :]).reshape(n, PEER_HEADS, PEER_TOPK * PEER_TOPK)
        top_s, top_p = lax.top_k(cand_s, PEER_TOPK)
        idx = jnp.take_along_axis(cand_i, top_p, axis=-1)
        g = jax.nn.softmax(top_s.astype(jnp.float32), axis=-1)
        act = jax.nn.gelu(jnp.einsum('nd,nhkd->nhk', hx, u_tab[idx]), approximate=False)
        wgt = (g * act.astype(jnp.float32)).astype(hx.dtype)
        return jnp.einsum('nhk,nhkd->nd', wgt, v_tab[idx])

    return lax.map(block, hb).reshape(B, L, D)


def setup_inputs(seed: int = 0) -> dict:
    key = jax.random.key(seed)
    ks = jax.random.split(key, 32)
    f32 = jnp.float32
    D, C = D_MODEL, HY_WIDTH

    def nrm(k, shape, scale):
        return jax.random.normal(k, shape, f32) * scale

    return {
        "x": nrm(ks[0], (BATCH, SEQ, D), 1.0),
        "c": nrm(ks[1], (BATCH, D), 1.0),
        "ctx": nrm(ks[2], (BATCH, CTX_LEN, D), 1.0),
        "c_ctx": nrm(ks[3], (D,), 1.0),
        "w_mod": nrm(ks[4], (DEPTH, D, N_MOD * D), 0.5 * D ** -0.5),
        "b_mod": nrm(ks[5], (DEPTH, N_MOD * D), 0.01),
        "norm_pre_mix": 1.0 + nrm(ks[6], (DEPTH, D), 0.05),
        "norm_post_mix": 1.0 + nrm(ks[7], (DEPTH, D), 0.05),
        "norm_pre_ffn": 1.0 + nrm(ks[8], (DEPTH, D), 0.05),
        "norm_post_ffn": 1.0 + nrm(ks[9], (DEPTH, D), 0.05),
        "w_in": nrm(ks[10], (DEPTH, D, IN_COLS), D ** -0.5),
        "hy_conv_w": nrm(ks[11], (DEPTH, 3, 3 * C), 3 ** -0.5),
        "hy_conv_b": nrm(ks[12], (DEPTH, 3 * C), 0.01),
        "filt_w1": nrm(ks[13], (DEPTH, FILT_EMB, FILT_ORDER), FILT_EMB ** -0.5),
        "filt_b1": nrm(ks[14], (DEPTH, FILT_ORDER), 0.1),
        "filt_w2": nrm(ks[15], (DEPTH, FILT_ORDER, FILT_ORDER), FILT_ORDER ** -0.5),
        "filt_b2": nrm(ks[16], (DEPTH, FILT_ORDER), 0.1),
        "filt_w3": nrm(ks[17], (DEPTH, FILT_ORDER, FILT_ORDER), FILT_ORDER ** -0.5),
        "filt_b3": nrm(ks[18], (DEPTH, FILT_ORDER), 0.1),
        "filt_w_out": nrm(ks[19], (DEPTH, FILT_ORDER, 2 * C), 0.1 * FILT_ORDER ** -0.5),
        "filt_freq": 1.0 + nrm(ks[20], (DEPTH, FILT_ORDER), 0.05),
        "hy_bias": nrm(ks[21], (DEPTH, C), 0.1),
        "da_lambda": nrm(ks[22], (DEPTH, 4, DA_HEAD_DIM), 0.1),
        "da_subln": 1.0 + nrm(ks[23], (DEPTH, DA_V_DIM), 0.05),
        "w_hy_out": nrm(ks[24], (DEPTH, C, D), C ** -0.5),
        "w_da_out": nrm(ks[25], (DEPTH, DA_WIDTH, D), DA_WIDTH ** -0.5),
        "w_o": nrm(ks[26], (DEPTH, D, D), D ** -0.5),
        "peer_w_q": nrm(ks[27], (DEPTH, D, PEER_HEADS * PEER_DK), D ** -0.5),
        "peer_keys": nrm(ks[28], (DEPTH, 2, PEER_HEADS, PEER_N_KEYS, PEER_DK_HALF), PEER_DK_HALF ** -0.5),
        "peer_u": nrm(ks[29], (DEPTH, PEER_N_EXPERTS, D), D ** -0.5),
        "peer_v": nrm(ks[30], (DEPTH, PEER_N_EXPERTS, D), D ** -0.5),
    }


def reference(x, c, ctx, c_ctx, w_mod, b_mod, norm_pre_mix, norm_post_mix, norm_pre_ffn, norm_post_ffn,
              w_in, hy_conv_w, hy_conv_b, filt_w1, filt_b1, filt_w2, filt_b2, filt_w3, filt_b3,
              filt_w_out, filt_freq, hy_bias, da_lambda, da_subln, w_hy_out, w_da_out, w_o,
              peer_w_q, peer_keys, peer_u, peer_v):
    B, T, D = x.shape
    rows = T // GRID_W
    row_pos = jnp.repeat(jnp.arange(rows, dtype=jnp.int32), GRID_W)
    col_pos = jnp.tile(jnp.arange(GRID_W, dtype=jnp.int32), rows)
    n_blocks = T // Q_BLOCK
    cx = ctx
    for l in range(DEPTH):
        last = l == DEPTH - 1
        mod_lat = (jax.nn.silu(c) @ w_mod[l] + b_mod[l]).reshape(B, 1, N_MOD, D)
        mod_ctx = (jax.nn.silu(c_ctx) @ w_mod[l] + b_mod[l]).reshape(1, 1, N_MOD, D)
        sh1, sc1, g1, sh2, sc2, g2 = [mod_lat[:, :, i] for i in range(N_MOD)]
        csh1, csc1, cg1, csh2, csc2, cg2 = [mod_ctx[:, :, i] for i in range(N_MOD)]
        hy_args = (hy_conv_w[l], hy_conv_b[l], filt_w1[l], filt_b1[l], filt_w2[l], filt_b2[l],
                   filt_w3[l], filt_b3[l], filt_w_out[l], filt_freq[l], hy_bias[l])
        lam_init = 0.8 - 0.6 * math.exp(-0.3 * l)
        lam_p = da_lambda[l].astype(jnp.float32)
        lam = jnp.exp(jnp.sum(lam_p[0] * lam_p[1])) - jnp.exp(jnp.sum(lam_p[2] * lam_p[3])) + lam_init

        u_lat = modulate(rmsnorm(x, norm_pre_mix[l]), sh1, sc1)
        u_ctx = modulate(rmsnorm(cx, norm_pre_mix[l]), csh1, csc1)
        p_lat = u_lat @ w_in[l]
        p_ctx = u_ctx @ w_in[l]

        y_hy = hyena_mix(p_lat[..., :DA_Q_OFF], *hy_args)
        q_lat, k_lat, v_lat = split_qkv(p_lat)
        q_lat = rope2d(q_lat, row_pos, col_pos)
        k_lat = rope2d(k_lat, row_pos, col_pos)
        q_ctx, k_ctx, v_ctx = split_qkv(p_ctx)
        k_all = jnp.concatenate([k_ctx, k_lat], axis=1)
        v_all = jnp.concatenate([v_ctx, v_lat], axis=1)
        q_blocks = q_lat.reshape(B, n_blocks, Q_BLOCK, DA_HEADS, 2, DA_HEAD_DIM).swapaxes(0, 1)
        o_blocks = lax.map(lambda qb: diff_attend(qb, k_all, v_all, lam), q_blocks)
        o_lat = o_blocks.swapaxes(0, 1).reshape(B, T, DA_HEADS, DA_V_DIM)
        y_da = diff_head_out(o_lat, da_subln[l], lam_init)
        mix_lat = merge_branches(y_hy, y_da, p_lat[..., GATE_OFF:], w_hy_out[l], w_da_out[l], w_o[l])
        x = x + g1 * rmsnorm(mix_lat, norm_post_mix[l])
        if not last:
            y_hy_c = hyena_mix(p_ctx[..., :DA_Q_OFF], *hy_args)
            y_da_c = diff_head_out(diff_attend(q_ctx, k_ctx, v_ctx, lam), da_subln[l], lam_init)
            mix_ctx = merge_branches(y_hy_c, y_da_c, p_ctx[..., GATE_OFF:], w_hy_out[l], w_da_out[l], w_o[l])
            cx = cx + cg1 * rmsnorm(mix_ctx, norm_post_mix[l])

        h_lat = modulate(rmsnorm(x, norm_pre_ffn[l]), sh2, sc2)
        x = x + g2 * rmsnorm(peer(h_lat, peer_w_q[l], peer_keys[l], peer_u[l], peer_v[l]), norm_post_ffn[l])
        if not last:
            h_ctx = modulate(rmsnorm(cx, norm_pre_ffn[l]), csh2, csc2)
            cx = cx + cg2 * rmsnorm(peer(h_ctx, peer_w_q[l], peer_keys[l], peer_u[l], peer_v[l]), norm_post_ffn[l])
    return x
```

```cpp
#include <hip/hip_runtime.h>
#include <hip/hip_bf16.h>
#include <cstdio>
#include <cstdint>
namespace pg8 {
#define PG8_LAS __attribute__((address_space(3)))
typedef unsigned short bf16_t;
typedef short bf16x8 __attribute__((ext_vector_type(8)));
typedef float f32x4 __attribute__((ext_vector_type(4)));
typedef unsigned u32x4 __attribute__((ext_vector_type(4)));
constexpr int BM = 256, BK = 64, HALF = 128, HTB = HALF * BK * 2  , STAGE_BYTES = 8 * HTB, NXCD = 8, WGM = 8;

__host__ __device__ __forceinline__ int lds_byte(int r, int c) { const int st = (r >> 4) * 2 + (c >> 5), rr = r & 15, cc = c & 31, ob = rr * 64 + cc * 2; return st * 1024 + (ob ^ (((ob >> 9) & 1) << 5)); }
__host__ __device__ __forceinline__ void stage_rc(int b, int& R, int& C) { const int st = b / 1024, sb = b % 1024, swz = sb ^ (((sb >> 9) & 1) << 5); R = (st >> 1) * 16 + swz / 64; C = (st & 1) * 32 + (swz % 64) / 2; }
__host__ __device__ __forceinline__ int perm32(int rho) { const int n = rho >> 4, i = rho & 15; return 8 * (i >> 2) + 4 * n + (i & 3); }

struct Unit { int pm, pn; };
struct Gemm { const bf16_t* A; const bf16_t* Bt; int M, N, K; };

struct StaticOrder {
    int nM, nN, nwg, G, c;
    __host__ __device__ void init(int M, int N, int G_, int c_) { nM = M / BM; nN = N / BM; nwg = nM * nN; G = G_; c = c_; }
    __host__ __device__ bool next(int i, Unit& u) const {
        const long L = (long)i * G + c; if (L >= nwg) return false;
        int wgid = (int)L; { const int q = nwg / NXCD, r = nwg % NXCD, xcd = wgid % NXCD, off = wgid / NXCD; wgid = (xcd < r ? xcd * (q + 1) : r * (q + 1) + (xcd - r) * q) + off; }
        const int nig = WGM * nN, gid = wgid / nig, fm = gid * WGM, gsz = (nM - fm) < WGM ? (nM - fm) : WGM;
        u.pm = fm + ((wgid % nig) % gsz); u.pn = (wgid % nig) / gsz; return true;
    }
    __device__ __forceinline__ void a_ready(const Unit&) const {}
    __device__ __forceinline__ void done(const Unit&) const {}
};

__device__ __forceinline__ unsigned cvt_pk_bf16(float lo, float hi) { unsigned r; asm volatile("v_cvt_pk_bf16_f32 %0, %1, %2" : "=v"(r) : "v"(lo), "v"(hi)); return r; }
typedef float f32x2 __attribute__((ext_vector_type(2)));
__device__ __forceinline__ float bflo(unsigned w) { return __builtin_bit_cast(float, w << 16); }
__device__ __forceinline__ float bfhi(unsigned w) { return __builtin_bit_cast(float, w & 0xffff0000u); }
__device__ __forceinline__ float sigm(float x) { return 1.f / (1.f + __expf(-x)); }
struct EpiSplit1 {
    static constexpr bool PERM = true, AFTER_DRAIN = false;
    bf16_t* phy; long dq, dk, dv, dg;
    __device__ __forceinline__ void operator()(const f32x4 (&acc)[2][2][4][2], const Unit& u, int wr, int wc, int fr, int fq) const {
        const int pn = u.pn; const bool ctx = (u.pm == 32);
        const int s1 = pn >= 12, s2 = pn >= 16, s3 = pn >= 20, s4 = pn >= 24;
        bf16_t* base = phy + (long)s1 * dq + (long)s2 * (dk - dq) + (long)s3 * (dv - dk) + (long)s4 * (dg - dv);
        const int ldc = 3072 - s1 * 2048 + s4 * 3072;
        const int colt = (pn - 12 * s1 - 4 * s2 - 4 * s3 - 4 * s4) * 256;
        const bool lat_only = !(s2 && !s4);
        const int rowoff = (s3 && !s4) ? (ctx ? -8192 : 256) : 0;
        if (ctx && lat_only) return;
        const int row0 = u.pm * BM + wr * 64 + fr + rowoff, col0 = colt + wc * 32 + 8 * fq;
#pragma unroll
        for (int ai = 0; ai < 2; ++ai)
#pragma unroll
            for (int m = 0; m < 4; ++m) { bf16_t* rowp = base + (size_t)(row0 + ai * HALF + m * 16) * ldc + col0;
#pragma unroll
                for (int bj = 0; bj < 2; ++bj) { const f32x4 v0 = acc[ai][bj][m][0], v1 = acc[ai][bj][m][1];
                    u32x4 w; w.x = cvt_pk_bf16(v0[0], v0[1]); w.y = cvt_pk_bf16(v0[2], v0[3]); w.z = cvt_pk_bf16(v1[0], v1[1]); w.w = cvt_pk_bf16(v1[2], v1[3]);
                    *(u32x4*)(rowp + bj * HALF) = w; } }
    }
};
template <int MODE> struct EpiGate {
    static constexpr bool PERM = true, AFTER_DRAIN = false;
    bf16_t* O; int ldc; const bf16_t* G; int ldg;
    __device__ __forceinline__ void operator()(const f32x4 (&acc)[2][2][4][2], const Unit& u, int wr, int wc, int fr, int fq) const {
        const int row0 = u.pm * BM + wr * 64 + fr, col0 = u.pn * BM + wc * 32 + 8 * fq;
#pragma unroll
        for (int ai = 0; ai < 2; ++ai)
#pragma unroll
            for (int m = 0; m < 4; ++m) { const size_t r = (size_t)(row0 + ai * HALF + m * 16);
#pragma unroll
                for (int bj = 0; bj < 2; ++bj) { const f32x4 v0 = acc[ai][bj][m][0], v1 = acc[ai][bj][m][1];
                    const u32x4 g = *(const u32x4*)(G + r * ldg + col0 + bj * HALF);
                    float o[8] = { sigm(bflo(g.x)) * v0[0], sigm(bfhi(g.x)) * v0[1], sigm(bflo(g.y)) * v0[2], sigm(bfhi(g.y)) * v0[3],
                                   sigm(bflo(g.z)) * v1[0], sigm(bfhi(g.z)) * v1[1], sigm(bflo(g.w)) * v1[2], sigm(bfhi(g.w)) * v1[3] };
                    u32x4* op = (u32x4*)(O + r * ldc + col0 + bj * HALF);
                    if (MODE == 1) { const u32x4 p = *op; o[0] += bflo(p.x); o[1] += bfhi(p.x); o[2] += bflo(p.y); o[3] += bfhi(p.y); o[4] += bflo(p.z); o[5] += bfhi(p.z); o[6] += bflo(p.w); o[7] += bfhi(p.w); }
                    u32x4 w; w.x = cvt_pk_bf16(o[0], o[1]); w.y = cvt_pk_bf16(o[2], o[3]); w.z = cvt_pk_bf16(o[4], o[5]); w.w = cvt_pk_bf16(o[6], o[7]);
                    *op = w; } }
    }
};
struct EpiF32 {
    static constexpr bool PERM = true, AFTER_DRAIN = false;
    float* O; int ldc;
    __device__ __forceinline__ void operator()(const f32x4 (&acc)[2][2][4][2], const Unit& u, int wr, int wc, int fr, int fq) const {
        const int row0 = u.pm * BM + wr * 64 + fr, col0 = u.pn * BM + wc * 32 + 8 * fq;
#pragma unroll
        for (int ai = 0; ai < 2; ++ai)
#pragma unroll
            for (int m = 0; m < 4; ++m) { float* rowp = O + (size_t)(row0 + ai * HALF + m * 16) * ldc + col0;
#pragma unroll
                for (int bj = 0; bj < 2; ++bj) { *(f32x4*)(rowp + bj * HALF) = acc[ai][bj][m][0]; *(f32x4*)(rowp + bj * HALF + 4) = acc[ai][bj][m][1]; } }
    }
};
struct EpiBf16 {
    static constexpr bool PERM = true, AFTER_DRAIN = false;
    bf16_t* O; int ldc;
    __device__ __forceinline__ void operator()(const f32x4 (&acc)[2][2][4][2], const Unit& u, int wr, int wc, int fr, int fq) const {
        const int row0 = u.pm * BM + wr * 64 + fr, col0 = u.pn * BM + wc * 32 + 8 * fq;
#pragma unroll
        for (int ai = 0; ai < 2; ++ai)
#pragma unroll
            for (int m = 0; m < 4; ++m) { bf16_t* rowp = O + (size_t)(row0 + ai * HALF + m * 16) * ldc + col0;
#pragma unroll
                for (int bj = 0; bj < 2; ++bj) { const f32x4 v0 = acc[ai][bj][m][0], v1 = acc[ai][bj][m][1];
                    u32x4 w; w.x = cvt_pk_bf16(v0[0], v0[1]); w.y = cvt_pk_bf16(v0[2], v0[3]); w.z = cvt_pk_bf16(v1[0], v1[1]); w.w = cvt_pk_bf16(v1[2], v1[3]);
                    *(u32x4*)(rowp + bj * HALF) = w; } }
    }
};
struct EpiCtxKV {
    static constexpr bool PERM = true, AFTER_DRAIN = false;
    bf16_t* k2; long dv;
    __device__ __forceinline__ void operator()(const f32x4 (&acc)[2][2][4][2], const Unit& u, int wr, int wc, int fr, int fq) const {
        const int isv = u.pn >= 20; bf16_t* base = k2 + (long)isv * dv;
        const int row0 = wr * 64 + fr, col0 = (u.pn - 16 - 4 * isv) * 256 + wc * 32 + 8 * fq;
#pragma unroll
        for (int ai = 0; ai < 2; ++ai)
#pragma unroll
            for (int m = 0; m < 4; ++m) { bf16_t* rowp = base + (size_t)(row0 + ai * HALF + m * 16) * 1024 + col0;
#pragma unroll
                for (int bj = 0; bj < 2; ++bj) { const f32x4 v0 = acc[ai][bj][m][0], v1 = acc[ai][bj][m][1];
                    u32x4 w; w.x = cvt_pk_bf16(v0[0], v0[1]); w.y = cvt_pk_bf16(v0[2], v0[3]); w.z = cvt_pk_bf16(v1[0], v1[1]); w.w = cvt_pk_bf16(v1[2], v1[3]);
                    *(u32x4*)(rowp + bj * HALF) = w; } }
    }
};
struct OneUnit {
    int pm, pn;
    __device__ __forceinline__ bool next(int i, Unit& u) const { if (i) return false; u.pm = pm; u.pn = pn; return true; }
    __device__ __forceinline__ void a_ready(const Unit&) const {}
    __device__ __forceinline__ void done(const Unit&) const {}
};
template <class Epi, class Sched, bool ALIGN_EPI = false, bool SP2 = false>
__device__ __forceinline__ void gemm_phase(PG8_LAS unsigned char* lds, const Gemm g, const Sched& S, const Epi& E) {
    const int tid = threadIdx.x, wid = __builtin_amdgcn_readfirstlane(tid >> 6), lane = tid & 63, wr = wid >> 2, wc = wid & 3, fr = lane & 15, fq = lane >> 4;
    const int K = g.K, nt = K / BK;
    unsigned voffA[2], voffB[2];
#pragma unroll
    for (int i = 0; i < 2; ++i) { int R, C; stage_rc(tid * 16 + i * 8192, R, C); const int Rb = Epi::PERM ? ((R & ~31) + perm32(R & 31)) : R;
        voffA[i] = (unsigned)(R * K + C) * 2u; voffB[i] = (unsigned)(Rb * K + C) * 2u; }
    const size_t kstep = (size_t)(BK * 2);
    const size_t hstep = (size_t)HALF * K * 2;
    const size_t tstep = 2 * hstep;
    const unsigned ldsw = (unsigned)wid * 1024u;
    const int aoff = lds_byte(wr * 64 + fr, fq * 8), boff = lds_byte(wc * 32 + fr, fq * 8);
#define PG8_SA(b, h) (((b) * 2 + (h)) * HTB)
#define PG8_SB(b, h) ((4 + (b) * 2 + (h)) * HTB)
#define PG8_STAGE(bufoff, gbase, voff) do { _Pragma("unroll") for (int _i = 0; _i < 2; ++_i) \
        __builtin_amdgcn_global_load_lds((const unsigned*)((const char*)(gbase) + (voff)[_i]), (PG8_LAS unsigned*)(lds + (bufoff) + ldsw + _i * 8192), 16, 0, 0); } while (0)
#define PG8_LDA(dst, b, h) do { _Pragma("unroll") for (int m = 0; m < 4; ++m) _Pragma("unroll") for (int k = 0; k < 2; ++k) dst[m][k] = *(const PG8_LAS bf16x8*)(lds + PG8_SA(b, h) + aoff + m * 2048 + k * 1024); } while (0)
#define PG8_LDB(dst, b, h) do { _Pragma("unroll") for (int n = 0; n < 2; ++n) _Pragma("unroll") for (int k = 0; k < 2; ++k) dst[n][k] = *(const PG8_LAS bf16x8*)(lds + PG8_SB(b, h) + boff + n * 2048 + k * 1024); } while (0)
#define PG8_MMA(ai, bj, At, Bt) do { __builtin_amdgcn_s_setprio(1); _Pragma("unroll") for (int m = 0; m < 4; ++m) _Pragma("unroll") for (int n = 0; n < 2; ++n) _Pragma("unroll") for (int k = 0; k < 2; ++k) \
        acc[ai][bj][m][n] = __builtin_amdgcn_mfma_f32_16x16x32_bf16(Bt[n][k], At[m][k], acc[ai][bj][m][n], 0, 0, 0); __builtin_amdgcn_s_setprio(0); } while (0)
#define PG8_WAIT_V(n) asm volatile("s_waitcnt vmcnt(" #n ")" ::: "memory")
#define PG8_WAIT_L(n) asm volatile("s_waitcnt lgkmcnt(" #n ")" ::: "memory")
#define PG8_BAR __builtin_amdgcn_s_barrier()
#define PG8_SCHED __builtin_amdgcn_sched_barrier(0)
    Unit cur, nxt; int ui = 0;
    if (!S.next(0, cur)) return;
    f32x4 acc[2][2][4][2];
#pragma unroll
    for (int a = 0; a < 2; ++a)
#pragma unroll
        for (int b = 0; b < 2; ++b)
#pragma unroll
            for (int m = 0; m < 4; ++m)
#pragma unroll
                for (int n = 0; n < 2; ++n) acc[a][b][m][n] = (f32x4){0.f, 0.f, 0.f, 0.f};
    bf16x8 At[4][2], B0[2][2], B1[2][2];
    const char* cA = (const char*)g.A + (size_t)cur.pm * tstep; const char* cB = (const char*)g.Bt + (size_t)cur.pn * tstep;
    S.a_ready(cur);
    if constexpr (SP2) {
        PG8_STAGE(PG8_SB(0, 0), cB, voffB); PG8_STAGE(PG8_SB(0, 1), cB + hstep, voffB); PG8_STAGE(PG8_SA(0, 0), cA, voffA); PG8_STAGE(PG8_SA(0, 1), cA + hstep, voffA);
        if (wr == 1) PG8_BAR;
        PG8_WAIT_V(2); PG8_BAR;
        PG8_STAGE(PG8_SB(1, 0), cB + kstep, voffB); PG8_STAGE(PG8_SA(1, 0), cA + kstep, voffA); PG8_STAGE(PG8_SB(1, 1), cB + hstep + kstep, voffB);
        PG8_WAIT_V(6); PG8_BAR;
    } else {
        PG8_STAGE(PG8_SB(0, 0), cB, voffB); PG8_STAGE(PG8_SA(0, 0), cA, voffA); PG8_STAGE(PG8_SB(0, 1), cB + hstep, voffB); PG8_STAGE(PG8_SA(0, 1), cA + hstep, voffA);
        if (wr == 1) PG8_BAR;
        PG8_WAIT_V(4); PG8_BAR;
        PG8_STAGE(PG8_SB(1, 0), cB + kstep, voffB); PG8_STAGE(PG8_SA(1, 0), cA + kstep, voffA); PG8_STAGE(PG8_SB(1, 1), cB + hstep + kstep, voffB);
        PG8_WAIT_V(6); PG8_BAR;
    }
    for (;;) {
        const bool has_next = S.next(ui + 1, nxt);
        const char* nA = has_next ? (const char*)g.A + (size_t)nxt.pm * tstep : cA; const char* nB = has_next ? (const char*)g.Bt + (size_t)nxt.pn * tstep : cB;
        for (int t = 0; t < nt; t += 2) {
            const bool last = (t == nt - 2);
            const char* a1 = cA + (size_t)(t + 1) * kstep;
            const char* a2 = last ? nA : cA + (size_t)(t + 2) * kstep; const char* b2 = last ? nB : cB + (size_t)(t + 2) * kstep;
            const char* a3 = a2 + kstep; const char* b3 = b2 + kstep;
            if (last && has_next) S.a_ready(nxt);
            if constexpr (SP2) {
            PG8_LDB(B0, 0, 0); PG8_LDB(B1, 0, 1); PG8_SCHED; PG8_LDA(At, 0, 0); PG8_STAGE(PG8_SA(1, 1), a1 + hstep, voffA);
            PG8_WAIT_V(8); PG8_WAIT_L(0); PG8_BAR; PG8_MMA(0, 0, At, B0); PG8_MMA(0, 1, At, B1); PG8_BAR; PG8_SCHED;
            PG8_LDA(At, 0, 1); PG8_STAGE(PG8_SB(0, 0), b2, voffB); PG8_STAGE(PG8_SB(0, 1), b2 + hstep, voffB); PG8_STAGE(PG8_SA(0, 0), a2, voffA);
            PG8_WAIT_V(8); PG8_WAIT_L(0); PG8_BAR; PG8_MMA(1, 0, At, B0); PG8_MMA(1, 1, At, B1); PG8_BAR; PG8_SCHED;
            PG8_LDB(B0, 1, 0); PG8_LDB(B1, 1, 1); PG8_SCHED; PG8_LDA(At, 1, 0); PG8_STAGE(PG8_SA(0, 1), a2 + hstep, voffA);
            PG8_WAIT_V(8); PG8_WAIT_L(0); PG8_BAR; PG8_MMA(0, 0, At, B0); PG8_MMA(0, 1, At, B1); PG8_BAR; PG8_SCHED;
            PG8_LDA(At, 1, 1); PG8_STAGE(PG8_SB(1, 0), b3, voffB); PG8_STAGE(PG8_SB(1, 1), b3 + hstep, voffB); PG8_STAGE(PG8_SA(1, 0), a3, voffA);
            PG8_WAIT_V(8); PG8_WAIT_L(0); PG8_BAR; PG8_MMA(1, 0, At, B0); PG8_MMA(1, 1, At, B1); PG8_BAR; PG8_SCHED;
            } else {
            PG8_LDB(B0, 0, 0); PG8_SCHED; PG8_LDA(At, 0, 0); PG8_STAGE(PG8_SA(1, 1), a1 + hstep, voffA);
            PG8_WAIT_L(8); PG8_BAR; PG8_WAIT_L(0); PG8_MMA(0, 0, At, B0); PG8_BAR; PG8_SCHED;
            PG8_LDB(B1, 0, 1); PG8_STAGE(PG8_SB(0, 0), b2, voffB);
            PG8_BAR; PG8_WAIT_L(0); PG8_MMA(0, 1, At, B1); PG8_BAR;
            PG8_LDA(At, 0, 1); PG8_STAGE(PG8_SA(0, 0), a2, voffA);
            PG8_BAR; PG8_WAIT_L(0); PG8_MMA(1, 0, At, B0); PG8_BAR; PG8_SCHED;
            PG8_STAGE(PG8_SB(0, 1), b2 + hstep, voffB);
            PG8_WAIT_V(6); PG8_BAR; PG8_MMA(1, 1, At, B1); PG8_BAR;
            PG8_LDB(B0, 1, 0); PG8_SCHED; PG8_LDA(At, 1, 0); PG8_STAGE(PG8_SA(0, 1), a2 + hstep, voffA);
            PG8_WAIT_L(8); PG8_BAR; PG8_WAIT_L(0); PG8_MMA(0, 0, At, B0); PG8_BAR; PG8_SCHED;
            PG8_LDB(B1, 1, 1); PG8_STAGE(PG8_SB(1, 0), b3, voffB);
            PG8_BAR; PG8_WAIT_L(0); PG8_MMA(0, 1, At, B1); PG8_BAR;
            PG8_LDA(At, 1, 1); PG8_STAGE(PG8_SA(1, 0), a3, voffA);
            PG8_BAR; PG8_WAIT_L(0); PG8_MMA(1, 0, At, B0); PG8_BAR; PG8_SCHED;
            PG8_STAGE(PG8_SB(1, 1), b3 + hstep, voffB);
            PG8_WAIT_V(6); PG8_BAR; PG8_MMA(1, 1, At, B1); PG8_BAR;
            }
        }
        if constexpr (ALIGN_EPI) { if (wr == 0) PG8_BAR; }
        if constexpr (!Epi::AFTER_DRAIN) { E(acc, cur, wr, wc, fr, fq); S.done(cur); }
        if (!has_next) break;
#pragma unroll
        for (int a = 0; a < 2; ++a)
#pragma unroll
            for (int b = 0; b < 2; ++b)
#pragma unroll
                for (int m = 0; m < 4; ++m)
#pragma unroll
                    for (int n = 0; n < 2; ++n) acc[a][b][m][n] = (f32x4){0.f, 0.f, 0.f, 0.f};
        cur = nxt; cA = nA; cB = nB; ++ui;
        if constexpr (ALIGN_EPI) { if (wr == 1) PG8_BAR; }
    }
    PG8_WAIT_V(0);
    if constexpr (!ALIGN_EPI) { if (wr == 0) PG8_BAR; }
    PG8_BAR;
    if constexpr (Epi::AFTER_DRAIN) { E.fused(acc, cur, wr, wc, fr, fq, lds, wid, lane); S.done(cur); }
#undef PG8_SA
#undef PG8_SB
#undef PG8_STAGE
#undef PG8_LDA
#undef PG8_LDB
#undef PG8_MMA
#undef PG8_WAIT_V
#undef PG8_WAIT_L
#undef PG8_BAR
#undef PG8_SCHED
}
}
namespace att {
using bf16x8 = __attribute__((ext_vector_type(8))) short;
using s16x4  = __attribute__((ext_vector_type(4))) short;
using f32x16 = __attribute__((ext_vector_type(16))) float;
using u32x4  = __attribute__((ext_vector_type(4))) unsigned;
constexpr int DQK = 64, DV = 128, NW = 8, QBLK = 32, KVBLK = 64;
constexpr float SCALE = 0.125f;
constexpr float C2 = 0.125f * 1.4426950408889634f;
constexpr float THR2 = 11.5f;
constexpr int LDQ = 1024, LDK = 1024, LDO = 2048;
constexpr size_t SHM_V = KVBLK * DV * 2, SHM_K = KVBLK * DQK * 2, SHM_ATTN = 3 * SHM_V + 3 * SHM_K + NW * 64 * 4;
#define KSWZ64(row, ch) ((row) * 128 + ((((ch) ^ ((row) >> 1)) & 7) << 4))
#define SBAR() __builtin_amdgcn_sched_barrier(0)
__device__ __forceinline__ int crow(int r, int hi) { return (r & 3) + 8 * (r >> 2) + 4 * hi; }
__device__ __forceinline__ unsigned cvtpk(float lo, float hi) { unsigned r; asm volatile("v_cvt_pk_bf16_f32 %0, %1, %2" : "=v"(r) : "v"(lo), "v"(hi)); return r; }

#define MX3(a, b, c) __builtin_fmaxf(__builtin_fmaxf((a), (b)), (c))
__device__ __forceinline__ float rowmax32(const f32x16& p0, const f32x16& p1) {
  float a = MX3(p0[0], p0[1], p1[0]), b = MX3(p0[2], p0[3], p1[1]); a = MX3(a, p1[2], p1[3]);
#pragma unroll
  for (int r = 4; r < 16; r += 4) { a = MX3(a, p0[r], p0[r + 1]); b = MX3(b, p0[r + 2], p0[r + 3]); a = MX3(a, p1[r], p1[r + 1]); b = MX3(b, p1[r + 2], p1[r + 3]); }
  float m = __builtin_fmaxf(a, b);
  { auto rr = __builtin_amdgcn_permlane32_swap(__float_as_uint(m), __float_as_uint(m), false, false);
    m = __builtin_fmaxf(__uint_as_float(rr[0]), __uint_as_float(rr[1])); }
  return m;
}
template <bool FIRST, int VAR = 0> __device__ __forceinline__ void partialSM(f32x16& p0, f32x16& p1, float& m_ref, f32x16& negm, float& alpha) {
  const float pmax = rowmax32(p0, p1);
  alpha = 1.f;
  if (FIRST || __builtin_expect(__any(pmax > THR2), 0)) {
    const float d = FIRST ? pmax : __builtin_fmaxf(pmax, 0.f);
    m_ref += d;
#pragma unroll
    for (int r = 0; r < 16; ++r) { p0[r] -= d; p1[r] -= d; }
#pragma unroll
    for (int r = 0; r < 16; ++r) negm[r] = -m_ref;
    if (!FIRST) alpha = __builtin_amdgcn_exp2f(-d);
  }
#pragma unroll
  for (int r = 0; r < 16; ++r) p0[r] = (VAR == 1) ? p0[r] * 0.001f : __builtin_amdgcn_exp2f(p0[r]);
}
template <int VAR = 0> __device__ __forceinline__ void finishSM(f32x16& p0, f32x16& p1, bf16x8& pa0, bf16x8& pa1, bf16x8& pa2, bf16x8& pa3) {
#pragma unroll
  for (int r = 0; r < 16; ++r) p1[r] = (VAR == 1) ? p1[r] * 0.001f : __builtin_amdgcn_exp2f(p1[r]);
#define PK4(P, BASE, OUT) do { unsigned a0 = cvtpk(P[BASE + 0], P[BASE + 1]), a1 = cvtpk(P[BASE + 2], P[BASE + 3]);   \
    unsigned b0 = cvtpk(P[BASE + 4], P[BASE + 5]), b1 = cvtpk(P[BASE + 6], P[BASE + 7]);                              \
    auto r0 = __builtin_amdgcn_permlane32_swap(a0, b0, false, false); auto r1 = __builtin_amdgcn_permlane32_swap(a1, b1, false, false); \
    u32x4 w = {r0[0], r1[0], r0[1], r1[1]}; OUT = *reinterpret_cast<bf16x8*>(&w); } while (0)
  PK4(p0, 0, pa0); PK4(p0, 8, pa1); PK4(p1, 0, pa2); PK4(p1, 8, pa3);
#undef PK4
}
__device__ __forceinline__ void qkt(f32x16& p0, f32x16& p1, const char* Ks, const bf16x8* qr, const f32x16& negm, int r32, int hi) {
#pragma unroll
  for (int d0 = 0; d0 < 4; ++d0) { const int ch = d0 * 2 + hi;
    bf16x8 b0 = *reinterpret_cast<const bf16x8*>(Ks + KSWZ64(r32, ch));
    bf16x8 b1 = *reinterpret_cast<const bf16x8*>(Ks + KSWZ64(32 + r32, ch));
    if (d0 == 0) { p0 = __builtin_amdgcn_mfma_f32_32x32x16_bf16(b0, qr[0], negm, 0, 0, 0); p1 = __builtin_amdgcn_mfma_f32_32x32x16_bf16(b1, qr[0], negm, 0, 0, 0); }
    else { p0 = __builtin_amdgcn_mfma_f32_32x32x16_bf16(b0, qr[d0], p0, 0, 0, 0); p1 = __builtin_amdgcn_mfma_f32_32x32x16_bf16(b1, qr[d0], p1, 0, 0, 0); } }
}
__device__ __forceinline__ int v_st(int k, int c) { const int kk = (k & ~0xC) | ((k & 4) << 1) | ((k & 8) >> 1); return ((kk >> 3) * 4 + (c >> 5)) * 512 + ((kk & 7) * 32 + (c & 31)) * 2; }
__device__ __forceinline__ int v_rd_base(int lane) { return ((lane & 3) << 3) | (((lane >> 2) & 3) << 6) | (((lane >> 4) & 1) << 5) | (((lane >> 5) & 1) << 8); }
constexpr int v_rd_off(int d0, int ks, int half) { return d0 * 512 + ks * 4096 + half * 2048; }
template <int OFF> __device__ __forceinline__ s16x4 tr_read(int vb) {
  s16x4 r; asm volatile("ds_read_b64_tr_b16 %0, %1 offset:%2" : "=&v"(r) : "v"(vb), "i"(OFF) : "memory"); return r;
}
template <int D0> __device__ __forceinline__ void pv_one(f32x16& od, int vb, bf16x8 pa0, bf16x8 pa1, bf16x8 pa2, bf16x8 pa3) {
  const s16x4 l0 = tr_read<v_rd_off(D0, 0, 0)>(vb), h0 = tr_read<v_rd_off(D0, 0, 1)>(vb), l1 = tr_read<v_rd_off(D0, 1, 0)>(vb), h1 = tr_read<v_rd_off(D0, 1, 1)>(vb);
  const s16x4 l2 = tr_read<v_rd_off(D0, 2, 0)>(vb), h2 = tr_read<v_rd_off(D0, 2, 1)>(vb), l3 = tr_read<v_rd_off(D0, 3, 0)>(vb), h3 = tr_read<v_rd_off(D0, 3, 1)>(vb);
  asm volatile("s_waitcnt lgkmcnt(0)" ::: "memory"); SBAR();
#define PK(L, H) (bf16x8){L[0], L[1], L[2], L[3], H[0], H[1], H[2], H[3]}
  od = __builtin_amdgcn_mfma_f32_32x32x16_bf16(pa0, PK(l0, h0), od, 0, 0, 0);
  od = __builtin_amdgcn_mfma_f32_32x32x16_bf16(pa1, PK(l1, h1), od, 0, 0, 0);
  od = __builtin_amdgcn_mfma_f32_32x32x16_bf16(pa2, PK(l2, h2), od, 0, 0, 0);
  od = __builtin_amdgcn_mfma_f32_32x32x16_bf16(pa3, PK(l3, h3), od, 0, 0, 0);
#undef PK
}
__device__ __forceinline__ void pv_d0(f32x16* o, f32x16& lsum, int vb, bf16x8 pa0, bf16x8 pa1, bf16x8 pa2, bf16x8 pa3) {
  const bf16x8 ones = {0x3F80, 0x3F80, 0x3F80, 0x3F80, 0x3F80, 0x3F80, 0x3F80, 0x3F80};
  pv_one<0>(o[0], vb, pa0, pa1, pa2, pa3); pv_one<1>(o[1], vb, pa0, pa1, pa2, pa3);
  lsum = __builtin_amdgcn_mfma_f32_32x32x16_bf16(pa0, ones, lsum, 0, 0, 0); lsum = __builtin_amdgcn_mfma_f32_32x32x16_bf16(pa1, ones, lsum, 0, 0, 0);
  pv_one<2>(o[2], vb, pa0, pa1, pa2, pa3); pv_one<3>(o[3], vb, pa0, pa1, pa2, pa3);
  lsum = __builtin_amdgcn_mfma_f32_32x32x16_bf16(pa2, ones, lsum, 0, 0, 0); lsum = __builtin_amdgcn_mfma_f32_32x32x16_bf16(pa3, ones, lsum, 0, 0, 0);
}
template <int VAR = 0> __device__ __forceinline__ void attn_unit(const unsigned short* __restrict__ Qb, const unsigned short* __restrict__ Kh, const unsigned short* __restrict__ Vh,
                                          float* __restrict__ Ob, int seq, char* lds) {
  int tid_ = threadIdx.x; asm volatile("" : "+v"(tid_));
  const int tid = tid_, wid = tid >> 6, lane = tid & 63, r32 = lane & 31, hi = lane >> 5;
  char* V_lds = lds; char* K_lds = lds + 3 * SHM_V;
  float* ws = (float*)(lds + 3 * SHM_V + 3 * SHM_K) + wid * 64; float* al_l = ws + 32;
  float m_ref = 0.f; f32x16 o[4] = {}; f32x16 lsum = {}; f32x16 negm = {}; bf16x8 qr[4];
  const unsigned short* Qw = Qb + (long)(wid * QBLK + r32) * LDQ + hi * 8;
#pragma unroll
  for (int d0 = 0; d0 < 4; ++d0) qr[d0] = *reinterpret_cast<const bf16x8*>(Qw + d0 * 16);
  const int vb0 = (int)(uintptr_t)V_lds + v_rd_base(lane);
  int koff, voff0, voff1;
  { const int row = 8 * wid + (lane >> 3), ch = (lane & 7) ^ ((row >> 1) & 7); koff = row * LDK + ch * 8; }
  { const int blk = 4 * wid + (lane >> 5), kk = (blk >> 2) * 8 + ((lane >> 2) & 7), k = (kk & ~0xC) | ((kk & 4) << 1) | ((kk & 8) >> 1); voff0 = k * LDK + (blk & 3) * 32 + (lane & 3) * 8; }
  { const int blk = 4 * wid + 2 + (lane >> 5), kk = (blk >> 2) * 8 + ((lane >> 2) & 7), k = (kk & ~0xC) | ((kk & 4) << 1) | ((kk & 8) >> 1); voff1 = k * LDK + (blk & 3) * 32 + (lane & 3) * 8; }
  typedef __attribute__((address_space(3))) unsigned ldsu32;
  const unsigned widu = (unsigned)__builtin_amdgcn_readfirstlane(wid);
  const unsigned ldsK = (unsigned)(uintptr_t)K_lds + widu * 1024u, ldsV = (unsigned)(uintptr_t)V_lds + widu * 2048u;
#define SDMA(b, k0) do { if (VAR != 4) { \
    __builtin_amdgcn_global_load_lds((const unsigned*)(Kh + (long)(k0) * LDK + koff), (ldsu32*)(uintptr_t)(ldsK + (b) * (unsigned)SHM_K), 16, 0, 0); \
    __builtin_amdgcn_global_load_lds((const unsigned*)(Vh + (long)(k0) * LDK + voff0), (ldsu32*)(uintptr_t)(ldsV + (b) * (unsigned)SHM_V), 16, 0, 0); \
    __builtin_amdgcn_global_load_lds((const unsigned*)(Vh + (long)(k0) * LDK + voff1), (ldsu32*)(uintptr_t)(ldsV + (b) * (unsigned)SHM_V + 1024u), 16, 0, 0); } } while (0)
#define SWAIT() asm volatile("s_waitcnt vmcnt(0)" ::: "memory")
#define RESC(a) do { if (__any((a) < 1.f)) { if (hi == 0) al_l[r32] = (a); asm volatile("s_waitcnt lgkmcnt(0)" ::: "memory"); \
    _Pragma("unroll") for (int r = 0; r < 16; ++r) { const float f_ = al_l[crow(r, hi)]; o[0][r] *= f_; o[1][r] *= f_; o[2][r] *= f_; o[3][r] *= f_; lsum[r] *= f_; } } } while (0)
  f32x16 pA0, pA1, pB0, pB1; float alA, alB; bf16x8 pa0, pa1, pa2, pa3; const int NT = seq / KVBLK;
  SDMA(0, 0); SWAIT(); __syncthreads();
  if (VAR != 3) qkt(pA0, pA1, K_lds, qr, negm, r32, hi); partialSM<true, VAR>(pA0, pA1, m_ref, negm, alA);
  SDMA(1, KVBLK);
  SWAIT(); __syncthreads();
  int bp = 0, bc = 1, bn = 2;
#define ROT3() do { const int t_ = bp; bp = bc; bc = bn; bn = t_; } while (0)
  for (int j = 1; j + 1 < NT; j += 2) {
    SDMA(bn, (j + 1) * KVBLK);
    SBAR(); if (VAR != 3) qkt(pB0, pB1, K_lds + bc * SHM_K, qr, negm, r32, hi);
    finishSM<VAR>(pA0, pA1, pa0, pa1, pa2, pa3); SBAR();
    if (VAR != 2) pv_d0(o, lsum, vb0 + bp * (int)SHM_V, pa0, pa1, pa2, pa3); partialSM<false, VAR>(pB0, pB1, m_ref, negm, alB);
    RESC(alB); SWAIT(); __syncthreads(); ROT3();
    SDMA(bn, (j + 2) * KVBLK);
    SBAR(); if (VAR != 3) qkt(pA0, pA1, K_lds + bc * SHM_K, qr, negm, r32, hi);
    finishSM<VAR>(pB0, pB1, pa0, pa1, pa2, pa3); SBAR();
    if (VAR != 2) pv_d0(o, lsum, vb0 + bp * (int)SHM_V, pa0, pa1, pa2, pa3); partialSM<false, VAR>(pA0, pA1, m_ref, negm, alA);
    RESC(alA); SWAIT(); __syncthreads(); ROT3();
  }
  SBAR(); if (VAR != 3) qkt(pB0, pB1, K_lds + bc * SHM_K, qr, negm, r32, hi);
  finishSM<VAR>(pA0, pA1, pa0, pa1, pa2, pa3); SBAR();
  if (VAR != 2) pv_d0(o, lsum, vb0 + bp * (int)SHM_V, pa0, pa1, pa2, pa3); partialSM<false, VAR>(pB0, pB1, m_ref, negm, alB);
  RESC(alB);
  finishSM<VAR>(pB0, pB1, pa0, pa1, pa2, pa3); SBAR();
  if (VAR != 2) pv_d0(o, lsum, vb0 + bc * (int)SHM_V, pa0, pa1, pa2, pa3);
#undef ROT3
  float rli[16];
#pragma unroll
  for (int r = 0; r < 16; ++r) rli[r] = __builtin_amdgcn_rcpf(lsum[r]);
  float* Ow = Ob + (long)(wid * QBLK) * LDO;
#pragma unroll
  for (int r = 0; r < 16; ++r) { const int orow = crow(r, hi);
#pragma unroll
    for (int d0 = 0; d0 < 4; ++d0) Ow[(long)orow * LDO + d0 * 32 + r32] = o[d0][r] * rli[r]; }
  __syncthreads();
#undef SDMA
#undef SWAIT
#undef RESC
}
#undef SBAR
#undef MX3
}
constexpr int NWAVES = 8, NTHR = 512;
constexpr int DM = 2048, SEQ = 8192, CTXL = 256, MROWS = SEQ + CTXL  , NKEYS = SEQ + CTXL;
constexpr int HYW = 1024, INCOLS = 10240, NMOD = 6 * DM;
constexpr float EPS = 1e-6f;
constexpr int NEXP = 16384;
constexpr size_t MiB = 1u << 20;
constexpr size_t WS_CTL = 0, CTL_ZERO_BYTES = 64 * 1024;
constexpr size_t WS_MODP = 1 * MiB;
constexpr size_t WS_WIN = 2 * MiB;
constexpr size_t WS_WHY = 42 * MiB, WS_WDA = 46 * MiB;
constexpr size_t WS_WO = 50 * MiB, WS_WQ = 58 * MiB;
constexpr size_t WS_UB = 66 * MiB, WS_VB = 130 * MiB;
constexpr size_t WS_USC = 98 * MiB, WS_VSC = 162 * MiB;
constexpr size_t WS_TAPF = 194 * MiB, WS_TAPB = 226 * MiB;
constexpr size_t WS_MB = 194 * MiB;
constexpr size_t WS_HB = 226 * MiB;
constexpr size_t WS_U = 258 * MiB;
constexpr size_t WS_Q2 = 258 * MiB, WS_K2 = 274 * MiB;
constexpr size_t WS_YHY = 258 * MiB, WS_YDA = 274 * MiB;
constexpr size_t WS_PHY = 291 * MiB;
constexpr size_t WS_QRAW = 339 * MiB;
constexpr size_t WS_KRAW = 355 * MiB + 512 * 1024;
constexpr size_t WS_O = 291 * MiB;
constexpr size_t WS_MIX = 291 * MiB;
constexpr size_t WS_YCT = 355 * MiB + 512 * 1024;
constexpr size_t WS_V2 = 372 * MiB;
constexpr size_t WS_GATES = 388 * MiB + 512 * 1024;
constexpr size_t WS_X0 = 452 * MiB + 512 * 1024;
constexpr size_t WS_UHT = 468 * MiB + 512 * 1024;
constexpr size_t WS_QP = 356 * MiB;
constexpr size_t WS_IDX = 420 * MiB, WS_GW = 424 * MiB;
constexpr size_t WS_PD = 258 * MiB;
constexpr size_t WS_OPRE = 290 * MiB;
constexpr size_t WS_WGT = 432 * MiB;
constexpr size_t WS_SSP = 354 * MiB;
constexpr size_t WS_KSPEC = 485 * MiB;
constexpr size_t WS_UCTX = 520 * MiB;
constexpr size_t WS_END = 522 * MiB;
static_assert(WS_UHT + (size_t)1024 * 8192 * 2 <= WS_KSPEC && WS_KSPEC + (size_t)256 * 8320 * 16 <= WS_END && WS_GW + (size_t)8192 * 128 * 4 <= WS_GATES + 64 * MiB, "ws map");

constexpr int LDS_BYTES = 147456;
constexpr int MISC_OFF = 147456 - 256;

#define GAS __attribute__((address_space(1)))
#define LAS __attribute__((address_space(3)))
typedef unsigned short bf16;
typedef unsigned v4u __attribute__((ext_vector_type(4)));
typedef unsigned v2u __attribute__((ext_vector_type(2)));
typedef float f32x4 __attribute__((ext_vector_type(4)));
typedef GAS unsigned gu32;
#define RLX_AGENT __ATOMIC_RELAXED, __HIP_MEMORY_SCOPE_AGENT
#define LDS_WAIT() asm volatile("s_waitcnt lgkmcnt(0)" ::: "memory")
#define VM_WAIT() asm volatile("s_waitcnt vmcnt(0)" ::: "memory")
__device__ __forceinline__ unsigned f2bf(float f) { unsigned u = __builtin_bit_cast(unsigned, f); return (u + 0x7fffu + ((u >> 16) & 1u)) >> 16; }
__device__ __forceinline__ unsigned pk2(float lo, float hi) { return f2bf(lo) | (f2bf(hi) << 16); }
__device__ __forceinline__ float bf2f(unsigned short b) { return __builtin_bit_cast(float, (unsigned)b << 16); }
__device__ __forceinline__ float blo(unsigned w) { return __builtin_bit_cast(float, w << 16); }
__device__ __forceinline__ float bhi(unsigned w) { return __builtin_bit_cast(float, w & 0xffff0000u); }
__device__ __forceinline__ float fsin(float x) { return __builtin_amdgcn_sinf(x * 0.15915494309189535f); }
__device__ __forceinline__ float fcos(float x) { return __builtin_amdgcn_cosf(x * 0.15915494309189535f); }
__device__ __forceinline__ float wave_sum(float v) {
#pragma unroll
    for (int o = 1; o < 64; o <<= 1) v += __shfl_xor(v, o);
    return v;
}
__device__ __forceinline__ float wave_max(float v) {
#pragma unroll
    for (int o = 1; o < 64; o <<= 1) v = fmaxf(v, __shfl_xor(v, o));
    return v;
}
#define XB_TMO      128
#define XB_XCNT(j)  (256  + 64 * (j))
#define XB_XSUB(j)  (1280 + 64 * (j))
#define XB_XGEN(j)  (2304 + 64 * (j))
#define XB_TOP      3328
#define XB_TOPGEN   3392
#define XCD_BAR_WORDS 3456
#define XB_SPIN_CAP (1u << 24)

__device__ __forceinline__ unsigned xb_ld(unsigned* p)              { return __hip_atomic_load(p, __ATOMIC_RELAXED, __HIP_MEMORY_SCOPE_AGENT); }
__device__ __forceinline__ unsigned xb_add(unsigned* p, unsigned v) { return __hip_atomic_fetch_add(p, v, __ATOMIC_RELAXED, __HIP_MEMORY_SCOPE_AGENT); }
__device__ __forceinline__ unsigned xb_xcc_id() { return (unsigned)__builtin_amdgcn_s_getreg((3 << 11) | 20) & 0xFu; }
#define XB_SPIN(cond, bar) do { unsigned _sp = 0; while (cond) { __builtin_amdgcn_s_sleep(1); \
    if ((++_sp & 255u) == 0u) { if (xb_ld(&(bar)[XB_TMO])) break; if (_sp > XB_SPIN_CAP) { atomicAdd(&(bar)[XB_TMO], 1u); break; } } } } while (0)

struct XcdBarrier {
    unsigned* bar; unsigned x;
    volatile LAS unsigned* st;
};

__device__ __forceinline__ XcdBarrier xcd_barrier_post(unsigned* bar, volatile LAS unsigned* st) {
    XcdBarrier b; b.bar = bar; b.x = xb_xcc_id(); b.st = st;
    if (threadIdx.x == 0) (void)xb_add(&bar[XB_XCNT(b.x)], 1u);
    return b;
}
__device__ __forceinline__ void xcd_barrier_complete(unsigned* bar, unsigned x, unsigned& nloc, unsigned& nx) {
    const unsigned G = gridDim.x * gridDim.y * gridDim.z;
    unsigned sum, cnt, mine, sp = 0u;
    for (;;) {
        sum = 0u; cnt = 0u; mine = 0u;
#pragma unroll
        for (unsigned j = 0; j < 16; ++j) { const unsigned c = xb_ld(&bar[XB_XCNT(j)]); sum += c; cnt += (c > 0u) ? 1u : 0u; mine = (j == x) ? c : mine; }
        if (sum == G) break;
        __builtin_amdgcn_s_sleep(1);
        if ((++sp & 255u) == 0u) { if (xb_ld(&bar[XB_TMO])) break; if (sp > XB_SPIN_CAP) { atomicAdd(&bar[XB_TMO], 1u); break; } }
    }
    nloc = mine > 0u ? mine : 1u; nx = cnt > 0u ? cnt : 1u;
}

__device__ __forceinline__ void xcd_barrier(const XcdBarrier& b) {
    asm volatile("s_waitcnt vmcnt(0)" ::: "memory");
    __syncthreads();
    if (threadIdx.x == 0) {
        unsigned* bar = b.bar;
        __builtin_amdgcn_s_waitcnt(0);
        unsigned nloc = b.st[0], nx = b.st[1];
        if (nloc == 0u) { xcd_barrier_complete(bar, b.x, nloc, nx); b.st[0] = nloc; b.st[1] = nx; }
        const unsigned old = xb_add(&bar[XB_XSUB(b.x)], 1u);
        const unsigned gen = old / nloc;
        if (old + 1u == (gen + 1u) * nloc) {
            __builtin_amdgcn_fence(__ATOMIC_RELEASE, "agent");
            asm volatile("s_waitcnt vmcnt(0)" ::: "memory");
            const unsigned og = xb_add(&bar[XB_TOP], 1u);
            const unsigned tg = og / nx;
            if (og + 1u == (tg + 1u) * nx) xb_add(&bar[XB_TOPGEN], 1u);
            else XB_SPIN(xb_ld(&bar[XB_TOPGEN]) == tg, bar);
            __builtin_amdgcn_fence(__ATOMIC_ACQUIRE, "agent");
            xb_add(&bar[XB_XGEN(b.x)], 1u);
            asm volatile("s_waitcnt vmcnt(0)" ::: "memory");
        } else {
            XB_SPIN(xb_ld(&bar[XB_XGEN(b.x)]) == gen, bar);
            __builtin_amdgcn_fence(__ATOMIC_ACQUIRE, "agent");
            asm volatile("s_waitcnt vmcnt(0)" ::: "memory");
        }
    }
    __syncthreads();
}
struct Args { const float* in[31]; float* out; unsigned char* ws; int ph_lo, ph_hi, li, pad; };
struct Frame {
    LAS unsigned char* lds; char* ldsg;
    int tid, lane, wave, vcu, G, gw, NGW;
    float* out; unsigned char* ws;
};
__device__ __forceinline__ const float* modp(const Frame& F) { return (const float*)(F.ws + WS_MODP); }
__device__ __forceinline__ f32x4 mod4(const Args& A, const Frame& F, int which, int i) {
    const float* p = modp(F) + which * NMOD + i; f32x4 v = *(const f32x4*)(A.in[5] + i);
#pragma unroll
    for (int kc = 0; kc < 4; ++kc) v += *(const f32x4*)(p + kc * 2 * NMOD);
    return v;
}
__device__ __forceinline__ float silu(float x) { return x / (1.f + __expf(-x)); }

__device__ __forceinline__ void p0_transpose_pair(const float* Wa, bf16* WTa, int ita, const float* Wb, bf16* WTb, int itb, int K, int N, bool two, LAS float* scr, int lane) {
    const int kka = lane >> 3, nl = (lane & 7) * 4, nb = N / 32;
    const int k0a = 64 * (ita / nb), n0a = 32 * (ita % nb), k0b = 64 * (itb / nb), n0b = 32 * (itb % nb);
    f32x4 va[8], vb_[8];
#pragma unroll
    for (int i = 0; i < 8; ++i) va[i] = *(const f32x4*)(Wa + (size_t)(k0a + 8 * i + kka) * N + n0a + nl);
    if (two) {
#pragma unroll
        for (int i = 0; i < 8; ++i) vb_[i] = *(const f32x4*)(Wb + (size_t)(k0b + 8 * i + kka) * N + n0b + nl); }
#pragma unroll
    for (int i = 0; i < 8; ++i) { LAS float* s = scr + (8 * i + kka) * 33 + nl; s[0] = va[i][0]; s[1] = va[i][1]; s[2] = va[i][2]; s[3] = va[i][3]; }
    if (two) {
#pragma unroll
        for (int i = 0; i < 8; ++i) { LAS float* s = scr + 2176 + (8 * i + kka) * 33 + nl; s[0] = vb_[i][0]; s[1] = vb_[i][1]; s[2] = vb_[i][2]; s[3] = vb_[i][3]; } }
    LDS_WAIT(); asm volatile("" ::: "memory");
    const int c = lane & 7;
#pragma unroll
    for (int j = 0; j < 4; ++j) { const int n = (lane >> 3) + 8 * j; const LAS float* s = scr + (8 * c) * 33 + n;
        v4u o; o.x = pk2(s[0 * 33], s[1 * 33]); o.y = pk2(s[2 * 33], s[3 * 33]); o.z = pk2(s[4 * 33], s[5 * 33]); o.w = pk2(s[6 * 33], s[7 * 33]);
        *(GAS v4u*)(WTa + (size_t)(n0a + n) * K + k0a + 8 * c) = o; }
    if (two) {
#pragma unroll
        for (int j = 0; j < 4; ++j) { const int n = (lane >> 3) + 8 * j; const LAS float* s = scr + 2176 + (8 * c) * 33 + n;
            v4u o; o.x = pk2(s[0 * 33], s[1 * 33]); o.y = pk2(s[2 * 33], s[3 * 33]); o.z = pk2(s[4 * 33], s[5 * 33]); o.w = pk2(s[6 * 33], s[7 * 33]);
            *(GAS v4u*)(WTb + (size_t)(n0b + n) * K + k0b + 8 * c) = o; } }
    LDS_WAIT(); asm volatile("" ::: "memory");
}
__device__ __forceinline__ void p0_filter_item(const Args& A, Frame& F, int pb) {
    LAS float* zb = (LAS float*)F.lds;
    LAS float* hA = zb + 64 * 36;
    LAS float* hB = hA + 64 * 68;
    LAS float* tl = hB + 64 * 68 + F.wave * (64 * 33);
    const int l0 = pb * 64, tid = F.tid;
    const float* w1 = A.in[13]; const float* b1 = A.in[14]; const float* w2 = A.in[15]; const float* b2 = A.in[16];
    const float* w3 = A.in[17]; const float* b3 = A.in[18]; const float* wout = A.in[19]; const float* freq = A.in[20];
    for (int idx = tid; idx < 64 * 33; idx += NTHR) { const int pos = idx / 33, f = idx % 33; const int l = l0 + pos;
        const float w = 6.283185307179586f * (float)l / 8192.f; float v;
        if (f == 0) v = (float)l / 8191.f;
        else { const int j = (f - 1) & 15; const float band = 1e-4f + (float)j * ((15.f - 1e-4f) / 15.f); const float a = band * w; v = (f <= 16) ? fcos(a) : -fsin(a); }
        zb[pos * 36 + f] = v; }
    __syncthreads();
    const int j = tid & 63, pg = tid >> 6;
    { float acc[8]; const float bj = b1[j], fj = freq[j];
#pragma unroll
      for (int i = 0; i < 8; ++i) acc[i] = bj;
      for (int k = 0; k < 33; ++k) { const float w = w1[k * 64 + j];
#pragma unroll
        for (int i = 0; i < 8; ++i) acc[i] += zb[(pg * 8 + i) * 36 + k] * w; }
#pragma unroll
      for (int i = 0; i < 8; ++i) hA[(pg * 8 + i) * 68 + j] = fsin(fj * acc[i]); }
    __syncthreads();
    { float acc[8]; const float bj = b2[j], fj = freq[j];
#pragma unroll
      for (int i = 0; i < 8; ++i) acc[i] = bj;
      for (int k = 0; k < 64; ++k) { const float w = w2[k * 64 + j];
#pragma unroll
        for (int i = 0; i < 8; ++i) acc[i] += hA[(pg * 8 + i) * 68 + k] * w; }
#pragma unroll
      for (int i = 0; i < 8; ++i) hB[(pg * 8 + i) * 68 + j] = fsin(fj * acc[i]); }
    __syncthreads();
    { float acc[8]; const float bj = b3[j], fj = freq[j];
#pragma unroll
      for (int i = 0; i < 8; ++i) acc[i] = bj;
      for (int k = 0; k < 64; ++k) { const float w = w3[k * 64 + j];
#pragma unroll
        for (int i = 0; i < 8; ++i) acc[i] += hB[(pg * 8 + i) * 68 + k] * w; }
      __syncthreads();
#pragma unroll
      for (int i = 0; i < 8; ++i) hA[j * 68 + pg * 8 + i] = fsin(fj * acc[i]); }
    __syncthreads();
    const int lane = F.lane;
    float* tapF = (float*)(F.ws + WS_TAPF); float* tapB = (float*)(F.ws + WS_TAPB);
    for (int ch = 0; ch < 4; ++ch) {
        const int c0 = F.wave * 256 + ch * 64, col = c0 + lane, chan = col & 1023;
        float wr[64];
#pragma unroll
        for (int k = 0; k < 64; ++k) wr[k] = wout[k * 2048 + col];
        const float delta = fabsf(-3.0701134573253945f + (-15.350567286626973f + 3.0701134573253945f) * ((float)chan / 1023.f));
        float* dst = ((col < 1024) ? tapF : tapB) ;
        for (int lh = 0; lh < 2; ++lh) {
#pragma unroll 1
            for (int g = 0; g < 8; ++g) { typedef float f32x2 __attribute__((ext_vector_type(2)));
                const LAS float* hr = hA + lh * 32 + 4 * g; f32x2 a01 = {0.f, 0.f}, a23 = {0.f, 0.f};
#pragma unroll
                for (int kb = 0; kb < 64; kb += 8) {
#pragma unroll
                    for (int k = kb; k < kb + 8; ++k) { const f32x4 h4 = *(const LAS f32x4*)(hr + k * 68); const f32x2 w2 = {wr[k], wr[k]};
                        a01 = (f32x2){h4[0], h4[1]} * w2 + a01; a23 = (f32x2){h4[2], h4[3]} * w2 + a23; }
                    __builtin_amdgcn_sched_barrier(0); }
                const float av[4] = {a01[0], a01[1], a23[0], a23[1]};
#pragma unroll
                for (int e = 0; e < 4; ++e) { const int l = 4 * g + e; const float t = (float)(l0 + lh * 32 + l) / 8191.f;
                    tl[lane * 33 + l] = av[e] * (__expf(-t * delta) + 0.05f); } }
            LDS_WAIT(); asm volatile("" ::: "memory");
#pragma unroll 4
            for (int cc = 0; cc < 32; ++cc) { const int c = 2 * cc + (lane >> 5), l = lane & 31;
                const int chn = (c0 + c) & 1023;
                dst[(size_t)chn * 8192 + l0 + lh * 32 + l] = tl[c * 33 + l]; }
            LDS_WAIT(); asm volatile("" ::: "memory");
        }
    }
    __syncthreads();
}
#ifdef P0_MASK
#define P0REP(s) _Pragma("unroll 1") for (int rep_ = 0; rep_ <= ((P0_MASK >> (s)) & 1); ++rep_)
#define P3REP(s) _Pragma("unroll 1") for (int rep3_ = 0; rep3_ <= ((P0_MASK >> (s)) & 1); ++rep3_)
#else
#define P0REP(s)
#define P3REP(s)
#endif
__device__ __forceinline__ void p0_prologue(const Args& A, Frame& F) {
    P0REP(0) if ((int)blockIdx.x < 128) p0_filter_item(A, F, (int)blockIdx.x);
    P0REP(1) { const float* wm = A.in[4]; const float* c = A.in[1]; const float* cc = A.in[3]; float* mp = (float*)(F.ws + WS_MODP);
      LAS float* sl = (LAS float*)F.lds;
      for (int k = F.tid; k < DM; k += NTHR) { sl[k] = silu(c[k]); sl[DM + k] = silu(cc[k]); }
      __syncthreads();
      const int cl = F.lane & 7, rl = F.lane >> 3;
      for (int it = F.gw; it < 384 * 4; it += F.NGW) { const int cg = it % 384, kc = it / 384;
          f32x4 al = {0.f, 0.f, 0.f, 0.f}, ac = {0.f, 0.f, 0.f, 0.f};
#pragma unroll
          for (int h = 0; h < 2; ++h) { f32x4 w[32];
#pragma unroll
              for (int i = 0; i < 32; ++i) w[i] = *(const f32x4*)(wm + (size_t)(kc * 512 + rl + 8 * (32 * h + i)) * NMOD + cg * 32 + cl * 4);
#pragma unroll
              for (int i = 0; i < 32; ++i) { const int k = kc * 512 + rl + 8 * (32 * h + i); al += w[i] * sl[k]; ac += w[i] * sl[DM + k]; } }
#pragma unroll
          for (int o = 8; o < 64; o <<= 1) {
#pragma unroll
              for (int e = 0; e < 4; ++e) { al[e] += __shfl_xor(al[e], o); ac[e] += __shfl_xor(ac[e], o); } }
          if (rl == 0) { *(f32x4*)(mp + (kc * 2 + 0) * NMOD + cg * 32 + cl * 4) = al; *(f32x4*)(mp + (kc * 2 + 1) * NMOD + cg * 32 + cl * 4) = ac; } }
      __syncthreads(); }
    P0REP(2) { LAS float* scr = (LAS float*)(F.lds + F.wave * 17408);
      constexpr int I_IN = (DM / 64) * (INCOLS / 32), I_HY = (HYW / 64) * (DM / 32), I_O = (DM / 64) * (DM / 32);
      for (int it = F.gw; it < I_IN; it += 2 * F.NGW) { const bool two = it + F.NGW < I_IN;
          p0_transpose_pair(A.in[10], (bf16*)(F.ws + WS_WIN), it, A.in[10], (bf16*)(F.ws + WS_WIN), two ? it + F.NGW : it, DM, INCOLS, two, scr, F.lane); }
      for (int it = F.gw; it < I_O; it += F.NGW)
          p0_transpose_pair(A.in[26], (bf16*)(F.ws + WS_WO), it, A.in[27], (bf16*)(F.ws + WS_WQ), it, DM, DM, true, scr, F.lane);
      for (int it = F.gw; it < 2 * I_HY; it += F.NGW) { const bool da = it >= I_HY; const int r = da ? it - I_HY : it;
          const float* W = da ? A.in[25] : A.in[24]; bf16* WT = (bf16*)(F.ws + (da ? WS_WDA : WS_WHY));
          p0_transpose_pair(W, WT, r, W, WT, r, HYW, DM, false, scr, F.lane); } }
    P0REP(3) {
      const int bx = (int)blockIdx.x; const bool bal = (F.G == 256);
      const int rbase = bal ? (bx < 128 ? bx * 112 : 14336 + (bx - 128) * 144) : 0, rcnt = bal ? (bx < 128 ? 112 : 144) : 2 * NEXP;
      const int rstart = bal ? F.wave : F.gw, rstep = bal ? NWAVES : F.NGW;
      for (int ri = rstart; ri < rcnt; ri += 2 * rstep) {
          const int rowa = rbase + ri, rowb = (ri + rstep < rcnt) ? rowa + rstep : rowa; const bool two = rowb != rowa;
          const bool ua = rowa < NEXP, ub_ = rowb < NEXP; const int ra = ua ? rowa : rowa - NEXP, rb = ub_ ? rowb : rowb - NEXP;
          const float* sa = (ua ? A.in[29] : A.in[30]) + (size_t)ra * DM + 16 * F.lane; const float* sb = (ub_ ? A.in[29] : A.in[30]) + (size_t)rb * DM + 16 * F.lane;
          f32x4 xa[8], xb[8];
#pragma unroll
          for (int i = 0; i < 8; ++i) xa[i] = *(const f32x4*)(sa + 1024 * (i >> 2) + 4 * (i & 3));
#pragma unroll
          for (int i = 0; i < 8; ++i) xb[i] = *(const f32x4*)(sb + 1024 * (i >> 2) + 4 * (i & 3));
          float ma = 0.f, mb = 0.f;
#pragma unroll
          for (int i = 0; i < 8; ++i) { ma = fmaxf(ma, fmaxf(fmaxf(fabsf(xa[i][0]), fabsf(xa[i][1])), fmaxf(fabsf(xa[i][2]), fabsf(xa[i][3]))));
              mb = fmaxf(mb, fmaxf(fmaxf(fabsf(xb[i][0]), fabsf(xb[i][1])), fmaxf(fabsf(xb[i][2]), fabsf(xb[i][3])))); }
#pragma unroll
          for (int o = 1; o < 64; o <<= 1) { ma = fmaxf(ma, __shfl_xor(ma, o)); mb = fmaxf(mb, __shfl_xor(mb, o)); }
          const float sca = (ma > 0.f) ? 384.f / ma : 1.f, scb = (mb > 0.f) ? 384.f / mb : 1.f;
          unsigned char* da = F.ws + (ua ? WS_UB : WS_VB) + (size_t)(F.lane >> 4) * ((size_t)NEXP * 256) + (size_t)ra * 256 + 16 * (F.lane & 15);
          unsigned char* db = F.ws + (ub_ ? WS_UB : WS_VB) + (size_t)(F.lane >> 4) * ((size_t)NEXP * 256) + (size_t)rb * 256 + 16 * (F.lane & 15);
#pragma unroll
          for (int q = 0; q < 2; ++q) { v4u o;
#pragma unroll
              for (int e = 0; e < 4; ++e) { const f32x4 t = xa[4 * q + e] * sca; int w = 0;
                  w = __builtin_amdgcn_cvt_pk_fp8_f32(t[0], t[1], w, false); w = __builtin_amdgcn_cvt_pk_fp8_f32(t[2], t[3], w, true); o[e] = (unsigned)w; }
              *(v4u*)(da + (size_t)(4 * q) * ((size_t)NEXP * 256)) = o; }
          if (F.lane == 0) ((float*)(F.ws + (ua ? WS_USC : WS_VSC)))[ra] = 1.f / sca;
          if (two) {
#pragma unroll
              for (int q = 0; q < 2; ++q) { v4u o;
#pragma unroll
                  for (int e = 0; e < 4; ++e) { const f32x4 t = xb[4 * q + e] * scb; int w = 0;
                      w = __builtin_amdgcn_cvt_pk_fp8_f32(t[0], t[1], w, false); w = __builtin_amdgcn_cvt_pk_fp8_f32(t[2], t[3], w, true); o[e] = (unsigned)w; }
                  *(v4u*)(db + (size_t)(4 * q) * ((size_t)NEXP * 256)) = o; }
              if (F.lane == 0) ((float*)(F.ws + (ub_ ? WS_USC : WS_VSC)))[rb] = 1.f / scb; } } }

}

__device__ __forceinline__ void p1_rows(const Args& A, Frame& F) {
    bf16* U = (bf16*)(F.ws + WS_U); const float* gn = A.in[6];
#pragma unroll 1
    for (int which = 0; which < 2; ++which) {
        const int r0 = which ? SEQ : 0, r1 = which ? MROWS : SEQ; const float* src = which ? A.in[2] : A.in[0];
        int r = r0 + F.gw; if (r >= r1) continue;
        f32x4 a[8], b[8];
#pragma unroll
        for (int j = 0; j < 8; ++j) { const int col = 4 * F.lane + 256 * j; const f32x4 g = *(const f32x4*)(gn + col);
            a[j] = g * (mod4(A, F, which, 1 * DM + col) + 1.f); b[j] = mod4(A, F, which, 0 * DM + col); }
        for (; r < r1; r += F.NGW) {
            const f32x4* xr = (const f32x4*)(src + (size_t)(r - r0) * DM) + F.lane; f32x4 v[8]; float s = 0.f;
#pragma unroll
            for (int j = 0; j < 8; ++j) { v[j] = xr[64 * j]; s += (v[j][0] * v[j][0] + v[j][1] * v[j][1]) + (v[j][2] * v[j][2] + v[j][3] * v[j][3]); }
            const float rstd = rsqrtf(wave_sum(s) * (1.f / DM) + EPS);
            unsigned long long* o8 = (unsigned long long*)(U + (size_t)r * DM) + F.lane;
#pragma unroll
            for (int j = 0; j < 8; ++j) { const f32x4 y = v[j] * rstd * a[j] + b[j];
                o8[64 * j] = (unsigned long long)pk2(y[0], y[1]) | ((unsigned long long)pk2(y[2], y[3]) << 32); }
        }
    }
}

__device__ __forceinline__ void p2_ctx_unit(Frame& F) {
    typedef short s16x8 __attribute__((ext_vector_type(8))); typedef float f32x16 __attribute__((ext_vector_type(16)));
    const bf16* U = (const bf16*)(F.ws + WS_U) + (size_t)SEQ * DM; const bf16* W = (const bf16*)(F.ws + WS_WIN);
    LAS float* part = (LAS float*)F.lds;
#pragma unroll 1
    for (int unit = F.vcu; unit < 256; unit += F.G) {
        const int rb = unit >> 5, cb = unit & 31, l31 = F.lane & 31, hi = F.lane >> 5, k0 = 256 * F.wave + 8 * hi;
        const bf16* ap = U + (size_t)(32 * rb + l31) * DM + k0;
        const bf16* bp0 = W + (size_t)(4096 + 64 * cb + l31) * DM + k0; const bf16* bp1 = bp0 + (size_t)32 * DM;
        f32x16 c0, c1;
#pragma unroll
        for (int r = 0; r < 16; ++r) { c0[r] = 0.f; c1[r] = 0.f; }
#pragma unroll
        for (int h = 0; h < 2; ++h) { s16x8 a[8], b0[8], b1[8];
#pragma unroll
            for (int s = 0; s < 8; ++s) { const int ko = 16 * (8 * h + s); a[s] = *(const s16x8*)(ap + ko); b0[s] = *(const s16x8*)(bp0 + ko); b1[s] = *(const s16x8*)(bp1 + ko); }
#pragma unroll
            for (int s = 0; s < 8; ++s) { c0 = __builtin_amdgcn_mfma_f32_32x32x16_bf16(a[s], b0[s], c0, 0, 0, 0); c1 = __builtin_amdgcn_mfma_f32_32x32x16_bf16(a[s], b1[s], c1, 0, 0, 0); } }
#pragma unroll
        for (int r = 0; r < 16; ++r) { const int row = (r & 3) + 8 * (r >> 2) + 4 * hi; part[F.wave * 2048 + row * 64 + l31] = c0[r]; part[F.wave * 2048 + row * 64 + 32 + l31] = c1[r]; }
        __syncthreads();
        { const int row = F.tid >> 4, c4 = 4 * (F.tid & 15); f32x4 s = {0.f, 0.f, 0.f, 0.f};
#pragma unroll
          for (int w = 0; w < 8; ++w) s += *(const LAS f32x4*)(part + w * 2048 + row * 64 + c4);
          bf16* dst = (bf16*)(F.ws + (cb < 16 ? WS_KRAW + (size_t)SEQ * 1024 * 2 : WS_V2)) + (size_t)(32 * rb + row) * 1024 + 64 * (cb & 15) + c4;
          *(unsigned long long*)dst = (unsigned long long)pk2(s[0], s[1]) | ((unsigned long long)pk2(s[2], s[3]) << 32); }
        __syncthreads();
    }
}

__device__ __forceinline__ void p3_post(const Args& A, Frame& F, const int gw, const int NGW) {
    const bf16* qraw = (const bf16*)(F.ws + WS_QRAW); const bf16* kraw = (const bf16*)(F.ws + WS_KRAW);
    bf16* q2 = (bf16*)(F.ws + WS_Q2); bf16* k2 = (bf16*)(F.ws + WS_K2);
    P3REP(4) { const int hm = F.lane >> 2, ax = (F.lane >> 1) & 1, jh = F.lane & 1; const int e0 = hm * 64 + 32 * ax + 8 * jh;
      float inv[8];
#pragma unroll
      for (int j = 0; j < 8; ++j) inv[j] = __builtin_amdgcn_exp2f(-(float)(8 * jh + j) * (13.287712379549449f / 16.f));
      for (int t = gw; t < SEQ; t += NGW) {
          const float pos = (float)(ax ? (t & 63) : (t >> 6));
          float cs[8], sn[8];
#pragma unroll
          for (int j = 0; j < 8; ++j) { const float a = pos * inv[j]; cs[j] = fcos(a); sn[j] = fsin(a); }
#pragma unroll
          for (int w = 0; w < 2; ++w) {
              const bf16* src = (w ? kraw : qraw) + (size_t)t * 1024 + e0; bf16* dst = (w ? k2 + (size_t)(CTXL + t) * 1024 : q2 + (size_t)t * 1024) + e0;
              const v4u x1 = *(const v4u*)src, x2 = *(const v4u*)(src + 16);
              float a1[8] = { blo(x1.x), bhi(x1.x), blo(x1.y), bhi(x1.y), blo(x1.z), bhi(x1.z), blo(x1.w), bhi(x1.w) };
              float a2[8] = { blo(x2.x), bhi(x2.x), blo(x2.y), bhi(x2.y), blo(x2.z), bhi(x2.z), blo(x2.w), bhi(x2.w) };
              float o1[8], o2[8];
              const float qs = w ? 1.f : att::C2;
#pragma unroll
              for (int j = 0; j < 8; ++j) { o1[j] = (a1[j] * cs[j] - a2[j] * sn[j]) * qs; o2[j] = (a2[j] * cs[j] + a1[j] * sn[j]) * qs; }
              v4u w1, w2; w1.x = pk2(o1[0], o1[1]); w1.y = pk2(o1[2], o1[3]); w1.z = pk2(o1[4], o1[5]); w1.w = pk2(o1[6], o1[7]);
              w2.x = pk2(o2[0], o2[1]); w2.y = pk2(o2[2], o2[3]); w2.z = pk2(o2[4], o2[5]); w2.w = pk2(o2[6], o2[7]);
              *(v4u*)dst = w1; *(v4u*)(dst + 16) = w2; }
      }
      for (int i = gw * 64 + F.lane; i < CTXL * 1024 / 8; i += NGW * 64) *((v4u*)k2 + i) = *((const v4u*)(kraw + (size_t)SEQ * 1024) + i);
    }
    P3REP(5) { const bf16* phy = (const bf16*)(F.ws + WS_PHY); const float* cw = A.in[11]; const float* cb = A.in[12];
      bf16* x0o = (bf16*)(F.ws + WS_X0); bf16* uht = (bf16*)(F.ws + WS_UHT);
      LAS unsigned char* tile = F.lds;
#pragma unroll 1
      for (int it = F.vcu; it < 256; it += F.G) { int ln = F.lane; asm volatile("" : "+v"(ln));
          const int t0 = (it >> 1) * 64, cbase = (it & 1) * 512, c = cbase + 8 * ln, tw = t0 + 8 * F.wave;
#pragma unroll 1
          for (int pass = 0; pass < 2; ++pass) {
              const int ns = pass ? 1 : 2, sb = pass ? 2 : 0;
              f32x4 wt[2][3][2], bs[2][2];
#pragma unroll
              for (int s = 0; s < 2; ++s) if (s < ns) { const int col = (sb + s) * 1024 + c;
#pragma unroll
                  for (int k = 0; k < 3; ++k) { wt[s][k][0] = *(const f32x4*)(cw + k * 3072 + col); wt[s][k][1] = *(const f32x4*)(cw + k * 3072 + col + 4); }
                  bs[s][0] = *(const f32x4*)(cb + col); bs[s][1] = *(const f32x4*)(cb + col + 4); }
              v4u row[2][10];
#pragma unroll
              for (int s = 0; s < 2; ++s) if (s < ns) {
#pragma unroll
                  for (int r = 0; r < 10; ++r) { const int t = tw - 1 + r;
                      row[s][r] = (t >= 0 && t < SEQ) ? *(const v4u*)(phy + (size_t)t * 3072 + (sb + s) * 1024 + c) : (v4u){0u, 0u, 0u, 0u}; } }
#pragma unroll
              for (int tt = 0; tt < 8; ++tt) { float z[2][8];
#pragma unroll
                  for (int s = 0; s < 2; ++s) if (s < ns) {
#pragma unroll
                      for (int h = 0; h < 4; ++h) { const unsigned a = row[s][tt][h], m = row[s][tt + 1][h], n = row[s][tt + 2][h]; const int q = h >> 1, e = 2 * (h & 1);
                          z[s][2 * h]     = blo(a) * wt[s][0][q][e]     + blo(m) * wt[s][1][q][e]     + blo(n) * wt[s][2][q][e]     + bs[s][q][e];
                          z[s][2 * h + 1] = bhi(a) * wt[s][0][q][e + 1] + bhi(m) * wt[s][1][q][e + 1] + bhi(n) * wt[s][2][q][e + 1] + bs[s][q][e + 1]; } }
                  if (pass == 0) { const int tl = 8 * F.wave + tt;
                      LAS unsigned short* tp = (LAS unsigned short*)(tile + (size_t)(8 * ln) * 128 + ((((tl >> 3) ^ ln) & 7) << 4) + 2 * (tl & 7));
#pragma unroll
                      for (int e = 0; e < 8; ++e) tp[e * 64] = (unsigned short)f2bf(z[0][e] * z[1][e]);
                  } else { v4u o; o.x = pk2(z[0][0], z[0][1]); o.y = pk2(z[0][2], z[0][3]); o.z = pk2(z[0][4], z[0][5]); o.w = pk2(z[0][6], z[0][7]);
                      *(v4u*)(x0o + (size_t)(tw + tt) * 1024 + c) = o; } }
          }
          __syncthreads();
          { const int csub = ln >> 3, piece = ln & 7;
#pragma unroll
            for (int i = 0; i < 8; ++i) { const int cl = 64 * F.wave + 8 * i + csub;
                const v4u v = *(const LAS v4u*)(tile + (size_t)cl * 128 + (((piece ^ (cl >> 3)) & 7) << 4));
                *(v4u*)(uht + (size_t)(cbase + cl) * SEQ + t0 + 8 * piece) = v; } }
          __syncthreads();
      } }
}

__device__ __forceinline__ void p4_conv_channel(Frame& F, int c) {
    LAS float* T = (LAS float*)F.lds;
    LAS float* uh = T + 16384;
    const float* tapF = (const float*)(F.ws + WS_TAPF) + (size_t)c * 8192; const float* tapB = (const float*)(F.ws + WS_TAPB) + (size_t)c * 8192;
    const bf16* uht = (const bf16*)(F.ws + WS_UHT) + (size_t)c * 8192;
    for (int i = F.tid; i < 8192; i += NTHR) { T[8192 + i] = tapF[i]; T[8192 - i] = (i == 0) ? tapF[0] : tapB[i]; uh[i] = bf2f(uht[i]); }
    if (F.tid == 0) T[0] = 0.f;
    __syncthreads();
    float acc[16];
#pragma unroll
    for (int i = 0; i < 16; ++i) acc[i] = 0.f;
    const int tid = F.tid;
    for (int S = 0; S < 512; ++S) {
        const int base = 16 * (tid - S) + 8192 - 16;
        float W[32], u[16];
#pragma unroll
        for (int q = 0; q < 32; q += 4) { const f32x4 w4 = *(const LAS f32x4*)(T + base + q); W[q] = w4[0]; W[q + 1] = w4[1]; W[q + 2] = w4[2]; W[q + 3] = w4[3]; }
#pragma unroll
        for (int q = 0; q < 16; q += 4) { const f32x4 u4 = *(const LAS f32x4*)(uh + 16 * S + q); u[q] = u4[0]; u[q + 1] = u4[1]; u[q + 2] = u4[2]; u[q + 3] = u4[3]; }
#pragma unroll
        for (int j = 0; j < 16; ++j)
#pragma unroll
            for (int i = 0; i < 16; ++i) acc[i] += W[16 + i - j] * u[j];
    }
    bf16* yo = (bf16*)(F.ws + WS_YCT) + (size_t)c * 8192 + 16 * tid;
    v4u o0, o1; o0.x = pk2(acc[0], acc[1]); o0.y = pk2(acc[2], acc[3]); o0.z = pk2(acc[4], acc[5]); o0.w = pk2(acc[6], acc[7]);
    o1.x = pk2(acc[8], acc[9]); o1.y = pk2(acc[10], acc[11]); o1.z = pk2(acc[12], acc[13]); o1.w = pk2(acc[14], acc[15]);
    *(v4u*)yo = o0; *(v4u*)(yo + 8) = o1;
    __syncthreads();
}
namespace fftc {
constexpr int N = 16384, LH = 8192, KSTR = 8320;
typedef float c32 __attribute__((ext_vector_type(2)));
__device__ __forceinline__ int rev4(int k) {
    unsigned r = __brev((unsigned)k) >> 18; return (int)(((r & 0x2AAAu) >> 1) | ((r & 0x1555u) << 1));
}
__device__ __forceinline__ int sw(int e) { const int t = e >> 4; return e ^ ((t & 3) * 5) ^ ((t & 4) << 2); }
__device__ __forceinline__ int rev4b(int m) { const unsigned r = __brev((unsigned)m) >> 24; return (int)(((r & 0xAAu) >> 1) | ((r & 0x55u) << 1)); }
__device__ __forceinline__ c32 cmul(c32 a, c32 b) { return (c32){a.x * b.x - a.y * b.y, a.x * b.y + a.y * b.x}; }
__device__ __forceinline__ c32 cadd(c32 a, c32 b) { c32 r; asm("v_pk_add_f32 %0, %1, %2" : "=v"(r) : "v"(a), "v"(b)); return r; }
__device__ __forceinline__ c32 csub(c32 a, c32 b) { c32 r; asm("v_pk_add_f32 %0, %1, %2 neg_lo:[0,1] neg_hi:[0,1]" : "=v"(r) : "v"(a), "v"(b)); return r; }
__device__ __forceinline__ c32 csubi(c32 a, c32 b) { c32 r; asm("v_pk_add_f32 %0, %1, %2 op_sel:[0,1] op_sel_hi:[1,0] neg_hi:[0,1]" : "=v"(r) : "v"(a), "v"(b)); return r; }
__device__ __forceinline__ c32 caddi(c32 a, c32 b) { c32 r; asm("v_pk_add_f32 %0, %1, %2 op_sel:[0,1] op_sel_hi:[1,0] neg_lo:[0,1]" : "=v"(r) : "v"(a), "v"(b)); return r; }
__device__ __forceinline__ c32 cmulw(c32 a, c32 w, c32 wr) { c32 t, r;
    asm("v_pk_mul_f32 %0, %1, %2 op_sel_hi:[0,1]" : "=v"(t) : "v"(a), "v"(w));
    asm("v_pk_fma_f32 %0, %1, %2, %3 op_sel:[1,0,0] op_sel_hi:[1,1,1]" : "=v"(r) : "v"(a), "v"(wr), "v"(t)); return r; }
struct Tw { c32 w1, r1, w2, r2, w3, r3; };
template <bool INV> __device__ __forceinline__ Tw make_tw(float ang) {
    float c, s; Tw t;
    asm("s_nop 1\n\tv_cos_f32 %0, %2\n\tv_sin_f32 %1, %2\n\ts_nop 1" : "=&v"(c), "=&v"(s) : "v"(ang));
    t.w1 = INV ? (c32){c, s} : (c32){c, -s}; t.r1 = INV ? (c32){-s, c} : (c32){s, c};
    t.w2 = cmulw(t.w1, t.w1, t.r1); t.r2 = cmulw(t.r1, t.w1, t.r1); t.w3 = cmulw(t.w2, t.w1, t.r1); t.r3 = cmulw(t.r2, t.w1, t.r1); return t;
}
template <bool INV, bool TW> __device__ __forceinline__ void bfly(c32& a0, c32& a1, c32& a2, c32& a3, const Tw& t) {
    if (INV) {
        if (TW) { a1 = cmulw(a1, t.w1, t.r1); a2 = cmulw(a2, t.w2, t.r2); a3 = cmulw(a3, t.w3, t.r3); }
        const c32 s0 = cadd(a0, a2), s1 = csub(a0, a2), s2 = cadd(a1, a3), s3 = csub(a1, a3);
        a0 = cadd(s0, s2); a2 = csub(s0, s2); a1 = caddi(s1, s3); a3 = csubi(s1, s3);
    } else {
        const c32 t0 = cadd(a0, a2), t1 = csub(a0, a2), t2 = cadd(a1, a3), t3 = csub(a1, a3);
        a0 = cadd(t0, t2); a2 = csub(t0, t2); a1 = csubi(t1, t3); a3 = caddi(t1, t3);
        if (TW) { a1 = cmulw(a1, t.w1, t.r1); a2 = cmulw(a2, t.w2, t.r2); a3 = cmulw(a3, t.w3, t.r3); }
    }
}
template <int S, bool INV> __device__ __forceinline__ void stage(LAS c32* x, int tid) {
    constexpr int L = N >> (2 * S), q = L / 4;
    asm volatile("" : "+v"(tid));
    if constexpr (q >= 512) {
        LAS c32* xs = x + sw(tid); constexpr int R = q / 512;
#pragma unroll
        for (int i = 0; i < 8; ++i) { const int off = (i / R) * L + 512 * (i % R);
            c32 a0 = xs[off], a1 = xs[off + q], a2 = xs[off + 2 * q], a3 = xs[off + 3 * q];
            const Tw t = make_tw<INV>((float)(tid + 512 * (i % R)) * (1.f / (float)L));
            bfly<INV, true>(a0, a1, a2, a3, t);
            xs[off] = a0; xs[off + q] = a1; xs[off + 2 * q] = a2; xs[off + 3 * q] = a3; }
    } else {
        const int j = tid & (q - 1), base = (tid / q) * L + j;
        LAS c32* p0 = x + sw(base); LAS c32* p1 = x + sw(base + q); LAS c32* p2 = x + sw(base + 2 * q); LAS c32* p3 = x + sw(base + 3 * q);
        Tw t; if constexpr (q > 1) t = make_tw<INV>((float)j * (1.f / (float)L));
#pragma unroll
        for (int i = 0; i < 8; ++i) { c32 a0 = p0[2048 * i], a1 = p1[2048 * i], a2 = p2[2048 * i], a3 = p3[2048 * i];
            bfly<INV, (q > 1)>(a0, a1, a2, a3, t);
            p0[2048 * i] = a0; p1[2048 * i] = a1; p2[2048 * i] = a2; p3[2048 * i] = a3; }
    }
    __syncthreads();
}
template <int S> __device__ __forceinline__ void fwd_stage(LAS c32* x, int tid) { stage<S, false>(x, tid); }
template <int S> __device__ __forceinline__ void inv_stage(LAS c32* x, int tid) { stage<S, true>(x, tid); }
__device__ __forceinline__ void fwd_all(LAS c32* x, int tid) { fwd_stage<0>(x, tid); fwd_stage<1>(x, tid); fwd_stage<2>(x, tid); fwd_stage<3>(x, tid); fwd_stage<4>(x, tid); fwd_stage<5>(x, tid); fwd_stage<6>(x, tid); }
__device__ __forceinline__ void inv_all(LAS c32* x, int tid) { inv_stage<6>(x, tid); inv_stage<5>(x, tid); inv_stage<4>(x, tid); inv_stage<3>(x, tid); inv_stage<2>(x, tid); inv_stage<1>(x, tid); inv_stage<0>(x, tid); }
__device__ __forceinline__ void conv_pair(LAS unsigned char* lds, int tid, int pr, const float* tapF, const float* tapB, const unsigned short* uht, unsigned short* yct) {
    LAS c32* x = (LAS c32*)lds;
    const size_t o1 = (size_t)(2 * pr) * LH, o2 = o1 + LH;
#pragma unroll 1
    for (int h = 0; h < 2; ++h) { f32x4 f1[2], f2[2], b1[2], b2[2];
#pragma unroll
      for (int i = 0; i < 2; ++i) { const int n = 4 * (tid + 512 * (2 * h + i)); f1[i] = *(const f32x4*)(tapF + o1 + n); f2[i] = *(const f32x4*)(tapF + o2 + n); b1[i] = *(const f32x4*)(tapB + o1 + n); b2[i] = *(const f32x4*)(tapB + o2 + n); }
#pragma unroll
      for (int i = 0; i < 2; ++i) {
#pragma unroll
          for (int e = 0; e < 4; ++e) { const int n = 4 * (tid + 512 * (2 * h + i)) + e; const bool z = (n == 0);
              x[sw(n)] = (c32){f1[i][e], f2[i][e]}; x[sw(z ? LH : N - n)] = z ? (c32){0.f, 0.f} : (c32){b1[i][e], b2[i][e]}; } } }
    __syncthreads();
    fwd_all(x, tid);
    const int lane = tid & 63, wv = tid >> 6, khi = ((lane & 3) << 4) | (lane & 12) | (lane >> 4);
    f32x4 Kr[17];
#pragma unroll
    for (int it = 0; it < 17; ++it) { const int m = wv + 8 * it;
        const bool act = (it == 16) ? (wv == 0 && khi < 32) : ((it == 0 && wv == 0) ? (khi <= 32) : true);
        const int kp = (N - (256 * khi + m)) & (N - 1);
        const int pk = sw((rev4b(m) << 6) | lane), pkp = sw(rev4(kp));
        Kr[it] = (f32x4){0.f, 0.f, 0.f, 0.f};
        if (act) { const c32 A = x[pk], Bq = x[pkp]; const c32 B = (c32){Bq.x, -Bq.y};
            const c32 sm = A + B, df = A - B; constexpr float h = 0.5f / (float)N;
            Kr[it] = (f32x4){sm.x * h, sm.y * h, df.y * h, -df.x * h}; } }
    __syncthreads();
    { v2u u1[4], u2[4];
#pragma unroll
      for (int i = 0; i < 4; ++i) { const int n = 4 * (tid + 512 * i); u1[i] = *(const v2u*)(uht + o1 + n); u2[i] = *(const v2u*)(uht + o2 + n); }
#pragma unroll
      for (int i = 0; i < 4; ++i) { const int n = 4 * (tid + 512 * i);
          x[sw(n)] = (c32){blo(u1[i].x), blo(u2[i].x)}; x[sw(n + 1)] = (c32){bhi(u1[i].x), bhi(u2[i].x)}; x[sw(n + 2)] = (c32){blo(u1[i].y), blo(u2[i].y)}; x[sw(n + 3)] = (c32){bhi(u1[i].y), bhi(u2[i].y)};
#pragma unroll
          for (int e = 0; e < 4; ++e) x[sw(LH + n + e)] = (c32){0.f, 0.f}; } }
    __syncthreads();
    fwd_all(x, tid);
#pragma unroll
    for (int it = 0; it < 17; ++it) { const int m = wv + 8 * it;
        const bool act = (it == 16) ? (wv == 0 && khi < 32) : ((it == 0 && wv == 0) ? (khi <= 32) : true);
        const int kp = (N - (256 * khi + m)) & (N - 1);
        const int pk = sw((rev4b(m) << 6) | lane), pkp = sw(rev4(kp));
        if (act) { const c32 A = x[pk], Bq = x[pkp]; const c32 B = (c32){Bq.x, -Bq.y};
            const c32 sm = A + B, df = A - B; const c32 U1 = sm * 0.5f, U2 = (c32){df.y * 0.5f, -df.x * 0.5f};
            const f32x4 K = Kr[it];
            const c32 Y1 = cmul(U1, (c32){K[0], K[1]}), Y2 = cmul(U2, (c32){K[2], K[3]});
            x[pkp] = (c32){Y1.x + Y2.y, Y2.x - Y1.y};
            x[pk]  = (c32){Y1.x - Y2.y, Y1.y + Y2.x}; } }
    __syncthreads();
    inv_all(x, tid);
#pragma unroll
    for (int i = 0; i < 4; ++i) { const int n = 4 * (tid + 512 * i); const c32 v0 = x[sw(n)], v1 = x[sw(n + 1)], v2 = x[sw(n + 2)], v3 = x[sw(n + 3)];
        *(v2u*)(yct + o1 + n) = (v2u){pk2(v0.x, v1.x), pk2(v2.x, v3.x)}; *(v2u*)(yct + o2 + n) = (v2u){pk2(v0.y, v1.y), pk2(v2.y, v3.y)}; }
    __syncthreads();
}
}
__device__ __forceinline__ float da_lambda(const Args& A, const Frame& F) {
    const float* lp = A.in[22]; const int l = F.lane;
    const float sa = wave_sum(lp[l] * lp[64 + l]), sb = wave_sum(lp[128 + l] * lp[192 + l]);
    return __expf(sa) - __expf(sb) + 0.2f;
}
__device__ __forceinline__ void p5_finalize(const Args& A, Frame& F) {
    { const float lam = da_lambda(A, F); const float* O = (const float*)(F.ws + WS_O); bf16* yda = (bf16*)(F.ws + WS_YDA); const float* sub = A.in[23];
      const int head = F.lane >> 3, e0 = (F.lane & 7) * 16;
      float sl[16];
#pragma unroll
      for (int i = 0; i < 16; ++i) sl[i] = sub[e0 + i] * 0.8f;
      for (int t = F.gw; t < SEQ; t += F.NGW) {
          const float* o0 = O + (size_t)t * 2048 + (2 * head) * 128 + e0; const float* o1 = o0 + 128;
          float y[16]; float ss = 0.f;
#pragma unroll
          for (int q = 0; q < 4; ++q) { const f32x4 a = *(const f32x4*)(o0 + 4 * q), b = *(const f32x4*)(o1 + 4 * q);
#pragma unroll
              for (int e = 0; e < 4; ++e) { const float v = a[e] - lam * b[e]; y[4 * q + e] = v; ss += v * v; } }
          ss += __shfl_xor(ss, 1); ss += __shfl_xor(ss, 2); ss += __shfl_xor(ss, 4);
          const float rstd = rsqrtf(ss * (1.f / 128.f) + EPS);
          v4u w0, w1; w0.x = pk2(y[0] * rstd * sl[0], y[1] * rstd * sl[1]); w0.y = pk2(y[2] * rstd * sl[2], y[3] * rstd * sl[3]);
          w0.z = pk2(y[4] * rstd * sl[4], y[5] * rstd * sl[5]); w0.w = pk2(y[6] * rstd * sl[6], y[7] * rstd * sl[7]);
          w1.x = pk2(y[8] * rstd * sl[8], y[9] * rstd * sl[9]); w1.y = pk2(y[10] * rstd * sl[10], y[11] * rstd * sl[11]);
          w1.z = pk2(y[12] * rstd * sl[12], y[13] * rstd * sl[13]); w1.w = pk2(y[14] * rstd * sl[14], y[15] * rstd * sl[15]);
          bf16* dst = yda + (size_t)t * 1024 + head * 128 + e0; *(v4u*)dst = w0; *(v4u*)(dst + 8) = w1; } }
    { const bf16* yct = (const bf16*)(F.ws + WS_YCT); const bf16* uht = (const bf16*)(F.ws + WS_UHT); const bf16* x0 = (const bf16*)(F.ws + WS_X0);
      bf16* yhy = (bf16*)(F.ws + WS_YHY); const float* bias = A.in[21];
      LAS unsigned char* tile = F.lds;
#pragma unroll 1
      for (int it = F.vcu; it < 256; it += F.G) { int ln = F.lane; asm volatile("" : "+v"(ln));
          const int t0 = (it >> 1) * 64, cbase = (it & 1) * 512, csub = ln >> 3, piece = ln & 7;
          v4u yv[8], uv[8]; float bv[8];
#pragma unroll
          for (int i = 0; i < 8; ++i) { const int cl = 64 * F.wave + 8 * i + csub; const size_t o = (size_t)(cbase + cl) * SEQ + t0 + 8 * piece;
              yv[i] = *(const v4u*)(yct + o); uv[i] = *(const v4u*)(uht + o); bv[i] = bias[cbase + cl]; }
#pragma unroll
          for (int i = 0; i < 8; ++i) { const int cl = 64 * F.wave + 8 * i + csub;
              LAS unsigned short* tp = (LAS unsigned short*)(tile + (size_t)(8 * piece) * 1024 + ((((cl >> 3) ^ piece) & 63) << 4) + 2 * (cl & 7));
#pragma unroll
              for (int h = 0; h < 4; ++h) { tp[(2 * h) * 512] = (unsigned short)f2bf(blo(yv[i][h]) + blo(uv[i][h]) * bv[i]); tp[(2 * h + 1) * 512] = (unsigned short)f2bf(bhi(yv[i][h]) + bhi(uv[i][h]) * bv[i]); } }
          __syncthreads();
          v4u xv[8];
#pragma unroll
          for (int tt = 0; tt < 8; ++tt) xv[tt] = *(const v4u*)(x0 + (size_t)(t0 + 8 * F.wave + tt) * 1024 + cbase + 8 * ln);
#pragma unroll
          for (int tt = 0; tt < 8; ++tt) { const int tl = 8 * F.wave + tt;
              const v4u m = *(const LAS v4u*)(tile + (size_t)tl * 1024 + (((ln ^ (tl >> 3)) & 63) << 4)); v4u o;
#pragma unroll
              for (int h = 0; h < 4; ++h) o[h] = pk2(blo(xv[tt][h]) * blo(m[h]), bhi(xv[tt][h]) * bhi(m[h]));
              *(v4u*)(yhy + (size_t)(t0 + tl) * 1024 + cbase + 8 * ln) = o; }
          __syncthreads();
      } }
}

__device__ __forceinline__ void p8_rows(const Args& A, Frame& F) {
    const float* mix = (const float*)(F.ws + WS_MIX); bf16* hb = (bf16*)(F.ws + WS_HB);
    int r = F.gw; if (r >= SEQ) return;
    f32x4 ga[8], a2[8], b2[8];
#pragma unroll
    for (int j = 0; j < 8; ++j) { const int col = 4 * F.lane + 256 * j;
        ga[j] = mod4(A, F, 0, 2 * DM + col) * *(const f32x4*)(A.in[7] + col);
        a2[j] = *(const f32x4*)(A.in[8] + col) * (mod4(A, F, 0, 4 * DM + col) + 1.f); b2[j] = mod4(A, F, 0, 3 * DM + col); }
    for (; r < SEQ; r += F.NGW) {
        const f32x4* mr = (const f32x4*)(mix + (size_t)r * DM) + F.lane; const f32x4* xr = (const f32x4*)(A.in[0] + (size_t)r * DM) + F.lane;
        f32x4 v[8], xv[8]; float s = 0.f;
#pragma unroll
        for (int j = 0; j < 8; ++j) { v[j] = mr[64 * j]; xv[j] = xr[64 * j]; }
#pragma unroll
        for (int j = 0; j < 8; ++j) s += (v[j][0] * v[j][0] + v[j][1] * v[j][1]) + (v[j][2] * v[j][2] + v[j][3] * v[j][3]);
        const float rstd = rsqrtf(wave_sum(s) * (1.f / DM) + EPS); float s2 = 0.f;
        f32x4* orow = (f32x4*)(F.out + (size_t)r * DM) + F.lane;
#pragma unroll
        for (int j = 0; j < 8; ++j) { v[j] = xv[j] + v[j] * rstd * ga[j]; orow[64 * j] = v[j];
            s2 += (v[j][0] * v[j][0] + v[j][1] * v[j][1]) + (v[j][2] * v[j][2] + v[j][3] * v[j][3]); }
        const float rstd2 = rsqrtf(wave_sum(s2) * (1.f / DM) + EPS);
        unsigned long long* o8 = (unsigned long long*)(hb + (size_t)r * DM) + F.lane;
#pragma unroll
        for (int j = 0; j < 8; ++j) { const f32x4 y = v[j] * rstd2 * a2[j] + b2[j];
            o8[64 * j] = (unsigned long long)pk2(y[0], y[1]) | ((unsigned long long)pk2(y[2], y[3]) << 32); }
    }
}

typedef float f32x16 __attribute__((ext_vector_type(16)));
#define TK_CS(A, B) do { const float hi_ = __builtin_fmaxf(v[A], v[B]), lo_ = __builtin_fminf(v[A], v[B]); v[A] = hi_; v[B] = lo_; } while (0)
__device__ __forceinline__ float tk_tag(float x, unsigned mask, unsigned id) { return __uint_as_float((__float_as_uint(x) & ~mask) | id); }
__device__ __forceinline__ void tk_sort16(float (&v)[16]) {
#pragma unroll
    for (int k = 2; k <= 16; k <<= 1)
#pragma unroll
        for (int j = k >> 1; j >= 1; j >>= 1)
#pragma unroll
            for (int i = 0; i < 16; ++i) { const int l = i ^ j; if (l > i) { if ((i & k) == 0) TK_CS(i, l); else TK_CS(l, i); } }
}
__device__ __forceinline__ void tk_merge16(float (&v)[16], const float (&o)[16]) {
#pragma unroll
    for (int t = 0; t < 16; ++t) v[t] = __builtin_fmaxf(v[t], o[15 - t]);
#pragma unroll
    for (int st = 8; st >= 1; st >>= 1)
#pragma unroll
        for (int t = 0; t < 16; ++t) if ((t & st) == 0) TK_CS(t, t + st);
}
__device__ __forceinline__ void p11_item(const Args& A, Frame& F, int item) {
    const int tb = item & 31, h = item >> 5;
    LAS float* KT = (LAS float*)F.lds;
    const float* keys = A.in[28];
    for (int i = F.tid; i < 2 * 128 * 32; i += NTHR) { const int k = i & 127, dc = (i >> 7) & 31, p = i >> 12;
        const f32x4 v = *(const f32x4*)(keys + ((size_t)(p * 8 + h) * 128 + k) * 128 + dc * 4);
        LAS float* d = KT + (p * 128 + dc * 4) * 128 + k; d[0] = v[0]; d[128] = v[1]; d[256] = v[2]; d[384] = v[3]; }
    __syncthreads();
    const int lane = F.lane, r32 = lane & 31, hi = lane >> 5;
    const int n = tb * 256 + F.wave * 32 + r32;
    const float* qrow = (const float*)(F.ws + WS_QP) + (size_t)n * DM + h * 256;
    f32x16 acc[2][4];
#pragma unroll
    for (int p = 0; p < 2; ++p) {
#pragma unroll
        for (int kt = 0; kt < 4; ++kt) acc[p][kt] = f32x16{};
        const LAS float* kb = KT + (p * 128 + 64 * hi) * 128 + r32;
        f32x4 qn = *(const f32x4*)(qrow + p * 128 + 64 * hi);
#pragma unroll 1
        for (int i4 = 0; i4 < 16; ++i4) {
            const f32x4 q = qn; qn = *(const f32x4*)(qrow + p * 128 + 64 * hi + 4 * ((i4 + 1) & 15));
#pragma unroll
            for (int e = 0; e < 4; ++e)
#pragma unroll
                for (int kt = 0; kt < 4; ++kt) acc[p][kt] = __builtin_amdgcn_mfma_f32_32x32x2f32(kb[(4 * i4 + e) * 128 + 32 * kt], q[e], acc[p][kt], 0, 0, 0);
        }
    }
    __syncthreads();
    float lv[2][16];
#pragma unroll
    for (int p = 0; p < 2; ++p) {
        float v[16];
#pragma unroll
        for (int r = 0; r < 16; ++r) v[r] = tk_tag(acc[p][0][r], 127u, (unsigned)((r & 3) + 8 * (r >> 2) + 4 * hi));
        tk_sort16(v);
#pragma unroll
        for (int kt = 1; kt < 4; ++kt) { float w[16];
#pragma unroll
            for (int r = 0; r < 16; ++r) w[r] = tk_tag(acc[p][kt][r], 127u, (unsigned)(32 * kt + (r & 3) + 8 * (r >> 2) + 4 * hi));
            tk_sort16(w); tk_merge16(v, w); }
        { float ov[16];
#pragma unroll
          for (int t = 0; t < 16; ++t) ov[t] = __shfl_xor(v[t], 32);
          tk_merge16(v, ov); }
#pragma unroll
        for (int t = 0; t < 16; ++t) lv[p][t] = v[t];
    }
    LAS int* cidl = (LAS int*)F.lds + (F.wave * 32 + r32) * 65;
    float blk[4][16]; { int c = 0;
#pragma unroll
        for (int i = 0; i < 16; ++i)
#pragma unroll
            for (int j = 0; j < 16; ++j) if ((i + 1) * (j + 1) <= 16) {
                blk[c >> 4][c & 15] = tk_tag(lv[0][i] + lv[1][j], 63u, (unsigned)c);
                if (hi == 0) cidl[c] = (int)((__float_as_uint(lv[0][i]) & 127u) * 128u + (__float_as_uint(lv[1][j]) & 127u));
                ++c; }
#pragma unroll
        for (; c < 64; ++c) blk[c >> 4][c & 15] = tk_tag(-3.0e38f, 63u, (unsigned)c); }
    tk_sort16(blk[0]); tk_sort16(blk[1]); tk_sort16(blk[2]); tk_sort16(blk[3]);
    tk_merge16(blk[0], blk[1]); tk_merge16(blk[2], blk[3]); tk_merge16(blk[0], blk[2]);
    float e[16], sum = 0.f;
#pragma unroll
    for (int t = 0; t < 16; ++t) { e[t] = __expf(blk[0][t] - blk[0][0]); sum += e[t]; }
    const float rs = 1.f / sum;
    if (hi == 0) { int* io = (int*)(F.ws + WS_IDX) + (size_t)n * 128 + h * 16; float* go = (float*)(F.ws + WS_GW) + (size_t)n * 128 + h * 16;
        int id[16];
#pragma unroll
        for (int t = 0; t < 16; ++t) id[t] = cidl[__float_as_uint(blk[0][t]) & 63u];
#pragma unroll
        for (int t = 0; t < 16; t += 4) { *(v4u*)(io + t) = (v4u){(unsigned)id[t], (unsigned)id[t + 1], (unsigned)id[t + 2], (unsigned)id[t + 3]};
            *(f32x4*)(go + t) = (f32x4){e[t] * rs, e[t + 1] * rs, e[t + 2] * rs, e[t + 3] * rs}; } }
    __syncthreads();
}
#undef TK_CS

__device__ __forceinline__ float gelu_erf(float x) { return 0.5f * x * (1.f + erff(x * 0.7071067811865476f)); }
__device__ __forceinline__ void fmac1(float& acc, float a, float b) { asm("v_fmac_f32 %0, %1, %2" : "+v"(acc) : "v"(a), "v"(b)); }
typedef _Float16 h2 __attribute__((ext_vector_type(2)));
__device__ __forceinline__ void p12_coldots(const Args& A, Frame& F) {
    typedef float f32x2 __attribute__((ext_vector_type(2)));
    const bf16* hb = (const bf16*)(F.ws + WS_HB); const unsigned char* ub = F.ws + WS_UB; const int* idx = (const int*)(F.ws + WS_IDX);
    const int lane = F.lane, wpg = F.NGW >> 3, x = F.gw / wpg, wl = F.gw - x * wpg, rs = lane >> 4, cc = lane & 15;
    float* pdx = (float*)(F.ws + WS_PD) + (size_t)x * SEQ * 128;
    const size_t coff = 256 * x + 16 * cc;
    const unsigned char* usl = ub + (size_t)x * ((size_t)NEXP * 256) + 16 * cc;
#define P12_LOADH(HF, ID0, ID1, nn) do { const v4u a_ = *(const v4u*)(hb + (size_t)(nn) * DM + coff), b_ = *(const v4u*)(hb + (size_t)(nn) * DM + coff + 8); \
        HF[0] = (h2){(_Float16)blo(a_.x), (_Float16)bhi(a_.x)}; HF[1] = (h2){(_Float16)blo(a_.y), (_Float16)bhi(a_.y)}; HF[2] = (h2){(_Float16)blo(a_.z), (_Float16)bhi(a_.z)}; HF[3] = (h2){(_Float16)blo(a_.w), (_Float16)bhi(a_.w)}; \
        HF[4] = (h2){(_Float16)blo(b_.x), (_Float16)bhi(b_.x)}; HF[5] = (h2){(_Float16)blo(b_.y), (_Float16)bhi(b_.y)}; HF[6] = (h2){(_Float16)blo(b_.z), (_Float16)bhi(b_.z)}; HF[7] = (h2){(_Float16)blo(b_.w), (_Float16)bhi(b_.w)}; \
        ID0 = idx[(size_t)(nn) * 128 + lane]; ID1 = idx[(size_t)(nn) * 128 + 64 + lane]; } while (0)
#define P12_LOADW(W, ID) do { _Pragma("unroll") for (int i = 0; i < 16; ++i) { const int e_ = __shfl((ID), 4 * i + rs); W[i] = *(const v4u*)(usl + (size_t)e_ * 256); } } while (0)
#define P12_DOTS(W, HF, B) do { _Pragma("unroll") for (int i = 0; i < 16; ++i) { float a0 = 0.f, a1 = 0.f; \
        _Pragma("unroll") for (int e = 0; e < 4; ++e) { const h2 lo = __builtin_amdgcn_cvt_scalef32_pk_f16_fp8((int)W[i][e], 1.0f, false), hi2 = __builtin_amdgcn_cvt_scalef32_pk_f16_fp8((int)W[i][e], 1.0f, true); \
            a0 = __builtin_amdgcn_fdot2(lo, HF[2 * e], a0, false); a1 = __builtin_amdgcn_fdot2(hi2, HF[2 * e + 1], a1, false); } \
        acc[16 * (B) + i] = a0 + a1; } } while (0)
    h2 hf[8], hfn[8]; int id0, id1, idn0 = 0, idn1 = 0; v4u wA[16], wB[16];
    if (wl < SEQ) { P12_LOADH(hf, id0, id1, wl); P12_LOADW(wA, id0); }
#pragma unroll 1
    for (int n = wl; n < SEQ; n += wpg) {
        const int nn = n + wpg; const bool more = nn < SEQ;
        float acc[32];
        if (more) P12_LOADH(hfn, idn0, idn1, nn);
        P12_LOADW(wB, id1);
        __builtin_amdgcn_sched_barrier(0);
        P12_DOTS(wA, hf, 0);
        __builtin_amdgcn_sched_barrier(0);
        if (more) P12_LOADW(wA, idn0);
        __builtin_amdgcn_sched_barrier(0);
        P12_DOTS(wB, hf, 1);
        __builtin_amdgcn_sched_barrier(0);
        float r16[16], r8[8], r4[4], r2[2];
        { const bool t = cc & 8;
#pragma unroll
          for (int k = 0; k < 16; ++k) r16[k] = (t ? acc[k + 16] : acc[k]) + __shfl_xor(t ? acc[k] : acc[k + 16], 8); }
        { const bool t = cc & 4;
#pragma unroll
          for (int k = 0; k < 8; ++k) r8[k] = (t ? r16[k + 8] : r16[k]) + __shfl_xor(t ? r16[k] : r16[k + 8], 4); }
        { const bool t = cc & 2;
#pragma unroll
          for (int k = 0; k < 4; ++k) r4[k] = (t ? r8[k + 4] : r8[k]) + __shfl_xor(t ? r8[k] : r8[k + 4], 2); }
        { const bool t = cc & 1;
#pragma unroll
          for (int k = 0; k < 2; ++k) r2[k] = (t ? r4[k + 2] : r4[k]) + __shfl_xor(t ? r4[k] : r4[k + 2], 1); }
        const int I0 = 2 * (cc & 1) + 4 * ((cc >> 1) & 1) + 8 * ((cc >> 2) & 1) + 16 * (cc >> 3);
        pdx[(size_t)n * 128 + 4 * I0 + rs] = r2[0]; pdx[(size_t)n * 128 + 4 * (I0 + 1) + rs] = r2[1];
#pragma unroll
        for (int i = 0; i < 8; ++i) hf[i] = hfn[i];
        id0 = idn0; id1 = idn1;
    }
#undef P12_LOADH
#undef P12_LOADW
#undef P12_DOTS
}
__device__ __forceinline__ void p12b_weights(const Args& A, Frame& F) {
    const int* idx = (const int*)(F.ws + WS_IDX); const float* gwp = (const float*)(F.ws + WS_GW); const float* pd = (const float*)(F.ws + WS_PD);
    const float* usc = (const float*)(F.ws + WS_USC); const float* vsc = (const float*)(F.ws + WS_VSC); float* wgt = (float*)(F.ws + WS_WGT);
    const int lane = F.lane;
    for (int n = F.gw; n < SEQ; n += F.NGW) {
        const int id0 = idx[(size_t)n * 128 + lane], id1 = idx[(size_t)n * 128 + 64 + lane];
        float d0 = 0.f, d1 = 0.f;
#pragma unroll
        for (int g = 0; g < 8; ++g) { d0 += pd[((size_t)g * SEQ + n) * 128 + lane]; d1 += pd[((size_t)g * SEQ + n) * 128 + 64 + lane]; }
        wgt[(size_t)n * 128 + lane] = gwp[(size_t)n * 128 + lane] * gelu_erf(d0 * usc[id0]) * vsc[id0];
        wgt[(size_t)n * 128 + 64 + lane] = gwp[(size_t)n * 128 + 64 + lane] * gelu_erf(d1 * usc[id1]) * vsc[id1];
    }
}
__device__ __forceinline__ void p13_colsum(const Args& A, Frame& F) {
    typedef float f32x2 __attribute__((ext_vector_type(2)));
    const unsigned char* vb = F.ws + WS_VB; const int* idx = (const int*)(F.ws + WS_IDX); const float* gwp = (const float*)(F.ws + WS_GW);
    const float* wgt = (const float*)(F.ws + WS_WGT);
    float* opre = (float*)(F.ws + WS_OPRE); float* ssp = (float*)(F.ws + WS_SSP);
    const int lane = F.lane, wpg = F.NGW >> 3, x = F.gw / wpg, wl = F.gw - x * wpg, rs = lane >> 4, cc = lane & 15;
    const size_t coff = 256 * x + 16 * cc;
    const unsigned char* vsl = vb + (size_t)x * ((size_t)NEXP * 256) + 16 * cc;
#pragma unroll 1
    for (int n = wl; n < SEQ; n += wpg) {
        const int id0 = idx[(size_t)n * 128 + lane], id1 = idx[(size_t)n * 128 + 64 + lane];
        const float wg0 = wgt[(size_t)n * 128 + lane], wg1 = wgt[(size_t)n * 128 + 64 + lane];
        h2 o2[8];
#pragma unroll
        for (int i = 0; i < 8; ++i) o2[i] = (h2){(_Float16)0.f, (_Float16)0.f};
#pragma unroll
        for (int b = 0; b < 2; ++b) {
            v4u w[16]; h2 wv[16];
#pragma unroll
            for (int i = 0; i < 16; ++i) { const int e = __shfl(b ? id1 : id0, 4 * i + rs); const _Float16 t = (_Float16)(__shfl(b ? wg1 : wg0, 4 * i + rs) * 4096.f); wv[i] = (h2){t, t};
                w[i] = *(const v4u*)(vsl + (size_t)e * 256); }
#pragma unroll
            for (int i = 0; i < 16; ++i) {
#pragma unroll
                for (int e = 0; e < 4; ++e) { const h2 lo = __builtin_amdgcn_cvt_scalef32_pk_f16_fp8((int)w[i][e], 1.0f, false), hi2 = __builtin_amdgcn_cvt_scalef32_pk_f16_fp8((int)w[i][e], 1.0f, true);
                    o2[2 * e] = lo * wv[i] + o2[2 * e]; o2[2 * e + 1] = hi2 * wv[i] + o2[2 * e + 1]; } }
            __builtin_amdgcn_sched_barrier(0);
        }
        float o[16];
#pragma unroll
        for (int i = 0; i < 8; ++i) { o[2 * i] = (float)o2[i][0] * (1.f / 4096.f); o[2 * i + 1] = (float)o2[i][1] * (1.f / 4096.f); }
        float t8[8]; f32x4 t4;
        { const bool t = lane & 32;
#pragma unroll
          for (int k = 0; k < 8; ++k) t8[k] = (t ? o[k + 8] : o[k]) + __shfl_xor(t ? o[k] : o[k + 8], 32); }
        { const bool t = lane & 16;
#pragma unroll
          for (int k = 0; k < 4; ++k) t4[k] = (t ? t8[k + 4] : t8[k]) + __shfl_xor(t ? t8[k] : t8[k + 4], 16); }
        *(f32x4*)(opre + (size_t)n * DM + coff + 8 * (lane >> 5) + 4 * ((lane >> 4) & 1)) = t4;
        const float ss = wave_sum((t4[0] * t4[0] + t4[1] * t4[1]) + (t4[2] * t4[2] + t4[3] * t4[3]));
        if (lane == 0) ssp[(size_t)x * SEQ + n] = ss;
    }
}
__device__ __forceinline__ void p14_final(const Args& A, Frame& F) {
    const float* opre = (const float*)(F.ws + WS_OPRE); const float* ssp = (const float*)(F.ws + WS_SSP);
    int n = F.gw; if (n >= SEQ) return;
    f32x4 gnp[8];
#pragma unroll
    for (int j = 0; j < 8; ++j) { const int col = 4 * F.lane + 256 * j; gnp[j] = mod4(A, F, 0, 5 * DM + col) * *(const f32x4*)(A.in[9] + col); }
    for (; n < SEQ; n += F.NGW) {
        const float ss = wave_sum(F.lane < 8 ? ssp[(size_t)F.lane * SEQ + n] : 0.f);
        const float rstd = rsqrtf(ss * (1.f / DM) + EPS);
        const f32x4* pr = (const f32x4*)(opre + (size_t)n * DM) + F.lane; f32x4* orow = (f32x4*)(F.out + (size_t)n * DM) + F.lane;
        f32x4 p[8], xo[8];
#pragma unroll
        for (int j = 0; j < 8; ++j) { p[j] = pr[64 * j]; xo[j] = orow[64 * j]; }
#pragma unroll
        for (int j = 0; j < 8; ++j) orow[64 * j] = xo[j] + gnp[j] * p[j] * rstd;
    }
}
constexpr int NPH = 16;
constexpr int CW_BAR = 4096;
constexpr int MAX_LAUNCHES = 3;
static_assert((CW_BAR + MAX_LAUNCHES * XCD_BAR_WORDS) * 4 <= (int)CTL_ZERO_BYTES, "barrier words inside the memset region");
__device__ __forceinline__ bool refresh_ids(Frame& F) { int t = threadIdx.x; asm volatile("" : "+v"(t)); F.tid = t; F.lane = t & 63; return true; }
__global__ void __launch_bounds__(NTHR, 2) hybrid_fwd(Args args) {
    extern __shared__ __attribute__((aligned(16))) unsigned char lds[];
    Frame F;
    F.lds = (LAS unsigned char*)lds; F.ldsg = (char*)lds;
    F.tid = threadIdx.x; F.lane = F.tid & 63; F.wave = __builtin_amdgcn_readfirstlane(F.tid >> 6);
    F.G = gridDim.x; { const int bx = blockIdx.x; F.vcu = (F.G % 8 == 0) ? (bx % 8) * (F.G / 8) + bx / 8 : bx; }
    F.gw = F.vcu * NWAVES + F.wave; F.NGW = F.G * NWAVES;
    F.out = args.out; F.ws = args.ws;
    volatile LAS unsigned* MISC = (volatile LAS unsigned*)(F.lds + MISC_OFF);
    for (int u = F.tid; u < 64; u += NTHR) MISC[u] = 0u;
    __syncthreads();
    unsigned* ctl = (unsigned*)(F.ws + WS_CTL);
    XcdBarrier bar = xcd_barrier_post(ctl + CW_BAR + args.li * XCD_BAR_WORDS, MISC + 8);
    const int lo = args.ph_lo, hi = args.ph_hi;
#define IN(k) (lo <= (k) && (k) < hi && refresh_ids(F))
#define SEAM(k) do { if (IN(k) && IN((k) + 1)) xcd_barrier(bar); } while (0)

    if (IN(0)) { p0_prologue(args, F); } SEAM(0);
    if (IN(1)) { p1_rows(args, F); } SEAM(1);
    if (IN(2)) {
        p2_ctx_unit(F);
        pg8::Gemm g{(const bf16*)(F.ws + WS_U), (const bf16*)(F.ws + WS_WIN), SEQ, INCOLS, DM}; pg8::StaticOrder S; S.init(SEQ, INCOLS, F.G, (int)blockIdx.x);
        pg8::EpiSplit1 E{(bf16*)(F.ws + WS_PHY), (long)(WS_QRAW - WS_PHY) / 2, (long)(WS_KRAW - WS_PHY) / 2, (long)(WS_V2 - WS_PHY) / 2, (long)(WS_GATES - WS_PHY) / 2};
        pg8::gemm_phase<pg8::EpiSplit1, pg8::StaticOrder, true, true>(F.lds, g, S, E);
    } SEAM(2);
    if (IN(3)) { p3_post(args, F, F.gw, F.NGW); } SEAM(3);
    if (IN(4)) {
        const int x = F.vcu >> 5, qb = F.vcu & 31;
        if (F.G == 256) {
#pragma unroll 1
            for (int i = 0; i < 2; ++i) { const int hm = 2 * x + i;
                att::attn_unit((const bf16*)(F.ws + WS_Q2) + (size_t)(qb * 256) * 1024 + hm * 64, (const bf16*)(F.ws + WS_K2) + hm * 64,
                               (const bf16*)(F.ws + WS_V2) + (hm >> 1) * 128, (float*)(F.ws + WS_O) + (size_t)(qb * 256) * 2048 + hm * 128, NKEYS, F.ldsg); }
#ifdef ATT_VAR
            { const int hm = 2 * x;
                att::attn_unit<ATT_VAR>((const bf16*)(F.ws + WS_Q2) + (size_t)(qb * 256) * 1024 + hm * 64, (const bf16*)(F.ws + WS_K2) + hm * 64,
                               (const bf16*)(F.ws + WS_V2) + (hm >> 1) * 128, (float*)(F.ws + WS_KSPEC), NKEYS, F.ldsg); }
#endif
        }
    }
    if (IN(5)) {
#pragma unroll 1
        for (int pr = F.vcu; pr < HYW / 2; pr += F.G)
            fftc::conv_pair(F.lds, F.tid, pr, (const float*)(F.ws + WS_TAPF), (const float*)(F.ws + WS_TAPB), (const bf16*)(F.ws + WS_UHT), (bf16*)(F.ws + WS_YCT));
    } SEAM(5);
    if (IN(6)) { p5_finalize(args, F); } SEAM(6);
    if (IN(7)) {
        pg8::StaticOrder S; S.init(SEQ, DM, F.G, (int)blockIdx.x);
        { pg8::Gemm g{(const bf16*)(F.ws + WS_YHY), (const bf16*)(F.ws + WS_WHY), SEQ, DM, HYW};
          pg8::EpiGate<0> E{(bf16*)(F.ws + WS_MB), DM, (const bf16*)(F.ws + WS_GATES), 4096};
          pg8::gemm_phase<pg8::EpiGate<0>, pg8::StaticOrder, true, true>(F.lds, g, S, E); }
        { pg8::Gemm g{(const bf16*)(F.ws + WS_YDA), (const bf16*)(F.ws + WS_WDA), SEQ, DM, HYW};
          pg8::EpiGate<1> E{(bf16*)(F.ws + WS_MB), DM, (const bf16*)(F.ws + WS_GATES) + 2048, 4096};
          pg8::gemm_phase<pg8::EpiGate<1>, pg8::StaticOrder, true, true>(F.lds, g, S, E); }
    } SEAM(7);
    if (IN(8)) {
        pg8::Gemm g{(const bf16*)(F.ws + WS_MB), (const bf16*)(F.ws + WS_WO), SEQ, DM, DM}; pg8::StaticOrder S; S.init(SEQ, DM, F.G, (int)blockIdx.x);
        pg8::EpiF32 E{(float*)(F.ws + WS_MIX), DM};
        pg8::gemm_phase<pg8::EpiF32, pg8::StaticOrder, true, true>(F.lds, g, S, E);
    } SEAM(8);
    if (IN(9)) { p8_rows(args, F); } SEAM(9);
    if (IN(10)) {
        pg8::Gemm g{(const bf16*)(F.ws + WS_HB), (const bf16*)(F.ws + WS_WQ), SEQ, DM, DM}; pg8::StaticOrder S; S.init(SEQ, DM, F.G, (int)blockIdx.x);
        pg8::EpiF32 E{(float*)(F.ws + WS_QP), DM};
        pg8::gemm_phase<pg8::EpiF32, pg8::StaticOrder, true, true>(F.lds, g, S, E);
    } SEAM(10);
    if (IN(11)) {
#pragma unroll 1
        for (int it = F.vcu; it < 256; it += F.G) p11_item(args, F, it);
    } SEAM(11);
    if (IN(12)) { p12_coldots(args, F); } SEAM(12);
    if (IN(13)) { p12b_weights(args, F); } SEAM(13);
    if (IN(14)) { p13_colsum(args, F); } SEAM(14);
    if (IN(15)) { p14_final(args, F); }
#undef IN
#undef SEAM
}

#ifndef PROBE_PH
#define PROBE_PH -1
#endif
extern "C" void kernel_launch(void* const* d_in, const int* in_sizes, int n_in, void* d_out, int out_size, void* d_ws, size_t ws_size, hipStream_t stream) {
    static int grid = 0;
    if (grid == 0) {
        if (n_in != 31 || in_sizes[0] != SEQ * DM || out_size != SEQ * DM || ws_size < WS_END) {
            fprintf(stderr, "kernel_launch: built for 31 inputs, x/out of %d floats, >= %zu bytes of workspace; got n_in %d, in0 %d, out %d, ws %zu; nothing launched\n",
                    SEQ * DM, (size_t)WS_END, n_in, n_in > 0 ? in_sizes[0] : -1, out_size, ws_size); grid = -1; return; }
        int dev = 0, cus = 0, per_cu = 0;
        if (hipGetDevice(&dev) != hipSuccess || hipDeviceGetAttribute(&cus, hipDeviceAttributeMultiprocessorCount, dev) != hipSuccess) { fprintf(stderr, "kernel_launch: device query failed\n"); grid = -1; return; }
        if (hipFuncSetAttribute((const void*)hybrid_fwd, hipFuncAttributeMaxDynamicSharedMemorySize, LDS_BYTES) != hipSuccess) { fprintf(stderr, "kernel_launch: hipFuncSetAttribute failed\n"); grid = -1; return; }
        if (hipOccupancyMaxActiveBlocksPerMultiprocessor(&per_cu, (const void*)hybrid_fwd, NTHR, LDS_BYTES) != hipSuccess || per_cu < 1) {
            fprintf(stderr, "kernel_launch: occupancy query reports %d workgroups per CU; nothing launched\n", per_cu); (void)hipGetLastError(); grid = -1; return; }
        grid = cus;
        if (grid != 256) fprintf(stderr, "kernel_launch: note: %d CUs (tuned for 256)\n", grid);
    }
    if (grid < 0) return;
    if (hipMemsetAsync((char*)d_ws + WS_CTL, 0, CTL_ZERO_BYTES, stream) != hipSuccess) { fprintf(stderr, "kernel_launch: hipMemsetAsync failed\n"); return; }
    Args a{};
    for (int i = 0; i < 31; ++i) a.in[i] = (const float*)d_in[i];
    a.out = (float*)d_out; a.ws = (unsigned char*)d_ws;
    constexpr int NL = (PROBE_PH >= 0) ? 3 : 1;
    const int cut[4] = {0, (PROBE_PH >= 0) ? PROBE_PH + 1 : NPH, (PROBE_PH >= 0) ? PROBE_PH + 1 : NPH, NPH};
    for (int li = 0; li < NL; ++li) {
        a.ph_lo = (li == 1) ? PROBE_PH : cut[li]; a.ph_hi = cut[li + 1]; a.li = li;
        if (a.ph_lo >= a.ph_hi) continue;
        hipLaunchKernelGGL(hybrid_fwd, dim3(grid), dim3(NTHR), LDS_BYTES, stream, a);
        const hipError_t le = hipPeekAtLastError();
        if (le != hipSuccess) { fprintf(stderr, "kernel_launch: launch %d failed: %s\n", li, hipGetErrorName(le)); break; }
    }
}
```

```cpp
#include <hip/hip_runtime.h>
#include <hip/hip_bf16.h>
#include <cstdio>
#include <cstdint>
namespace pg8 {
#define PG8_LAS __attribute__((address_space(3)))
typedef unsigned short bf16_t;
typedef short bf16x8 __attribute__((ext_vector_type(8)));
typedef float f32x4 __attribute__((ext_vector_type(4)));
typedef unsigned u32x4 __attribute__((ext_vector_type(4)));
constexpr int BM = 256, BK = 64, HALF = 128, HTB = HALF * BK * 2  , STAGE_BYTES = 8 * HTB, NXCD = 8, WGM = 8;

__host__ __device__ __forceinline__ int lds_byte(int r, int c) { const int st = (r >> 4) * 2 + (c >> 5), rr = r & 15, cc = c & 31, ob = rr * 64 + cc * 2; return st * 1024 + (ob ^ (((ob >> 9) & 1) << 5)); }
__host__ __device__ __forceinline__ void stage_rc(int b, int& R, int& C) { const int st = b / 1024, sb = b % 1024, swz = sb ^ (((sb >> 9) & 1) << 5); R = (st >> 1) * 16 + swz / 64; C = (st & 1) * 32 + (swz % 64) / 2; }
__host__ __device__ __forceinline__ int perm32(int rho) { const int n = rho >> 4, i = rho & 15; return 8 * (i >> 2) + 4 * n + (i & 3); }

struct Unit { int pm, pn; };
struct Gemm { const bf16_t* A; const bf16_t* Bt; int M, N, K; };

struct StaticOrder {
    int nM, nN, nwg, G, c;
    __host__ __device__ void init(int M, int N, int G_, int c_) { nM = M / BM; nN = N / BM; nwg = nM * nN; G = G_; c = c_; }
    __host__ __device__ bool next(int i, Unit& u) const {
        const long L = (long)i * G + c; if (L >= nwg) return false;
        int wgid = (int)L; { const int q = nwg / NXCD, r = nwg % NXCD, xcd = wgid % NXCD, off = wgid / NXCD; wgid = (xcd < r ? xcd * (q + 1) : r * (q + 1) + (xcd - r) * q) + off; }
        const int nig = WGM * nN, gid = wgid / nig, fm = gid * WGM, gsz = (nM - fm) < WGM ? (nM - fm) : WGM;
        u.pm = fm + ((wgid % nig) % gsz); u.pn = (wgid % nig) / gsz; return true;
    }
    __device__ __forceinline__ void a_ready(const Unit&) const {}
    __device__ __forceinline__ void done(const Unit&) const {}
};

__device__ __forceinline__ unsigned cvt_pk_bf16(float lo, float hi) { unsigned r; asm volatile("v_cvt_pk_bf16_f32 %0, %1, %2" : "=v"(r) : "v"(lo), "v"(hi)); return r; }
typedef float f32x2 __attribute__((ext_vector_type(2)));
__device__ __forceinline__ float bflo(unsigned w) { return __builtin_bit_cast(float, w << 16); }
__device__ __forceinline__ float bfhi(unsigned w) { return __builtin_bit_cast(float, w & 0xffff0000u); }
__device__ __forceinline__ float sigm(float x) { return 1.f / (1.f + __expf(-x)); }
struct EpiSplit1 {
    static constexpr bool PERM = true, AFTER_DRAIN = false;
    bf16_t* phy; long dq, dk, dv, dg;
    __device__ __forceinline__ void operator()(const f32x4 (&acc)[2][2][4][2], const Unit& u, int wr, int wc, int fr, int fq) const {
        const int pn = u.pn; const bool ctx = (u.pm == 32);
        const int s1 = pn >= 12, s2 = pn >= 16, s3 = pn >= 20, s4 = pn >= 24;
        bf16_t* base = phy + (long)s1 * dq + (long)s2 * (dk - dq) + (long)s3 * (dv - dk) + (long)s4 * (dg - dv);
        const int ldc = 3072 - s1 * 2048 + s4 * 3072;
        const int colt = (pn - 12 * s1 - 4 * s2 - 4 * s3 - 4 * s4) * 256;
        const bool lat_only = !(s2 && !s4);
        const int rowoff = (s3 && !s4) ? (ctx ? -8192 : 256) : 0;
        if (ctx && lat_only) return;
        const int row0 = u.pm * BM + wr * 64 + fr + rowoff, col0 = colt + wc * 32 + 8 * fq;
#pragma unroll
        for (int ai = 0; ai < 2; ++ai)
#pragma unroll
            for (int m = 0; m < 4; ++m) { bf16_t* rowp = base + (size_t)(row0 + ai * HALF + m * 16) * ldc + col0;
#pragma unroll
                for (int bj = 0; bj < 2; ++bj) { const f32x4 v0 = acc[ai][bj][m][0], v1 = acc[ai][bj][m][1];
                    u32x4 w; w.x = cvt_pk_bf16(v0[0], v0[1]); w.y = cvt_pk_bf16(v0[2], v0[3]); w.z = cvt_pk_bf16(v1[0], v1[1]); w.w = cvt_pk_bf16(v1[2], v1[3]);
                    *(u32x4*)(rowp + bj * HALF) = w; } }
    }
};
template <int MODE> struct EpiGate {
    static constexpr bool PERM = true, AFTER_DRAIN = false;
    bf16_t* O; int ldc; const bf16_t* G; int ldg;
    __device__ __forceinline__ void operator()(const f32x4 (&acc)[2][2][4][2], const Unit& u, int wr, int wc, int fr, int fq) const {
        const int row0 = u.pm * BM + wr * 64 + fr, col0 = u.pn * BM + wc * 32 + 8 * fq;
#pragma unroll
        for (int ai = 0; ai < 2; ++ai)
#pragma unroll
            for (int m = 0; m < 4; ++m) { const size_t r = (size_t)(row0 + ai * HALF + m * 16);
#pragma unroll
                for (int bj = 0; bj < 2; ++bj) { const f32x4 v0 = acc[ai][bj][m][0], v1 = acc[ai][bj][m][1];
                    const u32x4 g = *(const u32x4*)(G + r * ldg + col0 + bj * HALF);
                    float o[8] = { sigm(bflo(g.x)) * v0[0], sigm(bfhi(g.x)) * v0[1], sigm(bflo(g.y)) * v0[2], sigm(bfhi(g.y)) * v0[3],
                                   sigm(bflo(g.z)) * v1[0], sigm(bfhi(g.z)) * v1[1], sigm(bflo(g.w)) * v1[2], sigm(bfhi(g.w)) * v1[3] };
                    u32x4* op = (u32x4*)(O + r * ldc + col0 + bj * HALF);
                    if (MODE == 1) { const u32x4 p = *op; o[0] += bflo(p.x); o[1] += bfhi(p.x); o[2] += bflo(p.y); o[3] += bfhi(p.y); o[4] += bflo(p.z); o[5] += bfhi(p.z); o[6] += bflo(p.w); o[7] += bfhi(p.w); }
                    u32x4 w; w.x = cvt_pk_bf16(o[0], o[1]); w.y = cvt_pk_bf16(o[2], o[3]); w.z = cvt_pk_bf16(o[4], o[5]); w.w = cvt_pk_bf16(o[6], o[7]);
                    *op = w; } }
    }
};
struct EpiF32 {
    static constexpr bool PERM = true, AFTER_DRAIN = false;
    float* O; int ldc;
    __device__ __forceinline__ void operator()(const f32x4 (&acc)[2][2][4][2], const Unit& u, int wr, int wc, int fr, int fq) const {
        const int row0 = u.pm * BM + wr * 64 + fr, col0 = u.pn * BM + wc * 32 + 8 * fq;
#pragma unroll
        for (int ai = 0; ai < 2; ++ai)
#pragma unroll
            for (int m = 0; m < 4; ++m) { float* rowp = O + (size_t)(row0 + ai * HALF + m * 16) * ldc + col0;
#pragma unroll
                for (int bj = 0; bj < 2; ++bj) { *(f32x4*)(rowp + bj * HALF) = acc[ai][bj][m][0]; *(f32x4*)(rowp + bj * HALF + 4) = acc[ai][bj][m][1]; } }
    }
};
struct EpiBf16 {
    static constexpr bool PERM = true, AFTER_DRAIN = false;
    bf16_t* O; int ldc;
    __device__ __forceinline__ void operator()(const f32x4 (&acc)[2][2][4][2], const Unit& u, int wr, int wc, int fr, int fq) const {
        const int row0 = u.pm * BM + wr * 64 + fr, col0 = u.pn * BM + wc * 32 + 8 * fq;
#pragma unroll
        for (int ai = 0; ai < 2; ++ai)
#pragma unroll
            for (int m = 0; m < 4; ++m) { bf16_t* rowp = O + (size_t)(row0 + ai * HALF + m * 16) * ldc + col0;
#pragma unroll
                for (int bj = 0; bj < 2; ++bj) { const f32x4 v0 = acc[ai][bj][m][0], v1 = acc[ai][bj][m][1];
                    u32x4 w; w.x = cvt_pk_bf16(v0[0], v0[1]); w.y = cvt_pk_bf16(v0[2], v0[3]); w.z = cvt_pk_bf16(v1[0], v1[1]); w.w = cvt_pk_bf16(v1[2], v1[3]);
                    *(u32x4*)(rowp + bj * HALF) = w; } }
    }
};
struct EpiCtxKV {
    static constexpr bool PERM = true, AFTER_DRAIN = false;
    bf16_t* k2; long dv;
    __device__ __forceinline__ void operator()(const f32x4 (&acc)[2][2][4][2], const Unit& u, int wr, int wc, int fr, int fq) const {
        const int isv = u.pn >= 20; bf16_t* base = k2 + (long)isv * dv;
        const int row0 = wr * 64 + fr, col0 = (u.pn - 16 - 4 * isv) * 256 + wc * 32 + 8 * fq;
#pragma unroll
        for (int ai = 0; ai < 2; ++ai)
#pragma unroll
            for (int m = 0; m < 4; ++m) { bf16_t* rowp = base + (size_t)(row0 + ai * HALF + m * 16) * 1024 + col0;
#pragma unroll
                for (int bj = 0; bj < 2; ++bj) { const f32x4 v0 = acc[ai][bj][m][0], v1 = acc[ai][bj][m][1];
                    u32x4 w; w.x = cvt_pk_bf16(v0[0], v0[1]); w.y = cvt_pk_bf16(v0[2], v0[3]); w.z = cvt_pk_bf16(v1[0], v1[1]); w.w = cvt_pk_bf16(v1[2], v1[3]);
                    *(u32x4*)(rowp + bj * HALF) = w; } }
    }
};
struct OneUnit {
    int pm, pn;
    __device__ __forceinline__ bool next(int i, Unit& u) const { if (i) return false; u.pm = pm; u.pn = pn; return true; }
    __device__ __forceinline__ void a_ready(const Unit&) const {}
    __device__ __forceinline__ void done(const Unit&) const {}
};
template <class Epi, class Sched, bool ALIGN_EPI = false, bool SP2 = false>
__device__ __forceinline__ void gemm_phase(PG8_LAS unsigned char* lds, const Gemm g, const Sched& S, const Epi& E) {
    const int tid = threadIdx.x, wid = __builtin_amdgcn_readfirstlane(tid >> 6), lane = tid & 63, wr = wid >> 2, wc = wid & 3, fr = lane & 15, fq = lane >> 4;
    const int K = g.K, nt = K / BK;
    unsigned voffA[2], voffB[2];
#pragma unroll
    for (int i = 0; i < 2; ++i) { int R, C; stage_rc(tid * 16 + i * 8192, R, C); const int Rb = Epi::PERM ? ((R & ~31) + perm32(R & 31)) : R;
        voffA[i] = (unsigned)(R * K + C) * 2u; voffB[i] = (unsigned)(Rb * K + C) * 2u; }
    const size_t kstep = (size_t)(BK * 2);
    const size_t hstep = (size_t)HALF * K * 2;
    const size_t tstep = 2 * hstep;
    const unsigned ldsw = (unsigned)wid * 1024u;
    const int aoff = lds_byte(wr * 64 + fr, fq * 8), boff = lds_byte(wc * 32 + fr, fq * 8);
#define PG8_SA(b, h) (((b) * 2 + (h)) * HTB)
#define PG8_SB(b, h) ((4 + (b) * 2 + (h)) * HTB)
#define PG8_STAGE(bufoff, gbase, voff) do { _Pragma("unroll") for (int _i = 0; _i < 2; ++_i) \
        __builtin_amdgcn_global_load_lds((const unsigned*)((const char*)(gbase) + (voff)[_i]), (PG8_LAS unsigned*)(lds + (bufoff) + ldsw + _i * 8192), 16, 0, 0); } while (0)
#define PG8_LDA(dst, b, h) do { _Pragma("unroll") for (int m = 0; m < 4; ++m) _Pragma("unroll") for (int k = 0; k < 2; ++k) dst[m][k] = *(const PG8_LAS bf16x8*)(lds + PG8_SA(b, h) + aoff + m * 2048 + k * 1024); } while (0)
#define PG8_LDB(dst, b, h) do { _Pragma("unroll") for (int n = 0; n < 2; ++n) _Pragma("unroll") for (int k = 0; k < 2; ++k) dst[n][k] = *(const PG8_LAS bf16x8*)(lds + PG8_SB(b, h) + boff + n * 2048 + k * 1024); } while (0)
#define PG8_MMA(ai, bj, At, Bt) do { __builtin_amdgcn_s_setprio(1); _Pragma("unroll") for (int m = 0; m < 4; ++m) _Pragma("unroll") for (int n = 0; n < 2; ++n) _Pragma("unroll") for (int k = 0; k < 2; ++k) \
        acc[ai][bj][m][n] = __builtin_amdgcn_mfma_f32_16x16x32_bf16(Bt[n][k], At[m][k], acc[ai][bj][m][n], 0, 0, 0); __builtin_amdgcn_s_setprio(0); } while (0)
#define PG8_WAIT_V(n) asm volatile("s_waitcnt vmcnt(" #n ")" ::: "memory")
#define PG8_WAIT_L(n) asm volatile("s_waitcnt lgkmcnt(" #n ")" ::: "memory")
#define PG8_BAR __builtin_amdgcn_s_barrier()
#define PG8_SCHED __builtin_amdgcn_sched_barrier(0)
    Unit cur, nxt; int ui = 0;
    if (!S.next(0, cur)) return;
    f32x4 acc[2][2][4][2];
#pragma unroll
    for (int a = 0; a < 2; ++a)
#pragma unroll
        for (int b = 0; b < 2; ++b)
#pragma unroll
            for (int m = 0; m < 4; ++m)
#pragma unroll
                for (int n = 0; n < 2; ++n) acc[a][b][m][n] = (f32x4){0.f, 0.f, 0.f, 0.f};
    bf16x8 At[4][2], B0[2][2], B1[2][2];
    const char* cA = (const char*)g.A + (size_t)cur.pm * tstep; const char* cB = (const char*)g.Bt + (size_t)cur.pn * tstep;
    S.a_ready(cur);
    if constexpr (SP2) {
        PG8_STAGE(PG8_SB(0, 0), cB, voffB); PG8_STAGE(PG8_SB(0, 1), cB + hstep, voffB); PG8_STAGE(PG8_SA(0, 0), cA, voffA); PG8_STAGE(PG8_SA(0, 1), cA + hstep, voffA);
        if (wr == 1) PG8_BAR;
        PG8_WAIT_V(2); PG8_BAR;
        PG8_STAGE(PG8_SB(1, 0), cB + kstep, voffB); PG8_STAGE(PG8_SA(1, 0), cA + kstep, voffA); PG8_STAGE(PG8_SB(1, 1), cB + hstep + kstep, voffB);
        PG8_WAIT_V(6); PG8_BAR;
    } else {
        PG8_STAGE(PG8_SB(0, 0), cB, voffB); PG8_STAGE(PG8_SA(0, 0), cA, voffA); PG8_STAGE(PG8_SB(0, 1), cB + hstep, voffB); PG8_STAGE(PG8_SA(0, 1), cA + hstep, voffA);
        if (wr == 1) PG8_BAR;
        PG8_WAIT_V(4); PG8_BAR;
        PG8_STAGE(PG8_SB(1, 0), cB + kstep, voffB); PG8_STAGE(PG8_SA(1, 0), cA + kstep, voffA); PG8_STAGE(PG8_SB(1, 1), cB + hstep + kstep, voffB);
        PG8_WAIT_V(6); PG8_BAR;
    }
    for (;;) {
        const bool has_next = S.next(ui + 1, nxt);
        const char* nA = has_next ? (const char*)g.A + (size_t)nxt.pm * tstep : cA; const char* nB = has_next ? (const char*)g.Bt + (size_t)nxt.pn * tstep : cB;
        for (int t = 0; t < nt; t += 2) {
            const bool last = (t == nt - 2);
            const char* a1 = cA + (size_t)(t + 1) * kstep;
            const char* a2 = last ? nA : cA + (size_t)(t + 2) * kstep; const char* b2 = last ? nB : cB + (size_t)(t + 2) * kstep;
            const char* a3 = a2 + kstep; const char* b3 = b2 + kstep;
            if (last && has_next) S.a_ready(nxt);
            if constexpr (SP2) {
            PG8_LDB(B0, 0, 0); PG8_LDB(B1, 0, 1); PG8_SCHED; PG8_LDA(At, 0, 0); PG8_STAGE(PG8_SA(1, 1), a1 + hstep, voffA);
            PG8_WAIT_V(8); PG8_WAIT_L(0); PG8_BAR; PG8_MMA(0, 0, At, B0); PG8_MMA(0, 1, At, B1); PG8_BAR; PG8_SCHED;
            PG8_LDA(At, 0, 1); PG8_STAGE(PG8_SB(0, 0), b2, voffB); PG8_STAGE(PG8_SB(0, 1), b2 + hstep, voffB); PG8_STAGE(PG8_SA(0, 0), a2, voffA);
            PG8_WAIT_V(8); PG8_WAIT_L(0); PG8_BAR; PG8_MMA(1, 0, At, B0); PG8_MMA(1, 1, At, B1); PG8_BAR; PG8_SCHED;
            PG8_LDB(B0, 1, 0); PG8_LDB(B1, 1, 1); PG8_SCHED; PG8_LDA(At, 1, 0); PG8_STAGE(PG8_SA(0, 1), a2 + hstep, voffA);
            PG8_WAIT_V(8); PG8_WAIT_L(0); PG8_BAR; PG8_MMA(0, 0, At, B0); PG8_MMA(0, 1, At, B1); PG8_BAR; PG8_SCHED;
            PG8_LDA(At, 1, 1); PG8_STAGE(PG8_SB(1, 0), b3, voffB); PG8_STAGE(PG8_SB(1, 1), b3 + hstep, voffB); PG8_STAGE(PG8_SA(1, 0), a3, voffA);
            PG8_WAIT_V(8); PG8_WAIT_L(0); PG8_BAR; PG8_MMA(1, 0, At, B0); PG8_MMA(1, 1, At, B1); PG8_BAR; PG8_SCHED;
            } else {
            PG8_LDB(B0, 0, 0); PG8_SCHED; PG8_LDA(At, 0, 0); PG8_STAGE(PG8_SA(1, 1), a1 + hstep, voffA);
            PG8_WAIT_L(8); PG8_BAR; PG8_WAIT_L(0); PG8_MMA(0, 0, At, B0); PG8_BAR; PG8_SCHED;
            PG8_LDB(B1, 0, 1); PG8_STAGE(PG8_SB(0, 0), b2, voffB);
            PG8_BAR; PG8_WAIT_L(0); PG8_MMA(0, 1, At, B1); PG8_BAR;
            PG8_LDA(At, 0, 1); PG8_STAGE(PG8_SA(0, 0), a2, voffA);
            PG8_BAR; PG8_WAIT_L(0); PG8_MMA(1, 0, At, B0); PG8_BAR; PG8_SCHED;
            PG8_STAGE(PG8_SB(0, 1), b2 + hstep, voffB);
            PG8_WAIT_V(6); PG8_BAR; PG8_MMA(1, 1, At, B1); PG8_BAR;
            PG8_LDB(B0, 1, 0); PG8_SCHED; PG8_LDA(At, 1, 0); PG8_STAGE(PG8_SA(0, 1), a2 + hstep, voffA);
            PG8_WAIT_L(8); PG8_BAR; PG8_WAIT_L(0); PG8_MMA(0, 0, At, B0); PG8_BAR; PG8_SCHED;
            PG8_LDB(B1, 1, 1); PG8_STAGE(PG8_SB(1, 0), b3, voffB);
            PG8_BAR; PG8_WAIT_L(0); PG8_MMA(0, 1, At, B1); PG8_BAR;
            PG8_LDA(At, 1, 1); PG8_STAGE(PG8_SA(1, 0), a3, voffA);
            PG8_BAR; PG8_WAIT_L(0); PG8_MMA(1, 0, At, B0); PG8_BAR; PG8_SCHED;
            PG8_STAGE(PG8_SB(1, 1), b3 + hstep, voffB);
            PG8_WAIT_V(6); PG8_BAR; PG8_MMA(1, 1, At, B1); PG8_BAR;
            }
        }
        if constexpr (ALIGN_EPI) { if (wr == 0) PG8_BAR; }
        if constexpr (!Epi::AFTER_DRAIN) { E(acc, cur, wr, wc, fr, fq); S.done(cur); }
        if (!has_next) break;
#pragma unroll
        for (int a = 0; a < 2; ++a)
#pragma unroll
            for (int b = 0; b < 2; ++b)
#pragma unroll
                for (int m = 0; m < 4; ++m)
#pragma unroll
                    for (int n = 0; n < 2; ++n) acc[a][b][m][n] = (f32x4){0.f, 0.f, 0.f, 0.f};
        cur = nxt; cA = nA; cB = nB; ++ui;
        if constexpr (ALIGN_EPI) { if (wr == 1) PG8_BAR; }
    }
    PG8_WAIT_V(0);
    if constexpr (!ALIGN_EPI) { if (wr == 0) PG8_BAR; }
    PG8_BAR;
    if constexpr (Epi::AFTER_DRAIN) { E.fused(acc, cur, wr, wc, fr, fq, lds, wid, lane); S.done(cur); }
#undef PG8_SA
#undef PG8_SB
#undef PG8_STAGE
#undef PG8_LDA
#undef PG8_LDB
#undef PG8_MMA
#undef PG8_WAIT_V
#undef PG8_WAIT_L
#undef PG8_BAR
#undef PG8_SCHED
}
}
namespace att {
using bf16x8 = __attribute__((ext_vector_type(8))) short;
using s16x4  = __attribute__((ext_vector_type(4))) short;
using f32x16 = __attribute__((ext_vector_type(16))) float;
using u32x4  = __attribute__((ext_vector_type(4))) unsigned;
constexpr int DQK = 64, DV = 128, NW = 8, QBLK = 32, KVBLK = 64;
constexpr float SCALE = 0.125f;
constexpr float C2 = 0.125f * 1.4426950408889634f;
constexpr float THR2 = 11.5f;
constexpr int LDQ = 1024, LDK = 1024, LDO = 2048;
constexpr size_t SHM_V = KVBLK * DV * 2, SHM_K = KVBLK * DQK * 2, SHM_ATTN = 3 * SHM_V + 3 * SHM_K + NW * 64 * 4;
#define KSWZ64(row, ch) ((row) * 128 + ((((ch) ^ ((row) >> 1)) & 7) << 4))
#define SBAR() __builtin_amdgcn_sched_barrier(0)
__device__ __forceinline__ int crow(int r, int hi) { return (r & 3) + 8 * (r >> 2) + 4 * hi; }
__device__ __forceinline__ unsigned cvtpk(float lo, float hi) { unsigned r; asm volatile("v_cvt_pk_bf16_f32 %0, %1, %2" : "=v"(r) : "v"(lo), "v"(hi)); return r; }

#define MX3(a, b, c) __builtin_fmaxf(__builtin_fmaxf((a), (b)), (c))
__device__ __forceinline__ float rowmax32(const f32x16& p0, const f32x16& p1) {
  float a = MX3(p0[0], p0[1], p1[0]), b = MX3(p0[2], p0[3], p1[1]); a = MX3(a, p1[2], p1[3]);
#pragma unroll
  for (int r = 4; r < 16; r += 4) { a = MX3(a, p0[r], p0[r + 1]); b = MX3(b, p0[r + 2], p0[r + 3]); a = MX3(a, p1[r], p1[r + 1]); b = MX3(b, p1[r + 2], p1[r + 3]); }
  float m = __builtin_fmaxf(a, b);
  { auto rr = __builtin_amdgcn_permlane32_swap(__float_as_uint(m), __float_as_uint(m), false, false);
    m = __builtin_fmaxf(__uint_as_float(rr[0]), __uint_as_float(rr[1])); }
  return m;
}
template <bool FIRST, int VAR = 0> __device__ __forceinline__ void partialSM(f32x16& p0, f32x16& p1, float& m_ref, f32x16& negm, float& alpha) {
  const float pmax = rowmax32(p0, p1);
  alpha = 1.f;
  if (FIRST || __builtin_expect(__any(pmax > THR2), 0)) {
    const float d = FIRST ? pmax : __builtin_fmaxf(pmax, 0.f);
    m_ref += d;
#pragma unroll
    for (int r = 0; r < 16; ++r) { p0[r] -= d; p1[r] -= d; }
#pragma unroll
    for (int r = 0; r < 16; ++r) negm[r] = -m_ref;
    if (!FIRST) alpha = __builtin_amdgcn_exp2f(-d);
  }
#pragma unroll
  for (int r = 0; r < 16; ++r) p0[r] = (VAR == 1) ? p0[r] * 0.001f : __builtin_amdgcn_exp2f(p0[r]);
}
template <int VAR = 0> __device__ __forceinline__ void finishSM(f32x16& p0, f32x16& p1, bf16x8& pa0, bf16x8& pa1, bf16x8& pa2, bf16x8& pa3) {
#pragma unroll
  for (int r = 0; r < 16; ++r) p1[r] = (VAR == 1) ? p1[r] * 0.001f : __builtin_amdgcn_exp2f(p1[r]);
#define PK4(P, BASE, OUT) do { unsigned a0 = cvtpk(P[BASE + 0], P[BASE + 1]), a1 = cvtpk(P[BASE + 2], P[BASE + 3]);   \
    unsigned b0 = cvtpk(P[BASE + 4], P[BASE + 5]), b1 = cvtpk(P[BASE + 6], P[BASE + 7]);                              \
    auto r0 = __builtin_amdgcn_permlane32_swap(a0, b0, false, false); auto r1 = __builtin_amdgcn_permlane32_swap(a1, b1, false, false); \
    u32x4 w = {r0[0], r1[0], r0[1], r1[1]}; OUT = *reinterpret_cast<bf16x8*>(&w); } while (0)
  PK4(p0, 0, pa0); PK4(p0, 8, pa1); PK4(p1, 0, pa2); PK4(p1, 8, pa3);
#undef PK4
}
__device__ __forceinline__ void qkt(f32x16& p0, f32x16& p1, const char* Ks, const bf16x8* qr, const f32x16& negm, int r32, int hi) {
#pragma unroll
  for (int d0 = 0; d0 < 4; ++d0) { const int ch = d0 * 2 + hi;
    bf16x8 b0 = *reinterpret_cast<const bf16x8*>(Ks + KSWZ64(r32, ch));
    bf16x8 b1 = *reinterpret_cast<const bf16x8*>(Ks + KSWZ64(32 + r32, ch));
    if (d0 == 0) { p0 = __builtin_amdgcn_mfma_f32_32x32x16_bf16(b0, qr[0], negm, 0, 0, 0); p1 = __builtin_amdgcn_mfma_f32_32x32x16_bf16(b1, qr[0], negm, 0, 0, 0); }
    else { p0 = __builtin_amdgcn_mfma_f32_32x32x16_bf16(b0, qr[d0], p0, 0, 0, 0); p1 = __builtin_amdgcn_mfma_f32_32x32x16_bf16(b1, qr[d0], p1, 0, 0, 0); } }
}
__device__ __forceinline__ int v_st(int k, int c) { const int kk = (k & ~0xC) | ((k & 4) << 1) | ((k & 8) >> 1); return ((kk >> 3) * 4 + (c >> 5)) * 512 + ((kk & 7) * 32 + (c & 31)) * 2; }
__device__ __forceinline__ int v_rd_base(int lane) { return ((lane & 3) << 3) | (((lane >> 2) & 3) << 6) | (((lane >> 4) & 1) << 5) | (((lane >> 5) & 1) << 8); }
constexpr int v_rd_off(int d0, int ks, int half) { return d0 * 512 + ks * 4096 + half * 2048; }
template <int OFF> __device__ __forceinline__ s16x4 tr_read(int vb) {
  s16x4 r; asm volatile("ds_read_b64_tr_b16 %0, %1 offset:%2" : "=&v"(r) : "v"(vb), "i"(OFF) : "memory"); return r;
}
template <int D0> __device__ __forceinline__ void pv_one(f32x16& od, int vb, bf16x8 pa0, bf16x8 pa1, bf16x8 pa2, bf16x8 pa3) {
  const s16x4 l0 = tr_read<v_rd_off(D0, 0, 0)>(vb), h0 = tr_read<v_rd_off(D0, 0, 1)>(vb), l1 = tr_read<v_rd_off(D0, 1, 0)>(vb), h1 = tr_read<v_rd_off(D0, 1, 1)>(vb);
  const s16x4 l2 = tr_read<v_rd_off(D0, 2, 0)>(vb), h2 = tr_read<v_rd_off(D0, 2, 1)>(vb), l3 = tr_read<v_rd_off(D0, 3, 0)>(vb), h3 = tr_read<v_rd_off(D0, 3, 1)>(vb);
  asm volatile("s_waitcnt lgkmcnt(0)" ::: "memory"); SBAR();
#define PK(L, H) (bf16x8){L[0], L[1], L[2], L[3], H[0], H[1], H[2], H[3]}
  od = __builtin_amdgcn_mfma_f32_32x32x16_bf16(pa0, PK(l0, h0), od, 0, 0, 0);
  od = __builtin_amdgcn_mfma_f32_32x32x16_bf16(pa1, PK(l1, h1), od, 0, 0, 0);
  od = __builtin_amdgcn_mfma_f32_32x32x16_bf16(pa2, PK(l2, h2), od, 0, 0, 0);
  od = __builtin_amdgcn_mfma_f32_32x32x16_bf16(pa3, PK(l3, h3), od, 0, 0, 0);
#undef PK
}
__device__ __forceinline__ void pv_d0(f32x16* o, f32x16& lsum, int vb, bf16x8 pa0, bf16x8 pa1, bf16x8 pa2, bf16x8 pa3) {
  const bf16x8 ones = {0x3F80, 0x3F80, 0x3F80, 0x3F80, 0x3F80, 0x3F80, 0x3F80, 0x3F80};
  pv_one<0>(o[0], vb, pa0, pa1, pa2, pa3); pv_one<1>(o[1], vb, pa0, pa1, pa2, pa3);
  lsum = __builtin_amdgcn_mfma_f32_32x32x16_bf16(pa0, ones, lsum, 0, 0, 0); lsum = __builtin_amdgcn_mfma_f32_32x32x16_bf16(pa1, ones, lsum, 0, 0, 0);
  pv_one<2>(o[2], vb, pa0, pa1, pa2, pa3); pv_one<3>(o[3], vb, pa0, pa1, pa2, pa3);
  lsum = __builtin_amdgcn_mfma_f32_32x32x16_bf16(pa2, ones, lsum, 0, 0, 0); lsum = __builtin_amdgcn_mfma_f32_32x32x16_bf16(pa3, ones, lsum, 0, 0, 0);
}
template <int VAR = 0> __device__ __forceinline__ void attn_unit(const unsigned short* __restrict__ Qb, const unsigned short* __restrict__ Kh, const unsigned short* __restrict__ Vh,
                                          float* __restrict__ Ob, int seq, char* lds) {
  int tid_ = threadIdx.x; asm volatile("" : "+v"(tid_));
  const int tid = tid_, wid = tid >> 6, lane = tid & 63, r32 = lane & 31, hi = lane >> 5;
  char* V_lds = lds; char* K_lds = lds + 3 * SHM_V;
  float* ws = (float*)(lds + 3 * SHM_V + 3 * SHM_K) + wid * 64; float* al_l = ws + 32;
  float m_ref = 0.f; f32x16 o[4] = {}; f32x16 lsum = {}; f32x16 negm = {}; bf16x8 qr[4];
  const unsigned short* Qw = Qb + (long)(wid * QBLK + r32) * LDQ + hi * 8;
#pragma unroll
  for (int d0 = 0; d0 < 4; ++d0) qr[d0] = *reinterpret_cast<const bf16x8*>(Qw + d0 * 16);
  const int vb0 = (int)(uintptr_t)V_lds + v_rd_base(lane);
  int koff, voff0, voff1;
  { const int row = 8 * wid + (lane >> 3), ch = (lane & 7) ^ ((row >> 1) & 7); koff = row * LDK + ch * 8; }
  { const int blk = 4 * wid + (lane >> 5), kk = (blk >> 2) * 8 + ((lane >> 2) & 7), k = (kk & ~0xC) | ((kk & 4) << 1) | ((kk & 8) >> 1); voff0 = k * LDK + (blk & 3) * 32 + (lane & 3) * 8; }
  { const int blk = 4 * wid + 2 + (lane >> 5), kk = (blk >> 2) * 8 + ((lane >> 2) & 7), k = (kk & ~0xC) | ((kk & 4) << 1) | ((kk & 8) >> 1); voff1 = k * LDK + (blk & 3) * 32 + (lane & 3) * 8; }
  typedef __attribute__((address_space(3))) unsigned ldsu32;
  const unsigned widu = (unsigned)__builtin_amdgcn_readfirstlane(wid);
  const unsigned ldsK = (unsigned)(uintptr_t)K_lds + widu * 1024u, ldsV = (unsigned)(uintptr_t)V_lds + widu * 2048u;
#define SDMA(b, k0) do { if (VAR != 4) { \
    __builtin_amdgcn_global_load_lds((const unsigned*)(Kh + (long)(k0) * LDK + koff), (ldsu32*)(uintptr_t)(ldsK + (b) * (unsigned)SHM_K), 16, 0, 0); \
    __builtin_amdgcn_global_load_lds((const unsigned*)(Vh + (long)(k0) * LDK + voff0), (ldsu32*)(uintptr_t)(ldsV + (b) * (unsigned)SHM_V), 16, 0, 0); \
    __builtin_amdgcn_global_load_lds((const unsigned*)(Vh + (long)(k0) * LDK + voff1), (ldsu32*)(uintptr_t)(ldsV + (b) * (unsigned)SHM_V + 1024u), 16, 0, 0); } } while (0)
#define SWAIT() asm volatile("s_waitcnt vmcnt(0)" ::: "memory")
#define RESC(a) do { if (__any((a) < 1.f)) { if (hi == 0) al_l[r32] = (a); asm volatile("s_waitcnt lgkmcnt(0)" ::: "memory"); \
    _Pragma("unroll") for (int r = 0; r < 16; ++r) { const float f_ = al_l[crow(r, hi)]; o[0][r] *= f_; o[1][r] *= f_; o[2][r] *= f_; o[3][r] *= f_; lsum[r] *= f_; } } } while (0)
  f32x16 pA0, pA1, pB0, pB1; float alA, alB; bf16x8 pa0, pa1, pa2, pa3; const int NT = seq / KVBLK;
  SDMA(0, 0); SWAIT(); __syncthreads();
  if (VAR != 3) qkt(pA0, pA1, K_lds, qr, negm, r32, hi); partialSM<true, VAR>(pA0, pA1, m_ref, negm, alA);
  SDMA(1, KVBLK);
  SWAIT(); __syncthreads();
  int bp = 0, bc = 1, bn = 2;
#define ROT3() do { const int t_ = bp; bp = bc; bc = bn; bn = t_; } while (0)
  for (int j = 1; j + 1 < NT; j += 2) {
    SDMA(bn, (j + 1) * KVBLK);
    SBAR(); if (VAR != 3) qkt(pB0, pB1, K_lds + bc * SHM_K, qr, negm, r32, hi);
    finishSM<VAR>(pA0, pA1, pa0, pa1, pa2, pa3); SBAR();
    if (VAR != 2) pv_d0(o, lsum, vb0 + bp * (int)SHM_V, pa0, pa1, pa2, pa3); partialSM<false, VAR>(pB0, pB1, m_ref, negm, alB);
    RESC(alB); SWAIT(); __syncthreads(); ROT3();
    SDMA(bn, (j + 2) * KVBLK);
    SBAR(); if (VAR != 3) qkt(pA0, pA1, K_lds + bc * SHM_K, qr, negm, r32, hi);
    finishSM<VAR>(pB0, pB1, pa0, pa1, pa2, pa3); SBAR();
    if (VAR != 2) pv_d0(o, lsum, vb0 + bp * (int)SHM_V, pa0, pa1, pa2, pa3); partialSM<false, VAR>(pA0, pA1, m_ref, negm, alA);
    RESC(alA); SWAIT(); __syncthreads(); ROT3();
  }
  SBAR(); if (VAR != 3) qkt(pB0, pB1, K_lds + bc * SHM_K, qr, negm, r32, hi);
  finishSM<VAR>(pA0, pA1, pa0, pa1, pa2, pa3); SBAR();
  if (VAR != 2) pv_d0(o, lsum, vb0 + bp * (int)SHM_V, pa0, pa1, pa2, pa3); partialSM<false, VAR>(pB0, pB1, m_ref, negm, alB);
  RESC(alB);
  finishSM<VAR>(pB0, pB1, pa0, pa1, pa2, pa3); SBAR();
  if (VAR != 2) pv_d0(o, lsum, vb0 + bc * (int)SHM_V, pa0, pa1, pa2, pa3);
#undef ROT3
  float rli[16];
#pragma unroll
  for (int r = 0; r < 16; ++r) rli[r] = __builtin_amdgcn_rcpf(lsum[r]);
  float* Ow = Ob + (long)(wid * QBLK) * LDO;
#pragma unroll
  for (int r = 0; r < 16; ++r) { const int orow = crow(r, hi);
#pragma unroll
    for (int d0 = 0; d0 < 4; ++d0) Ow[(long)orow * LDO + d0 * 32 + r32] = o[d0][r] * rli[r]; }
  __syncthreads();
#undef SDMA
#undef SWAIT
#undef RESC
}
#undef SBAR
#undef MX3
}
constexpr int NWAVES = 8, NTHR = 512;
constexpr int DM = 2048, SEQ = 8192, CTXL = 256, MROWS = SEQ + CTXL  , NKEYS = SEQ + CTXL;
constexpr int HYW = 1024, INCOLS = 10240, NMOD = 6 * DM;
constexpr float EPS = 1e-6f;
constexpr int NEXP = 16384;
constexpr size_t MiB = 1u << 20;
constexpr size_t WS_CTL = 0, CTL_ZERO_BYTES = 64 * 1024;
constexpr size_t WS_MODP = 1 * MiB;
constexpr size_t WS_WIN = 2 * MiB;
constexpr size_t WS_WHY = 42 * MiB, WS_WDA = 46 * MiB;
constexpr size_t WS_WO = 50 * MiB, WS_WQ = 58 * MiB;
constexpr size_t WS_UB = 66 * MiB, WS_VB = 130 * MiB;
constexpr size_t WS_USC = 98 * MiB, WS_VSC = 162 * MiB;
constexpr size_t WS_TAPF = 194 * MiB, WS_TAPB = 226 * MiB;
constexpr size_t WS_MB = 194 * MiB;
constexpr size_t WS_HB = 226 * MiB;
constexpr size_t WS_U = 258 * MiB;
constexpr size_t WS_Q2 = 258 * MiB, WS_K2 = 274 * MiB;
constexpr size_t WS_YHY = 258 * MiB, WS_YDA = 274 * MiB;
constexpr size_t WS_PHY = 291 * MiB;
constexpr size_t WS_QRAW = 339 * MiB;
constexpr size_t WS_KRAW = 355 * MiB + 512 * 1024;
constexpr size_t WS_O = 291 * MiB;
constexpr size_t WS_MIX = 291 * MiB;
constexpr size_t WS_YCT = 355 * MiB + 512 * 1024;
constexpr size_t WS_V2 = 372 * MiB;
constexpr size_t WS_GATES = 388 * MiB + 512 * 1024;
constexpr size_t WS_X0 = 452 * MiB + 512 * 1024;
constexpr size_t WS_UHT = 468 * MiB + 512 * 1024;
constexpr size_t WS_QP = 356 * MiB;
constexpr size_t WS_IDX = 420 * MiB, WS_GW = 424 * MiB;
constexpr size_t WS_PD = 258 * MiB;
constexpr size_t WS_OPRE = 290 * MiB;
constexpr size_t WS_WGT = 432 * MiB;
constexpr size_t WS_SSP = 354 * MiB;
constexpr size_t WS_KSPEC = 485 * MiB;
constexpr size_t WS_UCTX = 520 * MiB;
constexpr size_t WS_END = 522 * MiB;
static_assert(WS_UHT + (size_t)1024 * 8192 * 2 <= WS_KSPEC && WS_KSPEC + (size_t)256 * 8320 * 16 <= WS_END && WS_GW + (size_t)8192 * 128 * 4 <= WS_GATES + 64 * MiB, "ws map");

constexpr int LDS_BYTES = 147456;
constexpr int MISC_OFF = 147456 - 256;

#define GAS __attribute__((address_space(1)))
#define LAS __attribute__((address_space(3)))
typedef unsigned short bf16;
typedef unsigned v4u __attribute__((ext_vector_type(4)));
typedef unsigned v2u __attribute__((ext_vector_type(2)));
typedef float f32x4 __attribute__((ext_vector_type(4)));
typedef GAS unsigned gu32;
#define RLX_AGENT __ATOMIC_RELAXED, __HIP_MEMORY_SCOPE_AGENT
#define LDS_WAIT() asm volatile("s_waitcnt lgkmcnt(0)" ::: "memory")
#define VM_WAIT() asm volatile("s_waitcnt vmcnt(0)" ::: "memory")
__device__ __forceinline__ unsigned f2bf(float f) { unsigned u = __builtin_bit_cast(unsigned, f); return (u + 0x7fffu + ((u >> 16) & 1u)) >> 16; }
__device__ __forceinline__ unsigned pk2(float lo, float hi) { return f2bf(lo) | (f2bf(hi) << 16); }
__device__ __forceinline__ float bf2f(unsigned short b) { return __builtin_bit_cast(float, (unsigned)b << 16); }
__device__ __forceinline__ float blo(unsigned w) { return __builtin_bit_cast(float, w << 16); }
__device__ __forceinline__ float bhi(unsigned w) { return __builtin_bit_cast(float, w & 0xffff0000u); }
__device__ __forceinline__ float fsin(float x) { return __builtin_amdgcn_sinf(x * 0.15915494309189535f); }
__device__ __forceinline__ float fcos(float x) { return __builtin_amdgcn_cosf(x * 0.15915494309189535f); }
__device__ __forceinline__ float wave_sum(float v) {
#pragma unroll
    for (int o = 1; o < 64; o <<= 1) v += __shfl_xor(v, o);
    return v;
}
__device__ __forceinline__ float wave_max(float v) {
#pragma unroll
    for (int o = 1; o < 64; o <<= 1) v = fmaxf(v, __shfl_xor(v, o));
    return v;
}
#define XB_TMO      128
#define XB_XCNT(j)  (256  + 64 * (j))
#define XB_XSUB(j)  (1280 + 64 * (j))
#define XB_XGEN(j)  (2304 + 64 * (j))
#define XB_TOP      3328
#define XB_TOPGEN   3392
#define XCD_BAR_WORDS 3456
#define XB_SPIN_CAP (1u << 24)

__device__ __forceinline__ unsigned xb_ld(unsigned* p)              { return __hip_atomic_load(p, __ATOMIC_RELAXED, __HIP_MEMORY_SCOPE_AGENT); }
__device__ __forceinline__ unsigned xb_add(unsigned* p, unsigned v) { return __hip_atomic_fetch_add(p, v, __ATOMIC_RELAXED, __HIP_MEMORY_SCOPE_AGENT); }
__device__ __forceinline__ unsigned xb_xcc_id() { return (unsigned)__builtin_amdgcn_s_getreg((3 << 11) | 20) & 0xFu; }
#define XB_SPIN(cond, bar) do { unsigned _sp = 0; while (cond) { __builtin_amdgcn_s_sleep(1); \
    if ((++_sp & 255u) == 0u) { if (xb_ld(&(bar)[XB_TMO])) break; if (_sp > XB_SPIN_CAP) { atomicAdd(&(bar)[XB_TMO], 1u); break; } } } } while (0)

struct XcdBarrier {
    unsigned* bar; unsigned x;
    volatile LAS unsigned* st;
};

__device__ __forceinline__ XcdBarrier xcd_barrier_post(unsigned* bar, volatile LAS unsigned* st) {
    XcdBarrier b; b.bar = bar; b.x = xb_xcc_id(); b.st = st;
    if (threadIdx.x == 0) (void)xb_add(&bar[XB_XCNT(b.x)], 1u);
    return b;
}
__device__ __forceinline__ void xcd_barrier_complete(unsigned* bar, unsigned x, unsigned& nloc, unsigned& nx) {
    const unsigned G = gridDim.x * gridDim.y * gridDim.z;
    unsigned sum, cnt, mine, sp = 0u;
    for (;;) {
        sum = 0u; cnt = 0u; mine = 0u;
#pragma unroll
        for (unsigned j = 0; j < 16; ++j) { const unsigned c = xb_ld(&bar[XB_XCNT(j)]); sum += c; cnt += (c > 0u) ? 1u : 0u; mine = (j == x) ? c : mine; }
        if (sum == G) break;
        __builtin_amdgcn_s_sleep(1);
        if ((++sp & 255u) == 0u) { if (xb_ld(&bar[XB_TMO])) break; if (sp > XB_SPIN_CAP) { atomicAdd(&bar[XB_TMO], 1u); break; } }
    }
    nloc = mine > 0u ? mine : 1u; nx = cnt > 0u ? cnt : 1u;
}

__device__ __forceinline__ void xcd_barrier(const XcdBarrier& b) {
    asm volatile("s_waitcnt vmcnt(0)" ::: "memory");
    __syncthreads();
    if (threadIdx.x == 0) {
        unsigned* bar = b.bar;
        __builtin_amdgcn_s_waitcnt(0);
        unsigned nloc = b.st[0], nx = b.st[1];
        if (nloc == 0u) { xcd_barrier_complete(bar, b.x, nloc, nx); b.st[0] = nloc; b.st[1] = nx; }
        const unsigned old = xb_add(&bar[XB_XSUB(b.x)], 1u);
        const unsigned gen = old / nloc;
        if (old + 1u == (gen + 1u) * nloc) {
            __builtin_amdgcn_fence(__ATOMIC_RELEASE, "agent");
            asm volatile("s_waitcnt vmcnt(0)" ::: "memory");
            const unsigned og = xb_add(&bar[XB_TOP], 1u);
            const unsigned tg = og / nx;
            if (og + 1u == (tg + 1u) * nx) xb_add(&bar[XB_TOPGEN], 1u);
            else XB_SPIN(xb_ld(&bar[XB_TOPGEN]) == tg, bar);
            __builtin_amdgcn_fence(__ATOMIC_ACQUIRE, "agent");
            xb_add(&bar[XB_XGEN(b.x)], 1u);
            asm volatile("s_waitcnt vmcnt(0)" ::: "memory");
        } else {
            XB_SPIN(xb_ld(&bar[XB_XGEN(b.x)]) == gen, bar);
            __builtin_amdgcn_fence(__ATOMIC_ACQUIRE, "agent");
            asm volatile("s_waitcnt vmcnt(0)" ::: "memory");
        }
    }
    __syncthreads();
}
struct Args { const float* in[31]; float* out; unsigned char* ws; int ph_lo, ph_hi, li, pad; };
struct Frame {
    LAS unsigned char* lds; char* ldsg;
    int tid, lane, wave, vcu, G, gw, NGW;
    float* out; unsigned char* ws;
};
__device__ __forceinline__ const float* modp(const Frame& F) { return (const float*)(F.ws + WS_MODP); }
__device__ __forceinline__ f32x4 mod4(const Args& A, const Frame& F, int which, int i) {
    const float* p = modp(F) + which * NMOD + i; f32x4 v = *(const f32x4*)(A.in[5] + i);
#pragma unroll
    for (int kc = 0; kc < 4; ++kc) v += *(const f32x4*)(p + kc * 2 * NMOD);
    return v;
}
__device__ __forceinline__ float silu(float x) { return x / (1.f + __expf(-x)); }

__device__ __forceinline__ void p0_transpose_pair(const float* Wa, bf16* WTa, int ita, const float* Wb, bf16* WTb, int itb, int K, int N, bool two, LAS float* scr, int lane) {
    const int kka = lane >> 3, nl = (lane & 7) * 4, nb = N / 32;
    const int k0a = 64 * (ita / nb), n0a = 32 * (ita % nb), k0b = 64 * (itb / nb), n0b = 32 * (itb % nb);
    f32x4 va[8], vb_[8];
#pragma unroll
    for (int i = 0; i < 8; ++i) va[i] = *(const f32x4*)(Wa + (size_t)(k0a + 8 * i + kka) * N + n0a + nl);
    if (two) {
#pragma unroll
        for (int i = 0; i < 8; ++i) vb_[i] = *(const f32x4*)(Wb + (size_t)(k0b + 8 * i + kka) * N + n0b + nl); }
#pragma unroll
    for (int i = 0; i < 8; ++i) { LAS float* s = scr + (8 * i + kka) * 33 + nl; s[0] = va[i][0]; s[1] = va[i][1]; s[2] = va[i][2]; s[3] = va[i][3]; }
    if (two) {
#pragma unroll
        for (int i = 0; i < 8; ++i) { LAS float* s = scr + 2176 + (8 * i + kka) * 33 + nl; s[0] = vb_[i][0]; s[1] = vb_[i][1]; s[2] = vb_[i][2]; s[3] = vb_[i][3]; } }
    LDS_WAIT(); asm volatile("" ::: "memory");
    const int c = lane & 7;
#pragma unroll
    for (int j = 0; j < 4; ++j) { const int n = (lane >> 3) + 8 * j; const LAS float* s = scr + (8 * c) * 33 + n;
        v4u o; o.x = pk2(s[0 * 33], s[1 * 33]); o.y = pk2(s[2 * 33], s[3 * 33]); o.z = pk2(s[4 * 33], s[5 * 33]); o.w = pk2(s[6 * 33], s[7 * 33]);
        *(GAS v4u*)(WTa + (size_t)(n0a + n) * K + k0a + 8 * c) = o; }
    if (two) {
#pragma unroll
        for (int j = 0; j < 4; ++j) { const int n = (lane >> 3) + 8 * j; const LAS float* s = scr + 2176 + (8 * c) * 33 + n;
            v4u o; o.x = pk2(s[0 * 33], s[1 * 33]); o.y = pk2(s[2 * 33], s[3 * 33]); o.z = pk2(s[4 * 33], s[5 * 33]); o.w = pk2(s[6 * 33], s[7 * 33]);
            *(GAS v4u*)(WTb + (size_t)(n0b + n) * K + k0b + 8 * c) = o; } }
    LDS_WAIT(); asm volatile("" ::: "memory");
}
__device__ __forceinline__ void p0_filter_item(const Args& A, Frame& F, int pb) {
    LAS float* zb = (LAS float*)F.lds;
    LAS float* hA = zb + 64 * 36;
    LAS float* hB = hA + 64 * 68;
    LAS float* tl = hB + 64 * 68 + F.wave * (64 * 33);
    const int l0 = pb * 64, tid = F.tid;
    const float* w1 = A.in[13]; const float* b1 = A.in[14]; const float* w2 = A.in[15]; const float* b2 = A.in[16];
    const float* w3 = A.in[17]; const float* b3 = A.in[18]; const float* wout = A.in[19]; const float* freq = A.in[20];
    for (int idx = tid; idx < 64 * 33; idx += NTHR) { const int pos = idx / 33, f = idx % 33; const int l = l0 + pos;
        const float w = 6.283185307179586f * (float)l / 8192.f; float v;
        if (f == 0) v = (float)l / 8191.f;
        else { const int j = (f - 1) & 15; const float band = 1e-4f + (float)j * ((15.f - 1e-4f) / 15.f); const float a = band * w; v = (f <= 16) ? fcos(a) : -fsin(a); }
        zb[pos * 36 + f] = v; }
    __syncthreads();
    const int j = tid & 63, pg = tid >> 6;
    { float acc[8]; const float bj = b1[j], fj = freq[j];
#pragma unroll
      for (int i = 0; i < 8; ++i) acc[i] = bj;
      for (int k = 0; k < 33; ++k) { const float w = w1[k * 64 + j];
#pragma unroll
        for (int i = 0; i < 8; ++i) acc[i] += zb[(pg * 8 + i) * 36 + k] * w; }
#pragma unroll
      for (int i = 0; i < 8; ++i) hA[(pg * 8 + i) * 68 + j] = fsin(fj * acc[i]); }
    __syncthreads();
    { float acc[8]; const float bj = b2[j], fj = freq[j];
#pragma unroll
      for (int i = 0; i < 8; ++i) acc[i] = bj;
      for (int k = 0; k < 64; ++k) { const float w = w2[k * 64 + j];
#pragma unroll
        for (int i = 0; i < 8; ++i) acc[i] += hA[(pg * 8 + i) * 68 + k] * w; }
#pragma unroll
      for (int i = 0; i < 8; ++i) hB[(pg * 8 + i) * 68 + j] = fsin(fj * acc[i]); }
    __syncthreads();
    { float acc[8]; const float bj = b3[j], fj = freq[j];
#pragma unroll
      for (int i = 0; i < 8; ++i) acc[i] = bj;
      for (int k = 0; k < 64; ++k) { const float w = w3[k * 64 + j];
#pragma unroll
        for (int i = 0; i < 8; ++i) acc[i] += hB[(pg * 8 + i) * 68 + k] * w; }
      __syncthreads();
#pragma unroll
      for (int i = 0; i < 8; ++i) hA[j * 68 + pg * 8 + i] = fsin(fj * acc[i]); }
    __syncthreads();
    const int lane = F.lane;
    float* tapF = (float*)(F.ws + WS_TAPF); float* tapB = (float*)(F.ws + WS_TAPB);
    for (int ch = 0; ch < 4; ++ch) {
        const int c0 = F.wave * 256 + ch * 64, col = c0 + lane, chan = col & 1023;
        float wr[64];
#pragma unroll
        for (int k = 0; k < 64; ++k) wr[k] = wout[k * 2048 + col];
        const float delta = fabsf(-3.0701134573253945f + (-15.350567286626973f + 3.0701134573253945f) * ((float)chan / 1023.f));
        float* dst = ((col < 1024) ? tapF : tapB) ;
        for (int lh = 0; lh < 2; ++lh) {
#pragma unroll 1
            for (int g = 0; g < 8; ++g) { typedef float f32x2 __attribute__((ext_vector_type(2)));
                const LAS float* hr = hA + lh * 32 + 4 * g; f32x2 a01 = {0.f, 0.f}, a23 = {0.f, 0.f};
#pragma unroll
                for (int kb = 0; kb < 64; kb += 8) {
#pragma unroll
                    for (int k = kb; k < kb + 8; ++k) { const f32x4 h4 = *(const LAS f32x4*)(hr + k * 68); const f32x2 w2 = {wr[k], wr[k]};
                        a01 = (f32x2){h4[0], h4[1]} * w2 + a01; a23 = (f32x2){h4[2], h4[3]} * w2 + a23; }
                    __builtin_amdgcn_sched_barrier(0); }
                const float av[4] = {a01[0], a01[1], a23[0], a23[1]};
#pragma unroll
                for (int e = 0; e < 4; ++e) { const int l = 4 * g + e; const float t = (float)(l0 + lh * 32 + l) / 8191.f;
                    tl[lane * 33 + l] = av[e] * (__expf(-t * delta) + 0.05f); } }
            LDS_WAIT(); asm volatile("" ::: "memory");
#pragma unroll 4
            for (int cc = 0; cc < 32; ++cc) { const int c = 2 * cc + (lane >> 5), l = lane & 31;
                const int chn = (c0 + c) & 1023;
                dst[(size_t)chn * 8192 + l0 + lh * 32 + l] = tl[c * 33 + l]; }
            LDS_WAIT(); asm volatile("" ::: "memory");
        }
    }
    __syncthreads();
}
#ifdef P0_MASK
#define P0REP(s) _Pragma("unroll 1") for (int rep_ = 0; rep_ <= ((P0_MASK >> (s)) & 1); ++rep_)
#define P3REP(s) _Pragma("unroll 1") for (int rep3_ = 0; rep3_ <= ((P0_MASK >> (s)) & 1); ++rep3_)
#else
#define P0REP(s)
#define P3REP(s)
#endif
__device__ __forceinline__ void p0_prologue(const Args& A, Frame& F) {
    P0REP(0) if ((int)blockIdx.x < 128) p0_filter_item(A, F, (int)blockIdx.x);
    P0REP(1) { const float* wm = A.in[4]; const float* c = A.in[1]; const float* cc = A.in[3]; float* mp = (float*)(F.ws + WS_MODP);
      LAS float* sl = (LAS float*)F.lds;
      for (int k = F.tid; k < DM; k += NTHR) { sl[k] = silu(c[k]); sl[DM + k] = silu(cc[k]); }
      __syncthreads();
      const int cl = F.lane & 7, rl = F.lane >> 3;
      for (int it = F.gw; it < 384 * 4; it += F.NGW) { const int cg = it % 384, kc = it / 384;
          f32x4 al = {0.f, 0.f, 0.f, 0.f}, ac = {0.f, 0.f, 0.f, 0.f};
#pragma unroll
          for (int h = 0; h < 2; ++h) { f32x4 w[32];
#pragma unroll
              for (int i = 0; i < 32; ++i) w[i] = *(const f32x4*)(wm + (size_t)(kc * 512 + rl + 8 * (32 * h + i)) * NMOD + cg * 32 + cl * 4);
#pragma unroll
              for (int i = 0; i < 32; ++i) { const int k = kc * 512 + rl + 8 * (32 * h + i); al += w[i] * sl[k]; ac += w[i] * sl[DM + k]; } }
#pragma unroll
          for (int o = 8; o < 64; o <<= 1) {
#pragma unroll
              for (int e = 0; e < 4; ++e) { al[e] += __shfl_xor(al[e], o); ac[e] += __shfl_xor(ac[e], o); } }
          if (rl == 0) { *(f32x4*)(mp + (kc * 2 + 0) * NMOD + cg * 32 + cl * 4) = al; *(f32x4*)(mp + (kc * 2 + 1) * NMOD + cg * 32 + cl * 4) = ac; } }
      __syncthreads(); }
    P0REP(2) { LAS float* scr = (LAS float*)(F.lds + F.wave * 17408);
      constexpr int I_IN = (DM / 64) * (INCOLS / 32), I_HY = (HYW / 64) * (DM / 32), I_O = (DM / 64) * (DM / 32);
      for (int it = F.gw; it < I_IN; it += 2 * F.NGW) { const bool two = it + F.NGW < I_IN;
          p0_transpose_pair(A.in[10], (bf16*)(F.ws + WS_WIN), it, A.in[10], (bf16*)(F.ws + WS_WIN), two ? it + F.NGW : it, DM, INCOLS, two, scr, F.lane); }
      for (int it = F.gw; it < I_O; it += F.NGW)
          p0_transpose_pair(A.in[26], (bf16*)(F.ws + WS_WO), it, A.in[27], (bf16*)(F.ws + WS_WQ), it, DM, DM, true, scr, F.lane);
      for (int it = F.gw; it < 2 * I_HY; it += F.NGW) { const bool da = it >= I_HY; const int r = da ? it - I_HY : it;
          const float* W = da ? A.in[25] : A.in[24]; bf16* WT = (bf16*)(F.ws + (da ? WS_WDA : WS_WHY));
          p0_transpose_pair(W, WT, r, W, WT, r, HYW, DM, false, scr, F.lane); } }
    P0REP(3) {
      const int bx = (int)blockIdx.x; const bool bal = (F.G == 256);
      const int rbase = bal ? (bx < 128 ? bx * 112 : 14336 + (bx - 128) * 144) : 0, rcnt = bal ? (bx < 128 ? 112 : 144) : 2 * NEXP;
      const int rstart = bal ? F.wave : F.gw, rstep = bal ? NWAVES : F.NGW;
      for (int ri = rstart; ri < rcnt; ri += 2 * rstep) {
          const int rowa = rbase + ri, rowb = (ri + rstep < rcnt) ? rowa + rstep : rowa; const bool two = rowb != rowa;
          const bool ua = rowa < NEXP, ub_ = rowb < NEXP; const int ra = ua ? rowa : rowa - NEXP, rb = ub_ ? rowb : rowb - NEXP;
          const float* sa = (ua ? A.in[29] : A.in[30]) + (size_t)ra * DM + 16 * F.lane; const float* sb = (ub_ ? A.in[29] : A.in[30]) + (size_t)rb * DM + 16 * F.lane;
          f32x4 xa[8], xb[8];
#pragma unroll
          for (int i = 0; i < 8; ++i) xa[i] = *(const f32x4*)(sa + 1024 * (i >> 2) + 4 * (i & 3));
#pragma unroll
          for (int i = 0; i < 8; ++i) xb[i] = *(const f32x4*)(sb + 1024 * (i >> 2) + 4 * (i & 3));
          float ma = 0.f, mb = 0.f;
#pragma unroll
          for (int i = 0; i < 8; ++i) { ma = fmaxf(ma, fmaxf(fmaxf(fabsf(xa[i][0]), fabsf(xa[i][1])), fmaxf(fabsf(xa[i][2]), fabsf(xa[i][3]))));
              mb = fmaxf(mb, fmaxf(fmaxf(fabsf(xb[i][0]), fabsf(xb[i][1])), fmaxf(fabsf(xb[i][2]), fabsf(xb[i][3])))); }
#pragma unroll
          for (int o = 1; o < 64; o <<= 1) { ma = fmaxf(ma, __shfl_xor(ma, o)); mb = fmaxf(mb, __shfl_xor(mb, o)); }
          const float sca = (ma > 0.f) ? 384.f / ma : 1.f, scb = (mb > 0.f) ? 384.f / mb : 1.f;
          unsigned char* da = F.ws + (ua ? WS_UB : WS_VB) + (size_t)(F.lane >> 4) * ((size_t)NEXP * 256) + (size_t)ra * 256 + 16 * (F.lane & 15);
          unsigned char* db = F.ws + (ub_ ? WS_UB : WS_VB) + (size_t)(F.lane >> 4) * ((size_t)NEXP * 256) + (size_t)rb * 256 + 16 * (F.lane & 15);
#pragma unroll
          for (int q = 0; q < 2; ++q) { v4u o;
#pragma unroll
              for (int e = 0; e < 4; ++e) { const f32x4 t = xa[4 * q + e] * sca; int w = 0;
                  w = __builtin_amdgcn_cvt_pk_fp8_f32(t[0], t[1], w, false); w = __builtin_amdgcn_cvt_pk_fp8_f32(t[2], t[3], w, true); o[e] = (unsigned)w; }
              *(v4u*)(da + (size_t)(4 * q) * ((size_t)NEXP * 256)) = o; }
          if (F.lane == 0) ((float*)(F.ws + (ua ? WS_USC : WS_VSC)))[ra] = 1.f / sca;
          if (two) {
#pragma unroll
              for (int q = 0; q < 2; ++q) { v4u o;
#pragma unroll
                  for (int e = 0; e < 4; ++e) { const f32x4 t = xb[4 * q + e] * scb; int w = 0;
                      w = __builtin_amdgcn_cvt_pk_fp8_f32(t[0], t[1], w, false); w = __builtin_amdgcn_cvt_pk_fp8_f32(t[2], t[3], w, true); o[e] = (unsigned)w; }
                  *(v4u*)(db + (size_t)(4 * q) * ((size_t)NEXP * 256)) = o; }
              if (F.lane == 0) ((float*)(F.ws + (ub_ ? WS_USC : WS_VSC)))[rb] = 1.f / scb; } } }

}

__device__ __forceinline__ void p1_rows(const Args& A, Frame& F) {
    bf16* U = (bf16*)(F.ws + WS_U); const float* gn = A.in[6];
#pragma unroll 1
    for (int which = 0; which < 2; ++which) {
        const int r0 = which ? SEQ : 0, r1 = which ? MROWS : SEQ; const float* src = which ? A.in[2] : A.in[0];
        int r = r0 + F.gw; if (r >= r1) continue;
        f32x4 a[8], b[8];
#pragma unroll
        for (int j = 0; j < 8; ++j) { const int col = 4 * F.lane + 256 * j; const f32x4 g = *(const f32x4*)(gn + col);
            a[j] = g * (mod4(A, F, which, 1 * DM + col) + 1.f); b[j] = mod4(A, F, which, 0 * DM + col); }
        for (; r < r1; r += F.NGW) {
            const f32x4* xr = (const f32x4*)(src + (size_t)(r - r0) * DM) + F.lane; f32x4 v[8]; float s = 0.f;
#pragma unroll
            for (int j = 0; j < 8; ++j) { v[j] = xr[64 * j]; s += (v[j][0] * v[j][0] + v[j][1] * v[j][1]) + (v[j][2] * v[j][2] + v[j][3] * v[j][3]); }
            const float rstd = rsqrtf(wave_sum(s) * (1.f / DM) + EPS);
            unsigned long long* o8 = (unsigned long long*)(U + (size_t)r * DM) + F.lane;
#pragma unroll
            for (int j = 0; j < 8; ++j) { const f32x4 y = v[j] * rstd * a[j] + b[j];
                o8[64 * j] = (unsigned long long)pk2(y[0], y[1]) | ((unsigned long long)pk2(y[2], y[3]) << 32); }
        }
    }
}

__device__ __forceinline__ void p2_ctx_unit(Frame& F) {
    typedef short s16x8 __attribute__((ext_vector_type(8))); typedef float f32x16 __attribute__((ext_vector_type(16)));
    const bf16* U = (const bf16*)(F.ws + WS_U) + (size_t)SEQ * DM; const bf16* W = (const bf16*)(F.ws + WS_WIN);
    LAS float* part = (LAS float*)F.lds;
#pragma unroll 1
    for (int unit = F.vcu; unit < 256; unit += F.G) {
        const int rb = unit >> 5, cb = unit & 31, l31 = F.lane & 31, hi = F.lane >> 5, k0 = 256 * F.wave + 8 * hi;
        const bf16* ap = U + (size_t)(32 * rb + l31) * DM + k0;
        const bf16* bp0 = W + (size_t)(4096 + 64 * cb + l31) * DM + k0; const bf16* bp1 = bp0 + (size_t)32 * DM;
        f32x16 c0, c1;
#pragma unroll
        for (int r = 0; r < 16; ++r) { c0[r] = 0.f; c1[r] = 0.f; }
#pragma unroll
        for (int h = 0; h < 2; ++h) { s16x8 a[8], b0[8], b1[8];
#pragma unroll
            for (int s = 0; s < 8; ++s) { const int ko = 16 * (8 * h + s); a[s] = *(const s16x8*)(ap + ko); b0[s] = *(const s16x8*)(bp0 + ko); b1[s] = *(const s16x8*)(bp1 + ko); }
#pragma unroll
            for (int s = 0; s < 8; ++s) { c0 = __builtin_amdgcn_mfma_f32_32x32x16_bf16(a[s], b0[s], c0, 0, 0, 0); c1 = __builtin_amdgcn_mfma_f32_32x32x16_bf16(a[s], b1[s], c1, 0, 0, 0); } }
#pragma unroll
        for (int r = 0; r < 16; ++r) { const int row = (r & 3) + 8 * (r >> 2) + 4 * hi; part[F.wave * 2048 + row * 64 + l31] = c0[r]; part[F.wave * 2048 + row * 64 + 32 + l31] = c1[r]; }
        __syncthreads();
        { const int row = F.tid >> 4, c4 = 4 * (F.tid & 15); f32x4 s = {0.f, 0.f, 0.f, 0.f};
#pragma unroll
          for (int w = 0; w < 8; ++w) s += *(const LAS f32x4*)(part + w * 2048 + row * 64 + c4);
          bf16* dst = (bf16*)(F.ws + (cb < 16 ? WS_KRAW + (size_t)SEQ * 1024 * 2 : WS_V2)) + (size_t)(32 * rb + row) * 1024 + 64 * (cb & 15) + c4;
          *(unsigned long long*)dst = (unsigned long long)pk2(s[0], s[1]) | ((unsigned long long)pk2(s[2], s[3]) << 32); }
        __syncthreads();
    }
}

__device__ __forceinline__ void p3_post(const Args& A, Frame& F, const int gw, const int NGW) {
    const bf16* qraw = (const bf16*)(F.ws + WS_QRAW); const bf16* kraw = (const bf16*)(F.ws + WS_KRAW);
    bf16* q2 = (bf16*)(F.ws + WS_Q2); bf16* k2 = (bf16*)(F.ws + WS_K2);
    P3REP(4) { const int hm = F.lane >> 2, ax = (F.lane >> 1) & 1, jh = F.lane & 1; const int e0 = hm * 64 + 32 * ax + 8 * jh;
      float inv[8];
#pragma unroll
      for (int j = 0; j < 8; ++j) inv[j] = __builtin_amdgcn_exp2f(-(float)(8 * jh + j) * (13.287712379549449f / 16.f));
      for (int t = gw; t < SEQ; t += NGW) {
          const float pos = (float)(ax ? (t & 63) : (t >> 6));
          float cs[8], sn[8];
#pragma unroll
          for (int j = 0; j < 8; ++j) { const float a = pos * inv[j]; cs[j] = fcos(a); sn[j] = fsin(a); }
#pragma unroll
          for (int w = 0; w < 2; ++w) {
              const bf16* src = (w ? kraw : qraw) + (size_t)t * 1024 + e0; bf16* dst = (w ? k2 + (size_t)(CTXL + t) * 1024 : q2 + (size_t)t * 1024) + e0;
              const v4u x1 = *(const v4u*)src, x2 = *(const v4u*)(src + 16);
              float a1[8] = { blo(x1.x), bhi(x1.x), blo(x1.y), bhi(x1.y), blo(x1.z), bhi(x1.z), blo(x1.w), bhi(x1.w) };
              float a2[8] = { blo(x2.x), bhi(x2.x), blo(x2.y), bhi(x2.y), blo(x2.z), bhi(x2.z), blo(x2.w), bhi(x2.w) };
              float o1[8], o2[8];
              const float qs = w ? 1.f : att::C2;
#pragma unroll
              for (int j = 0; j < 8; ++j) { o1[j] = (a1[j] * cs[j] - a2[j] * sn[j]) * qs; o2[j] = (a2[j] * cs[j] + a1[j] * sn[j]) * qs; }
              v4u w1, w2; w1.x = pk2(o1[0], o1[1]); w1.y = pk2(o1[2], o1[3]); w1.z = pk2(o1[4], o1[5]); w1.w = pk2(o1[6], o1[7]);
              w2.x = pk2(o2[0], o2[1]); w2.y = pk2(o2[2], o2[3]); w2.z = pk2(o2[4], o2[5]); w2.w = pk2(o2[6], o2[7]);
              *(v4u*)dst = w1; *(v4u*)(dst + 16) = w2; }
      }
      for (int i = gw * 64 + F.lane; i < CTXL * 1024 / 8; i += NGW * 64) *((v4u*)k2 + i) = *((const v4u*)(kraw + (size_t)SEQ * 1024) + i);
    }
    P3REP(5) { const bf16* phy = (const bf16*)(F.ws + WS_PHY); const float* cw = A.in[11]; const float* cb = A.in[12];
      bf16* x0o = (bf16*)(F.ws + WS_X0); bf16* uht = (bf16*)(F.ws + WS_UHT);
      LAS unsigned char* tile = F.lds;
#pragma unroll 1
      for (int it = F.vcu; it < 256; it += F.G) { int ln = F.lane; asm volatile("" : "+v"(ln));
          const int t0 = (it >> 1) * 64, cbase = (it & 1) * 512, c = cbase + 8 * ln, tw = t0 + 8 * F.wave;
#pragma unroll 1
          for (int pass = 0; pass < 2; ++pass) {
              const int ns = pass ? 1 : 2, sb = pass ? 2 : 0;
              f32x4 wt[2][3][2], bs[2][2];
#pragma unroll
              for (int s = 0; s < 2; ++s) if (s < ns) { const int col = (sb + s) * 1024 + c;
#pragma unroll
                  for (int k = 0; k < 3; ++k) { wt[s][k][0] = *(const f32x4*)(cw + k * 3072 + col); wt[s][k][1] = *(const f32x4*)(cw + k * 3072 + col + 4); }
                  bs[s][0] = *(const f32x4*)(cb + col); bs[s][1] = *(const f32x4*)(cb + col + 4); }
              v4u row[2][10];
#pragma unroll
              for (int s = 0; s < 2; ++s) if (s < ns) {
#pragma unroll
                  for (int r = 0; r < 10; ++r) { const int t = tw - 1 + r;
                      row[s][r] = (t >= 0 && t < SEQ) ? *(const v4u*)(phy + (size_t)t * 3072 + (sb + s) * 1024 + c) : (v4u){0u, 0u, 0u, 0u}; } }
#pragma unroll
              for (int tt = 0; tt < 8; ++tt) { float z[2][8];
#pragma unroll
                  for (int s = 0; s < 2; ++s) if (s < ns) {
#pragma unroll
                      for (int h = 0; h < 4; ++h) { const unsigned a = row[s][tt][h], m = row[s][tt + 1][h], n = row[s][tt + 2][h]; const int q = h >> 1, e = 2 * (h & 1);
                          z[s][2 * h]     = blo(a) * wt[s][0][q][e]     + blo(m) * wt[s][1][q][e]     + blo(n) * wt[s][2][q][e]     + bs[s][q][e];
                          z[s][2 * h + 1] = bhi(a) * wt[s][0][q][e + 1] + bhi(m) * wt[s][1][q][e + 1] + bhi(n) * wt[s][2][q][e + 1] + bs[s][q][e + 1]; } }
                  if (pass == 0) { const int tl = 8 * F.wave + tt;
                      LAS unsigned short* tp = (LAS unsigned short*)(tile + (size_t)(8 * ln) * 128 + ((((tl >> 3) ^ ln) & 7) << 4) + 2 * (tl & 7));
#pragma unroll
                      for (int e = 0; e < 8; ++e) tp[e * 64] = (unsigned short)f2bf(z[0][e] * z[1][e]);
                  } else { v4u o; o.x = pk2(z[0][0], z[0][1]); o.y = pk2(z[0][2], z[0][3]); o.z = pk2(z[0][4], z[0][5]); o.w = pk2(z[0][6], z[0][7]);
                      *(v4u*)(x0o + (size_t)(tw + tt) * 1024 + c) = o; } }
          }
          __syncthreads();
          { const int csub = ln >> 3, piece = ln & 7;
#pragma unroll
            for (int i = 0; i < 8; ++i) { const int cl = 64 * F.wave + 8 * i + csub;
                const v4u v = *(const LAS v4u*)(tile + (size_t)cl * 128 + (((piece ^ (cl >> 3)) & 7) << 4));
                *(v4u*)(uht + (size_t)(cbase + cl) * SEQ + t0 + 8 * piece) = v; } }
          __syncthreads();
      } }
}

__device__ __forceinline__ void p4_conv_channel(Frame& F, int c) {
    LAS float* T = (LAS float*)F.lds;
    LAS float* uh = T + 16384;
    const float* tapF = (const float*)(F.ws + WS_TAPF) + (size_t)c * 8192; const float* tapB = (const float*)(F.ws + WS_TAPB) + (size_t)c * 8192;
    const bf16* uht = (const bf16*)(F.ws + WS_UHT) + (size_t)c * 8192;
    for (int i = F.tid; i < 8192; i += NTHR) { T[8192 + i] = tapF[i]; T[8192 - i] = (i == 0) ? tapF[0] : tapB[i]; uh[i] = bf2f(uht[i]); }
    if (F.tid == 0) T[0] = 0.f;
    __syncthreads();
    float acc[16];
#pragma unroll
    for (int i = 0; i < 16; ++i) acc[i] = 0.f;
    const int tid = F.tid;
    for (int S = 0; S < 512; ++S) {
        const int base = 16 * (tid - S) + 8192 - 16;
        float W[32], u[16];
#pragma unroll
        for (int q = 0; q < 32; q += 4) { const f32x4 w4 = *(const LAS f32x4*)(T + base + q); W[q] = w4[0]; W[q + 1] = w4[1]; W[q + 2] = w4[2]; W[q + 3] = w4[3]; }
#pragma unroll
        for (int q = 0; q < 16; q += 4) { const f32x4 u4 = *(const LAS f32x4*)(uh + 16 * S + q); u[q] = u4[0]; u[q + 1] = u4[1]; u[q + 2] = u4[2]; u[q + 3] = u4[3]; }
#pragma unroll
        for (int j = 0; j < 16; ++j)
#pragma unroll
            for (int i = 0; i < 16; ++i) acc[i] += W[16 + i - j] * u[j];
    }
    bf16* yo = (bf16*)(F.ws + WS_YCT) + (size_t)c * 8192 + 16 * tid;
    v4u o0, o1; o0.x = pk2(acc[0], acc[1]); o0.y = pk2(acc[2], acc[3]); o0.z = pk2(acc[4], acc[5]); o0.w = pk2(acc[6], acc[7]);
    o1.x = pk2(acc[8], acc[9]); o1.y = pk2(acc[10], acc[11]); o1.z = pk2(acc[12], acc[13]); o1.w = pk2(acc[14], acc[15]);
    *(v4u*)yo = o0; *(v4u*)(yo + 8) = o1;
    __syncthreads();
}
namespace fftc {
constexpr int N = 16384, LH = 8192, KSTR = 8320;
typedef float c32 __attribute__((ext_vector_type(2)));
__device__ __forceinline__ int rev4(int k) {
    unsigned r = __brev((unsigned)k) >> 18; return (int)(((r & 0x2AAAu) >> 1) | ((r & 0x1555u) << 1));
}
__device__ __forceinline__ int sw(int e) { const int t = e >> 4; return e ^ ((t & 3) * 5) ^ ((t & 4) << 2); }
__device__ __forceinline__ int rev4b(int m) { const unsigned r = __brev((unsigned)m) >> 24; return (int)(((r & 0xAAu) >> 1) | ((r & 0x55u) << 1)); }
__device__ __forceinline__ c32 cmul(c32 a, c32 b) { return (c32){a.x * b.x - a.y * b.y, a.x * b.y + a.y * b.x}; }
__device__ __forceinline__ c32 cadd(c32 a, c32 b) { c32 r; asm("v_pk_add_f32 %0, %1, %2" : "=v"(r) : "v"(a), "v"(b)); return r; }
__device__ __forceinline__ c32 csub(c32 a, c32 b) { c32 r; asm("v_pk_add_f32 %0, %1, %2 neg_lo:[0,1] neg_hi:[0,1]" : "=v"(r) : "v"(a), "v"(b)); return r; }
__device__ __forceinline__ c32 csubi(c32 a, c32 b) { c32 r; asm("v_pk_add_f32 %0, %1, %2 op_sel:[0,1] op_sel_hi:[1,0] neg_hi:[0,1]" : "=v"(r) : "v"(a), "v"(b)); return r; }
__device__ __forceinline__ c32 caddi(c32 a, c32 b) { c32 r; asm("v_pk_add_f32 %0, %1, %2 op_sel:[0,1] op_sel_hi:[1,0] neg_lo:[0,1]" : "=v"(r) : "v"(a), "v"(b)); return r; }
__device__ __forceinline__ c32 cmulw(c32 a, c32 w, c32 wr) { c32 t, r;
    asm("v_pk_mul_f32 %0, %1, %2 op_sel_hi:[0,1]" : "=v"(t) : "v"(a), "v"(w));
    asm("v_pk_fma_f32 %0, %1, %2, %3 op_sel:[1,0,0] op_sel_hi:[1,1,1]" : "=v"(r) : "v"(a), "v"(wr), "v"(t)); return r; }
struct Tw { c32 w1, r1, w2, r2, w3, r3; };
template <bool INV> __device__ __forceinline__ Tw make_tw(float ang) {
    float c, s; Tw t;
    asm("s_nop 1\n\tv_cos_f32 %0, %2\n\tv_sin_f32 %1, %2\n\ts_nop 1" : "=&v"(c), "=&v"(s) : "v"(ang));
    t.w1 = INV ? (c32){c, s} : (c32){c, -s}; t.r1 = INV ? (c32){-s, c} : (c32){s, c};
    t.w2 = cmulw(t.w1, t.w1, t.r1); t.r2 = cmulw(t.r1, t.w1, t.r1); t.w3 = cmulw(t.w2, t.w1, t.r1); t.r3 = cmulw(t.r2, t.w1, t.r1); return t;
}
template <bool INV, bool TW> __device__ __forceinline__ void bfly(c32& a0, c32& a1, c32& a2, c32& a3, const Tw& t) {
    if (INV) {
        if (TW) { a1 = cmulw(a1, t.w1, t.r1); a2 = cmulw(a2, t.w2, t.r2); a3 = cmulw(a3, t.w3, t.r3); }
        const c32 s0 = cadd(a0, a2), s1 = csub(a0, a2), s2 = cadd(a1, a3), s3 = csub(a1, a3);
        a0 = cadd(s0, s2); a2 = csub(s0, s2); a1 = caddi(s1, s3); a3 = csubi(s1, s3);
    } else {
        const c32 t0 = cadd(a0, a2), t1 = csub(a0, a2), t2 = cadd(a1, a3), t3 = csub(a1, a3);
        a0 = cadd(t0, t2); a2 = csub(t0, t2); a1 = csubi(t1, t3); a3 = caddi(t1, t3);
        if (TW) { a1 = cmulw(a1, t.w1, t.r1); a2 = cmulw(a2, t.w2, t.r2); a3 = cmulw(a3, t.w3, t.r3); }
    }
}
template <int S, bool INV> __device__ __forceinline__ void stage(LAS c32* x, int tid) {
    constexpr int L = N >> (2 * S), q = L / 4;
    asm volatile("" : "+v"(tid));
    if constexpr (q >= 512) {
        LAS c32* xs = x + sw(tid); constexpr int R = q / 512;
#pragma unroll
        for (int i = 0; i < 8; ++i) { const int off = (i / R) * L + 512 * (i % R);
            c32 a0 = xs[off], a1 = xs[off + q], a2 = xs[off + 2 * q], a3 = xs[off + 3 * q];
            const Tw t = make_tw<INV>((float)(tid + 512 * (i % R)) * (1.f / (float)L));
            bfly<INV, true>(a0, a1, a2, a3, t);
            xs[off] = a0; xs[off + q] = a1; xs[off + 2 * q] = a2; xs[off + 3 * q] = a3; }
    } else {
        const int j = tid & (q - 1), base = (tid / q) * L + j;
        LAS c32* p0 = x + sw(base); LAS c32* p1 = x + sw(base + q); LAS c32* p2 = x + sw(base + 2 * q); LAS c32* p3 = x + sw(base + 3 * q);
        Tw t; if constexpr (q > 1) t = make_tw<INV>((float)j * (1.f / (float)L));
#pragma unroll
        for (int i = 0; i < 8; ++i) { c32 a0 = p0[2048 * i], a1 = p1[2048 * i], a2 = p2[2048 * i], a3 = p3[2048 * i];
            bfly<INV, (q > 1)>(a0, a1, a2, a3, t);
            p0[2048 * i] = a0; p1[2048 * i] = a1; p2[2048 * i] = a2; p3[2048 * i] = a3; }
    }
    __syncthreads();
}
template <int S> __device__ __forceinline__ void fwd_stage(LAS c32* x, int tid) { stage<S, false>(x, tid); }
template <int S> __device__ __forceinline__ void inv_stage(LAS c32* x, int tid) { stage<S, true>(x, tid); }
__device__ __forceinline__ void fwd_all(LAS c32* x, int tid) { fwd_stage<0>(x, tid); fwd_stage<1>(x, tid); fwd_stage<2>(x, tid); fwd_stage<3>(x, tid); fwd_stage<4>(x, tid); fwd_stage<5>(x, tid); fwd_stage<6>(x, tid); }
__device__ __forceinline__ void inv_all(LAS c32* x, int tid) { inv_stage<6>(x, tid); inv_stage<5>(x, tid); inv_stage<4>(x, tid); inv_stage<3>(x, tid); inv_stage<2>(x, tid); inv_stage<1>(x, tid); inv_stage<0>(x, tid); }
__device__ __forceinline__ void conv_pair(LAS unsigned char* lds, int tid, int pr, const float* tapF, const float* tapB, const unsigned short* uht, unsigned short* yct) {
    LAS c32* x = (LAS c32*)lds;
    const size_t o1 = (size_t)(2 * pr) * LH, o2 = o1 + LH;
#pragma unroll 1
    for (int h = 0; h < 2; ++h) { f32x4 f1[2], f2[2], b1[2], b2[2];
#pragma unroll
      for (int i = 0; i < 2; ++i) { const int n = 4 * (tid + 512 * (2 * h + i)); f1[i] = *(const f32x4*)(tapF + o1 + n); f2[i] = *(const f32x4*)(tapF + o2 + n); b1[i] = *(const f32x4*)(tapB + o1 + n); b2[i] = *(const f32x4*)(tapB + o2 + n); }
#pragma unroll
      for (int i = 0; i < 2; ++i) {
#pragma unroll
          for (int e = 0; e < 4; ++e) { const int n = 4 * (tid + 512 * (2 * h + i)) + e; const bool z = (n == 0);
              x[sw(n)] = (c32){f1[i][e], f2[i][e]}; x[sw(z ? LH : N - n)] = z ? (c32){0.f, 0.f} : (c32){b1[i][e], b2[i][e]}; } } }
    __syncthreads();
    fwd_all(x, tid);
    const int lane = tid & 63, wv = tid >> 6, khi = ((lane & 3) << 4) | (lane & 12) | (lane >> 4);
    f32x4 Kr[17];
#pragma unroll
    for (int it = 0; it < 17; ++it) { const int m = wv + 8 * it;
        const bool act = (it == 16) ? (wv == 0 && khi < 32) : ((it == 0 && wv == 0) ? (khi <= 32) : true);
        const int kp = (N - (256 * khi + m)) & (N - 1);
        const int pk = sw((rev4b(m) << 6) | lane), pkp = sw(rev4(kp));
        Kr[it] = (f32x4){0.f, 0.f, 0.f, 0.f};
        if (act) { const c32 A = x[pk], Bq = x[pkp]; const c32 B = (c32){Bq.x, -Bq.y};
            const c32 sm = A + B, df = A - B; constexpr float h = 0.5f / (float)N;
            Kr[it] = (f32x4){sm.x * h, sm.y * h, df.y * h, -df.x * h}; } }
    __syncthreads();
    { v2u u1[4], u2[4];
#pragma unroll
      for (int i = 0; i < 4; ++i) { const int n = 4 * (tid + 512 * i); u1[i] = *(const v2u*)(uht + o1 + n); u2[i] = *(const v2u*)(uht + o2 + n); }
#pragma unroll
      for (int i = 0; i < 4; ++i) { const int n = 4 * (tid + 512 * i);
          x[sw(n)] = (c32){blo(u1[i].x), blo(u2[i].x)}; x[sw(n + 1)] = (c32){bhi(u1[i].x), bhi(u2[i].x)}; x[sw(n + 2)] = (c32){blo(u1[i].y), blo(u2[i].y)}; x[sw(n + 3)] = (c32){bhi(u1[i].y), bhi(u2[i].y)};
#pragma unroll
          for (int e = 0; e < 4; ++e) x[sw(LH + n + e)] = (c32){0.f, 0.f}; } }
    __syncthreads();
    fwd_all(x, tid);
#pragma unroll
    for (int it = 0; it < 17; ++it) { const int m = wv + 8 * it;
        const bool act = (it == 16) ? (wv == 0 && khi < 32) : ((it == 0 && wv == 0) ? (khi <= 32) : true);
        const int kp = (N - (256 * khi + m)) & (N - 1);
        const int pk = sw((rev4b(m) << 6) | lane), pkp = sw(rev4(kp));
        if (act) { const c32 A = x[pk], Bq = x[pkp]; const c32 B = (c32){Bq.x, -Bq.y};
            const c32 sm = A + B, df = A - B; const c32 U1 = sm * 0.5f, U2 = (c32){df.y * 0.5f, -df.x * 0.5f};
            const f32x4 K = Kr[it];
            const c32 Y1 = cmul(U1, (c32){K[0], K[1]}), Y2 = cmul(U2, (c32){K[2], K[3]});
            x[pkp] = (c32){Y1.x + Y2.y, Y2.x - Y1.y};
            x[pk]  = (c32){Y1.x - Y2.y, Y1.y + Y2.x}; } }
    __syncthreads();
    inv_all(x, tid);
#pragma unroll
    for (int i = 0; i < 4; ++i) { const int n = 4 * (tid + 512 * i); const c32 v0 = x[sw(n)], v1 = x[sw(n + 1)], v2 = x[sw(n + 2)], v3 = x[sw(n + 3)];
        *(v2u*)(yct + o1 + n) = (v2u){pk2(v0.x, v1.x), pk2(v2.x, v3.x)}; *(v2u*)(yct + o2 + n) = (v2u){pk2(v0.y, v1.y), pk2(v2.y, v3.y)}; }
    __syncthreads();
}
}
__device__ __forceinline__ float da_lambda(const Args& A, const Frame& F) {
    const float* lp = A.in[22]; const int l = F.lane;
    const float sa = wave_sum(lp[l] * lp[64 + l]), sb = wave_sum(lp[128 + l] * lp[192 + l]);
    return __expf(sa) - __expf(sb) + 0.2f;
}
__device__ __forceinline__ void p5_finalize(const Args& A, Frame& F) {
    { const float lam = da_lambda(A, F); const float* O = (const float*)(F.ws + WS_O); bf16* yda = (bf16*)(F.ws + WS_YDA); const float* sub = A.in[23];
      const int head = F.lane >> 3, e0 = (F.lane & 7) * 16;
      float sl[16];
#pragma unroll
      for (int i = 0; i < 16; ++i) sl[i] = sub[e0 + i] * 0.8f;
      for (int t = F.gw; t < SEQ; t += F.NGW) {
          const float* o0 = O + (size_t)t * 2048 + (2 * head) * 128 + e0; const float* o1 = o0 + 128;
          float y[16]; float ss = 0.f;
#pragma unroll
          for (int q = 0; q < 4; ++q) { const f32x4 a = *(const f32x4*)(o0 + 4 * q), b = *(const f32x4*)(o1 + 4 * q);
#pragma unroll
              for (int e = 0; e < 4; ++e) { const float v = a[e] - lam * b[e]; y[4 * q + e] = v; ss += v * v; } }
          ss += __shfl_xor(ss, 1); ss += __shfl_xor(ss, 2); ss += __shfl_xor(ss, 4);
          const float rstd = rsqrtf(ss * (1.f / 128.f) + EPS);
          v4u w0, w1; w0.x = pk2(y[0] * rstd * sl[0], y[1] * rstd * sl[1]); w0.y = pk2(y[2] * rstd * sl[2], y[3] * rstd * sl[3]);
          w0.z = pk2(y[4] * rstd * sl[4], y[5] * rstd * sl[5]); w0.w = pk2(y[6] * rstd * sl[6], y[7] * rstd * sl[7]);
          w1.x = pk2(y[8] * rstd * sl[8], y[9] * rstd * sl[9]); w1.y = pk2(y[10] * rstd * sl[10], y[11] * rstd * sl[11]);
          w1.z = pk2(y[12] * rstd * sl[12], y[13] * rstd * sl[13]); w1.w = pk2(y[14] * rstd * sl[14], y[15] * rstd * sl[15]);
          bf16* dst = yda + (size_t)t * 1024 + head * 128 + e0; *(v4u*)dst = w0; *(v4u*)(dst + 8) = w1; } }
    { const bf16* yct = (const bf16*)(F.ws + WS_YCT); const bf16* uht = (const bf16*)(F.ws + WS_UHT); const bf16* x0 = (const bf16*)(F.ws + WS_X0);
      bf16* yhy = (bf16*)(F.ws + WS_YHY); const float* bias = A.in[21];
      LAS unsigned char* tile = F.lds;
#pragma unroll 1
      for (int it = F.vcu; it < 256; it += F.G) { int ln = F.lane; asm volatile("" : "+v"(ln));
          const int t0 = (it >> 1) * 64, cbase = (it & 1) * 512, csub = ln >> 3, piece = ln & 7;
          v4u yv[8], uv[8]; float bv[8];
#pragma unroll
          for (int i = 0; i < 8; ++i) { const int cl = 64 * F.wave + 8 * i + csub; const size_t o = (size_t)(cbase + cl) * SEQ + t0 + 8 * piece;
              yv[i] = *(const v4u*)(yct + o); uv[i] = *(const v4u*)(uht + o); bv[i] = bias[cbase + cl]; }
#pragma unroll
          for (int i = 0; i < 8; ++i) { const int cl = 64 * F.wave + 8 * i + csub;
              LAS unsigned short* tp = (LAS unsigned short*)(tile + (size_t)(8 * piece) * 1024 + ((((cl >> 3) ^ piece) & 63) << 4) + 2 * (cl & 7));
#pragma unroll
              for (int h = 0; h < 4; ++h) { tp[(2 * h) * 512] = (unsigned short)f2bf(blo(yv[i][h]) + blo(uv[i][h]) * bv[i]); tp[(2 * h + 1) * 512] = (unsigned short)f2bf(bhi(yv[i][h]) + bhi(uv[i][h]) * bv[i]); } }
          __syncthreads();
          v4u xv[8];
#pragma unroll
          for (int tt = 0; tt < 8; ++tt) xv[tt] = *(const v4u*)(x0 + (size_t)(t0 + 8 * F.wave + tt) * 1024 + cbase + 8 * ln);
#pragma unroll
          for (int tt = 0; tt < 8; ++tt) { const int tl = 8 * F.wave + tt;
              const v4u m = *(const LAS v4u*)(tile + (size_t)tl * 1024 + (((ln ^ (tl >> 3)) & 63) << 4)); v4u o;
#pragma unroll
              for (int h = 0; h < 4; ++h) o[h] = pk2(blo(xv[tt][h]) * blo(m[h]), bhi(xv[tt][h]) * bhi(m[h]));
              *(v4u*)(yhy + (size_t)(t0 + tl) * 1024 + cbase + 8 * ln) = o; }
          __syncthreads();
      } }
}

__device__ __forceinline__ void p8_rows(const Args& A, Frame& F) {
    const float* mix = (const float*)(F.ws + WS_MIX); bf16* hb = (bf16*)(F.ws + WS_HB);
    int r = F.gw; if (r >= SEQ) return;
    f32x4 ga[8], a2[8], b2[8];
#pragma unroll
    for (int j = 0; j < 8; ++j) { const int col = 4 * F.lane + 256 * j;
        ga[j] = mod4(A, F, 0, 2 * DM + col) * *(const f32x4*)(A.in[7] + col);
        a2[j] = *(const f32x4*)(A.in[8] + col) * (mod4(A, F, 0, 4 * DM + col) + 1.f); b2[j] = mod4(A, F, 0, 3 * DM + col); }
    for (; r < SEQ; r += F.NGW) {
        const f32x4* mr = (const f32x4*)(mix + (size_t)r * DM) + F.lane; const f32x4* xr = (const f32x4*)(A.in[0] + (size_t)r * DM) + F.lane;
        f32x4 v[8], xv[8]; float s = 0.f;
#pragma unroll
        for (int j = 0; j < 8; ++j) { v[j] = mr[64 * j]; xv[j] = xr[64 * j]; }
#pragma unroll
        for (int j = 0; j < 8; ++j) s += (v[j][0] * v[j][0] + v[j][1] * v[j][1]) + (v[j][2] * v[j][2] + v[j][3] * v[j][3]);
        const float rstd = rsqrtf(wave_sum(s) * (1.f / DM) + EPS); float s2 = 0.f;
        f32x4* orow = (f32x4*)(F.out + (size_t)r * DM) + F.lane;
#pragma unroll
        for (int j = 0; j < 8; ++j) { v[j] = xv[j] + v[j] * rstd * ga[j]; orow[64 * j] = v[j];
            s2 += (v[j][0] * v[j][0] + v[j][1] * v[j][1]) + (v[j][2] * v[j][2] + v[j][3] * v[j][3]); }
        const float rstd2 = rsqrtf(wave_sum(s2) * (1.f / DM) + EPS);
        unsigned long long* o8 = (unsigned long long*)(hb + (size_t)r * DM) + F.lane;
#pragma unroll
        for (int j = 0; j < 8; ++j) { const f32x4 y = v[j] * rstd2 * a2[j] + b2[j];
            o8[64 * j] = (unsigned long long)pk2(y[0], y[1]) | ((unsigned long long)pk2(y[2], y[3]) << 32); }
    }
}

typedef float f32x16 __attribute__((ext_vector_type(16)));
#define TK_CS(A, B) do { const float hi_ = __builtin_fmaxf(v[A], v[B]), lo_ = __builtin_fminf(v[A], v[B]); v[A] = hi_; v[B] = lo_; } while (0)
__device__ __forceinline__ float tk_tag(float x, unsigned mask, unsigned id) { return __uint_as_float((__float_as_uint(x) & ~mask) | id); }
__device__ __forceinline__ void tk_sort16(float (&v)[16]) {
#pragma unroll
    for (int k = 2; k <= 16; k <<= 1)
#pragma unroll
        for (int j = k >> 1; j >= 1; j >>= 1)
#pragma unroll
            for (int i = 0; i < 16; ++i) { const int l = i ^ j; if (l > i) { if ((i & k) == 0) TK_CS(i, l); else TK_CS(l, i); } }
}
__device__ __forceinline__ void tk_merge16(float (&v)[16], const float (&o)[16]) {
#pragma unroll
    for (int t = 0; t < 16; ++t) v[t] = __builtin_fmaxf(v[t], o[15 - t]);
#pragma unroll
    for (int st = 8; st >= 1; st >>= 1)
#pragma unroll
        for (int t = 0; t < 16; ++t) if ((t & st) == 0) TK_CS(t, t + st);
}
__device__ __forceinline__ void p11_item(const Args& A, Frame& F, int item) {
    const int tb = item & 31, h = item >> 5;
    typedef short s16x8 __attribute__((ext_vector_type(8)));
    LAS unsigned char* KH = F.lds;
    const float* keys = A.in[28];
    for (int i = F.tid; i < 2 * 128 * 16; i += NTHR) { const int ch = i & 15, k = (i >> 4) & 127, p = i >> 11;
        const float* src = keys + ((size_t)(p * 8 + h) * 128 + k) * 128 + ch * 8; const f32x4 a = *(const f32x4*)src, b = *(const f32x4*)(src + 4);
        const float x[8] = {a[0], a[1], a[2], a[3], b[0], b[1], b[2], b[3]}; unsigned hw[4], lw[4];
#pragma unroll
        for (int e = 0; e < 4; ++e) { const unsigned h0 = f2bf(x[2 * e]), h1 = f2bf(x[2 * e + 1]); hw[e] = h0 | (h1 << 16);
            lw[e] = pk2(x[2 * e] - __builtin_bit_cast(float, h0 << 16), x[2 * e + 1] - __builtin_bit_cast(float, h1 << 16)); }
        LAS unsigned char* d = KH + (size_t)p * 65536 + (size_t)k * 256 + ((ch ^ (k & 15)) << 4);
        *(LAS v4u*)d = (v4u){hw[0], hw[1], hw[2], hw[3]}; *(LAS v4u*)(d + 32768) = (v4u){lw[0], lw[1], lw[2], lw[3]}; }
    __syncthreads();
    const int lane = F.lane, r32 = lane & 31, hi = lane >> 5;
    const int n = tb * 256 + F.wave * 32 + r32;
    const float* qrow = (const float*)(F.ws + WS_QP) + (size_t)n * DM + h * 256;
    f32x16 acc[2][4];
#pragma unroll
    for (int p = 0; p < 2; ++p) {
#pragma unroll
        for (int kt = 0; kt < 4; ++kt) acc[p][kt] = f32x16{};
        const LAS unsigned char* kb = KH + (size_t)p * 65536 + (size_t)r32 * 256;
        const float* qp = qrow + p * 128 + 8 * hi;
        f32x4 qa = *(const f32x4*)qp, qb = *(const f32x4*)(qp + 4);
#pragma unroll 1
        for (int s = 0; s < 8; ++s) {
            const f32x4 ca = qa, cb = qb; { const int sn = (s + 1) & 7; qa = *(const f32x4*)(qp + 16 * sn); qb = *(const f32x4*)(qp + 16 * sn + 4); }
            const float x[8] = {ca[0], ca[1], ca[2], ca[3], cb[0], cb[1], cb[2], cb[3]}; unsigned hw[4], lw[4];
#pragma unroll
            for (int e = 0; e < 4; ++e) { const unsigned h0 = f2bf(x[2 * e]), h1 = f2bf(x[2 * e + 1]); hw[e] = h0 | (h1 << 16);
                lw[e] = pk2(x[2 * e] - __builtin_bit_cast(float, h0 << 16), x[2 * e + 1] - __builtin_bit_cast(float, h1 << 16)); }
            const v4u bhv = {hw[0], hw[1], hw[2], hw[3]}, blv = {lw[0], lw[1], lw[2], lw[3]};
            const s16x8 bh = __builtin_bit_cast(s16x8, bhv), bl = __builtin_bit_cast(s16x8, blv);
            const int co = (((2 * s + hi) ^ (r32 & 15)) << 4);
#pragma unroll
            for (int kt = 0; kt < 4; ++kt) { const s16x8 ah = *(const LAS s16x8*)(kb + kt * 8192 + co), al = *(const LAS s16x8*)(kb + kt * 8192 + co + 32768);
                acc[p][kt] = __builtin_amdgcn_mfma_f32_32x32x16_bf16(al, bh, acc[p][kt], 0, 0, 0);
                acc[p][kt] = __builtin_amdgcn_mfma_f32_32x32x16_bf16(ah, bl, acc[p][kt], 0, 0, 0);
                acc[p][kt] = __builtin_amdgcn_mfma_f32_32x32x16_bf16(ah, bh, acc[p][kt], 0, 0, 0); }
        }
    }
    __syncthreads();
    float lv[2][16];
#pragma unroll
    for (int p = 0; p < 2; ++p) {
        float v[16];
#pragma unroll
        for (int r = 0; r < 16; ++r) v[r] = tk_tag(acc[p][0][r], 127u, (unsigned)((r & 3) + 8 * (r >> 2) + 4 * hi));
        tk_sort16(v);
#pragma unroll
        for (int kt = 1; kt < 4; ++kt) { float w[16];
#pragma unroll
            for (int r = 0; r < 16; ++r) w[r] = tk_tag(acc[p][kt][r], 127u, (unsigned)(32 * kt + (r & 3) + 8 * (r >> 2) + 4 * hi));
            tk_sort16(w); tk_merge16(v, w); }
        { float ov[16];
#pragma unroll
          for (int t = 0; t < 16; ++t) ov[t] = __shfl_xor(v[t], 32);
          tk_merge16(v, ov); }
#pragma unroll
        for (int t = 0; t < 16; ++t) lv[p][t] = v[t];
    }
    LAS int* cidl = (LAS int*)F.lds + (F.wave * 32 + r32) * 65;
    float blk[4][16]; { int c = 0;
#pragma unroll
        for (int i = 0; i < 16; ++i)
#pragma unroll
            for (int j = 0; j < 16; ++j) if ((i + 1) * (j + 1) <= 16) {
                blk[c >> 4][c & 15] = tk_tag(lv[0][i] + lv[1][j], 63u, (unsigned)c);
                if (hi == 0) cidl[c] = (int)((__float_as_uint(lv[0][i]) & 127u) * 128u + (__float_as_uint(lv[1][j]) & 127u));
                ++c; }
#pragma unroll
        for (; c < 64; ++c) blk[c >> 4][c & 15] = tk_tag(-3.0e38f, 63u, (unsigned)c); }
    tk_sort16(blk[0]); tk_sort16(blk[1]); tk_sort16(blk[2]); tk_sort16(blk[3]);
    tk_merge16(blk[0], blk[1]); tk_merge16(blk[2], blk[3]); tk_merge16(blk[0], blk[2]);
    float e[16], sum = 0.f;
#pragma unroll
    for (int t = 0; t < 16; ++t) { e[t] = __expf(blk[0][t] - blk[0][0]); sum += e[t]; }
    const float rs = 1.f / sum;
    if (hi == 0) { int* io = (int*)(F.ws + WS_IDX) + (size_t)n * 128 + h * 16; float* go = (float*)(F.ws + WS_GW) + (size_t)n * 128 + h * 16;
        int id[16];
#pragma unroll
        for (int t = 0; t < 16; ++t) id[t] = cidl[__float_as_uint(blk[0][t]) & 63u];
#pragma unroll
        for (int t = 0; t < 16; t += 4) { *(v4u*)(io + t) = (v4u){(unsigned)id[t], (unsigned)id[t + 1], (unsigned)id[t + 2], (unsigned)id[t + 3]};
            *(f32x4*)(go + t) = (f32x4){e[t] * rs, e[t + 1] * rs, e[t + 2] * rs, e[t + 3] * rs}; } }
    __syncthreads();
}
#undef TK_CS

__device__ __forceinline__ float gelu_erf(float x) { return 0.5f * x * (1.f + erff(x * 0.7071067811865476f)); }
__device__ __forceinline__ void fmac1(float& acc, float a, float b) { asm("v_fmac_f32 %0, %1, %2" : "+v"(acc) : "v"(a), "v"(b)); }
typedef _Float16 h2 __attribute__((ext_vector_type(2)));
__device__ __forceinline__ void p12_coldots(const Args& A, Frame& F) {
    typedef float f32x2 __attribute__((ext_vector_type(2)));
    const bf16* hb = (const bf16*)(F.ws + WS_HB); const unsigned char* ub = F.ws + WS_UB; const int* idx = (const int*)(F.ws + WS_IDX);
    const int lane = F.lane, wpg = F.NGW >> 3, x = F.gw / wpg, wl = F.gw - x * wpg, rs = lane >> 4, cc = lane & 15;
    float* pdx = (float*)(F.ws + WS_PD) + (size_t)x * SEQ * 128;
    const size_t coff = 256 * x + 16 * cc;
    const unsigned char* usl = ub + (size_t)x * ((size_t)NEXP * 256) + 16 * cc;
#define P12_LOADH(HF, ID0, ID1, nn) do { const v4u a_ = *(const v4u*)(hb + (size_t)(nn) * DM + coff), b_ = *(const v4u*)(hb + (size_t)(nn) * DM + coff + 8); \
        HF[0] = (h2){(_Float16)blo(a_.x), (_Float16)bhi(a_.x)}; HF[1] = (h2){(_Float16)blo(a_.y), (_Float16)bhi(a_.y)}; HF[2] = (h2){(_Float16)blo(a_.z), (_Float16)bhi(a_.z)}; HF[3] = (h2){(_Float16)blo(a_.w), (_Float16)bhi(a_.w)}; \
        HF[4] = (h2){(_Float16)blo(b_.x), (_Float16)bhi(b_.x)}; HF[5] = (h2){(_Float16)blo(b_.y), (_Float16)bhi(b_.y)}; HF[6] = (h2){(_Float16)blo(b_.z), (_Float16)bhi(b_.z)}; HF[7] = (h2){(_Float16)blo(b_.w), (_Float16)bhi(b_.w)}; \
        ID0 = idx[(size_t)(nn) * 128 + lane]; ID1 = idx[(size_t)(nn) * 128 + 64 + lane]; } while (0)
#define P12_LOADW(W, ID) do { _Pragma("unroll") for (int i = 0; i < 16; ++i) { const int e_ = __shfl((ID), 4 * i + rs); W[i] = *(const v4u*)(usl + (size_t)e_ * 256); } } while (0)
#define P12_DOTS(W, HF, B) do { _Pragma("unroll") for (int i = 0; i < 16; ++i) { float a0 = 0.f, a1 = 0.f; \
        _Pragma("unroll") for (int e = 0; e < 4; ++e) { const h2 lo = __builtin_amdgcn_cvt_scalef32_pk_f16_fp8((int)W[i][e], 1.0f, false), hi2 = __builtin_amdgcn_cvt_scalef32_pk_f16_fp8((int)W[i][e], 1.0f, true); \
            a0 = __builtin_amdgcn_fdot2(lo, HF[2 * e], a0, false); a1 = __builtin_amdgcn_fdot2(hi2, HF[2 * e + 1], a1, false); } \
        acc[16 * (B) + i] = a0 + a1; } } while (0)
    h2 hf[8], hfn[8]; int id0, id1, idn0 = 0, idn1 = 0; v4u wA[16], wB[16];
    if (wl < SEQ) { P12_LOADH(hf, id0, id1, wl); P12_LOADW(wA, id0); }
#pragma unroll 1
    for (int n = wl; n < SEQ; n += wpg) {
        const int nn = n + wpg; const bool more = nn < SEQ;
        float acc[32];
        if (more) P12_LOADH(hfn, idn0, idn1, nn);
        P12_LOADW(wB, id1);
        __builtin_amdgcn_sched_barrier(0);
        P12_DOTS(wA, hf, 0);
        __builtin_amdgcn_sched_barrier(0);
        if (more) P12_LOADW(wA, idn0);
        __builtin_amdgcn_sched_barrier(0);
        P12_DOTS(wB, hf, 1);
        __builtin_amdgcn_sched_barrier(0);
        float r16[16], r8[8], r4[4], r2[2];
        { const bool t = cc & 8;
#pragma unroll
          for (int k = 0; k < 16; ++k) r16[k] = (t ? acc[k + 16] : acc[k]) + __shfl_xor(t ? acc[k] : acc[k + 16], 8); }
        { const bool t = cc & 4;
#pragma unroll
          for (int k = 0; k < 8; ++k) r8[k] = (t ? r16[k + 8] : r16[k]) + __shfl_xor(t ? r16[k] : r16[k + 8], 4); }
        { const bool t = cc & 2;
#pragma unroll
          for (int k = 0; k < 4; ++k) r4[k] = (t ? r8[k + 4] : r8[k]) + __shfl_xor(t ? r8[k] : r8[k + 4], 2); }
        { const bool t = cc & 1;
#pragma unroll
          for (int k = 0; k < 2; ++k) r2[k] = (t ? r4[k + 2] : r4[k]) + __shfl_xor(t ? r4[k] : r4[k + 2], 1); }
        const int I0 = 2 * (cc & 1) + 4 * ((cc >> 1) & 1) + 8 * ((cc >> 2) & 1) + 16 * (cc >> 3);
        pdx[(size_t)n * 128 + 4 * I0 + rs] = r2[0]; pdx[(size_t)n * 128 + 4 * (I0 + 1) + rs] = r2[1];
#pragma unroll
        for (int i = 0; i < 8; ++i) hf[i] = hfn[i];
        id0 = idn0; id1 = idn1;
    }
#undef P12_LOADH
#undef P12_LOADW
#undef P12_DOTS
}
__device__ __forceinline__ void p12b_weights(const Args& A, Frame& F) {
    const int* idx = (const int*)(F.ws + WS_IDX); const float* gwp = (const float*)(F.ws + WS_GW); const float* pd = (const float*)(F.ws + WS_PD);
    const float* usc = (const float*)(F.ws + WS_USC); const float* vsc = (const float*)(F.ws + WS_VSC); float* wgt = (float*)(F.ws + WS_WGT);
    const int lane = F.lane;
    for (int n = F.gw; n < SEQ; n += F.NGW) {
        const int id0 = idx[(size_t)n * 128 + lane], id1 = idx[(size_t)n * 128 + 64 + lane];
        float d0 = 0.f, d1 = 0.f;
#pragma unroll
        for (int g = 0; g < 8; ++g) { d0 += pd[((size_t)g * SEQ + n) * 128 + lane]; d1 += pd[((size_t)g * SEQ + n) * 128 + 64 + lane]; }
        wgt[(size_t)n * 128 + lane] = gwp[(size_t)n * 128 + lane] * gelu_erf(d0 * usc[id0]) * vsc[id0];
        wgt[(size_t)n * 128 + 64 + lane] = gwp[(size_t)n * 128 + 64 + lane] * gelu_erf(d1 * usc[id1]) * vsc[id1];
    }
}
__device__ __forceinline__ void p13_colsum(const Args& A, Frame& F) {
    typedef float f32x2 __attribute__((ext_vector_type(2)));
    const unsigned char* vb = F.ws + WS_VB; const int* idx = (const int*)(F.ws + WS_IDX); const float* gwp = (const float*)(F.ws + WS_GW);
    const float* wgt = (const float*)(F.ws + WS_WGT);
    float* opre = (float*)(F.ws + WS_OPRE); float* ssp = (float*)(F.ws + WS_SSP);
    const int lane = F.lane, wpg = F.NGW >> 3, x = F.gw / wpg, wl = F.gw - x * wpg, rs = lane >> 4, cc = lane & 15;
    const size_t coff = 256 * x + 16 * cc;
    const unsigned char* vsl = vb + (size_t)x * ((size_t)NEXP * 256) + 16 * cc;
#pragma unroll 1
    for (int n = wl; n < SEQ; n += wpg) {
        const int id0 = idx[(size_t)n * 128 + lane], id1 = idx[(size_t)n * 128 + 64 + lane];
        const float wg0 = wgt[(size_t)n * 128 + lane], wg1 = wgt[(size_t)n * 128 + 64 + lane];
        h2 o2[8];
#pragma unroll
        for (int i = 0; i < 8; ++i) o2[i] = (h2){(_Float16)0.f, (_Float16)0.f};
#pragma unroll
        for (int b = 0; b < 2; ++b) {
            v4u w[16]; h2 wv[16];
#pragma unroll
            for (int i = 0; i < 16; ++i) { const int e = __shfl(b ? id1 : id0, 4 * i + rs); const _Float16 t = (_Float16)(__shfl(b ? wg1 : wg0, 4 * i + rs) * 4096.f); wv[i] = (h2){t, t};
                w[i] = *(const v4u*)(vsl + (size_t)e * 256); }
#pragma unroll
            for (int i = 0; i < 16; ++i) {
#pragma unroll
                for (int e = 0; e < 4; ++e) { const h2 lo = __builtin_amdgcn_cvt_scalef32_pk_f16_fp8((int)w[i][e], 1.0f, false), hi2 = __builtin_amdgcn_cvt_scalef32_pk_f16_fp8((int)w[i][e], 1.0f, true);
                    o2[2 * e] = lo * wv[i] + o2[2 * e]; o2[2 * e + 1] = hi2 * wv[i] + o2[2 * e + 1]; } }
            __builtin_amdgcn_sched_barrier(0);
        }
        float o[16];
#pragma unroll
        for (int i = 0; i < 8; ++i) { o[2 * i] = (float)o2[i][0] * (1.f / 4096.f); o[2 * i + 1] = (float)o2[i][1] * (1.f / 4096.f); }
        float t8[8]; f32x4 t4;
        { const bool t = lane & 32;
#pragma unroll
          for (int k = 0; k < 8; ++k) t8[k] = (t ? o[k + 8] : o[k]) + __shfl_xor(t ? o[k] : o[k + 8], 32); }
        { const bool t = lane & 16;
#pragma unroll
          for (int k = 0; k < 4; ++k) t4[k] = (t ? t8[k + 4] : t8[k]) + __shfl_xor(t ? t8[k] : t8[k + 4], 16); }
        *(f32x4*)(opre + (size_t)n * DM + coff + 8 * (lane >> 5) + 4 * ((lane >> 4) & 1)) = t4;
        const float ss = wave_sum((t4[0] * t4[0] + t4[1] * t4[1]) + (t4[2] * t4[2] + t4[3] * t4[3]));
        if (lane == 0) ssp[(size_t)x * SEQ + n] = ss;
    }
}
__device__ __forceinline__ void p14_final(const Args& A, Frame& F) {
    const float* opre = (const float*)(F.ws + WS_OPRE); const float* ssp = (const float*)(F.ws + WS_SSP);
    int n = F.gw; if (n >= SEQ) return;
    f32x4 gnp[8];
#pragma unroll
    for (int j = 0; j < 8; ++j) { const int col = 4 * F.lane + 256 * j; gnp[j] = mod4(A, F, 0, 5 * DM + col) * *(const f32x4*)(A.in[9] + col); }
    for (; n < SEQ; n += F.NGW) {
        const float ss = wave_sum(F.lane < 8 ? ssp[(size_t)F.lane * SEQ + n] : 0.f);
        const float rstd = rsqrtf(ss * (1.f / DM) + EPS);
        const f32x4* pr = (const f32x4*)(opre + (size_t)n * DM) + F.lane; f32x4* orow = (f32x4*)(F.out + (size_t)n * DM) + F.lane;
        f32x4 p[8], xo[8];
#pragma unroll
        for (int j = 0; j < 8; ++j) { p[j] = pr[64 * j]; xo[j] = orow[64 * j]; }
#pragma unroll
        for (int j = 0; j < 8; ++j) orow[64 * j] = xo[j] + gnp[j] * p[j] * rstd;
    }
}
constexpr int NPH = 16;
constexpr int CW_BAR = 4096;
constexpr int MAX_LAUNCHES = 3;
static_assert((CW_BAR + MAX_LAUNCHES * XCD_BAR_WORDS) * 4 <= (int)CTL_ZERO_BYTES, "barrier words inside the memset region");
__device__ __forceinline__ bool refresh_ids(Frame& F) { int t = threadIdx.x; asm volatile("" : "+v"(t)); F.tid = t; F.lane = t & 63; return true; }
__global__ void __launch_bounds__(NTHR, 2) hybrid_fwd(Args args) {
    extern __shared__ __attribute__((aligned(16))) unsigned char lds[];
    Frame F;
    F.lds = (LAS unsigned char*)lds; F.ldsg = (char*)lds;
    F.tid = threadIdx.x; F.lane = F.tid & 63; F.wave = __builtin_amdgcn_readfirstlane(F.tid >> 6);
    F.G = gridDim.x; { const int bx = blockIdx.x; F.vcu = (F.G % 8 == 0) ? (bx % 8) * (F.G / 8) + bx / 8 : bx; }
    F.gw = F.vcu * NWAVES + F.wave; F.NGW = F.G * NWAVES;
    F.out = args.out; F.ws = args.ws;
    volatile LAS unsigned* MISC = (volatile LAS unsigned*)(F.lds + MISC_OFF);
    for (int u = F.tid; u < 64; u += NTHR) MISC[u] = 0u;
    __syncthreads();
    unsigned* ctl = (unsigned*)(F.ws + WS_CTL);
    XcdBarrier bar = xcd_barrier_post(ctl + CW_BAR + args.li * XCD_BAR_WORDS, MISC + 8);
    const int lo = args.ph_lo, hi = args.ph_hi;
#define IN(k) (lo <= (k) && (k) < hi && refresh_ids(F))
#define SEAM(k) do { if (IN(k) && IN((k) + 1)) xcd_barrier(bar); } while (0)

    if (IN(0)) { p0_prologue(args, F); } SEAM(0);
    if (IN(1)) { p1_rows(args, F); } SEAM(1);
    if (IN(2)) {
        p2_ctx_unit(F);
        pg8::Gemm g{(const bf16*)(F.ws + WS_U), (const bf16*)(F.ws + WS_WIN), SEQ, INCOLS, DM}; pg8::StaticOrder S; S.init(SEQ, INCOLS, F.G, (int)blockIdx.x);
        pg8::EpiSplit1 E{(bf16*)(F.ws + WS_PHY), (long)(WS_QRAW - WS_PHY) / 2, (long)(WS_KRAW - WS_PHY) / 2, (long)(WS_V2 - WS_PHY) / 2, (long)(WS_GATES - WS_PHY) / 2};
        pg8::gemm_phase<pg8::EpiSplit1, pg8::StaticOrder, true, true>(F.lds, g, S, E);
    } SEAM(2);
    if (IN(3)) { p3_post(args, F, F.gw, F.NGW); } SEAM(3);
    if (IN(4)) {
        const int x = F.vcu >> 5, qb = F.vcu & 31;
        if (F.G == 256) {
#pragma unroll 1
            for (int i = 0; i < 2; ++i) { const int hm = 2 * x + i;
                att::attn_unit((const bf16*)(F.ws + WS_Q2) + (size_t)(qb * 256) * 1024 + hm * 64, (const bf16*)(F.ws + WS_K2) + hm * 64,
                               (const bf16*)(F.ws + WS_V2) + (hm >> 1) * 128, (float*)(F.ws + WS_O) + (size_t)(qb * 256) * 2048 + hm * 128, NKEYS, F.ldsg); }
#ifdef ATT_VAR
            { const int hm = 2 * x;
                att::attn_unit<ATT_VAR>((const bf16*)(F.ws + WS_Q2) + (size_t)(qb * 256) * 1024 + hm * 64, (const bf16*)(F.ws + WS_K2) + hm * 64,
                               (const bf16*)(F.ws + WS_V2) + (hm >> 1) * 128, (float*)(F.ws + WS_KSPEC), NKEYS, F.ldsg); }
#endif
        }
    }
    if (IN(5)) {
#pragma unroll 1
        for (int pr = F.vcu; pr < HYW / 2; pr += F.G)
            fftc::conv_pair(F.lds, F.tid, pr, (const float*)(F.ws + WS_TAPF), (const float*)(F.ws + WS_TAPB), (const bf16*)(F.ws + WS_UHT), (bf16*)(F.ws + WS_YCT));
    } SEAM(5);
    if (IN(6)) { p5_finalize(args, F); } SEAM(6);
    if (IN(7)) {
        pg8::StaticOrder S; S.init(SEQ, DM, F.G, (int)blockIdx.x);
        { pg8::Gemm g{(const bf16*)(F.ws + WS_YHY), (const bf16*)(F.ws + WS_WHY), SEQ, DM, HYW};
          pg8::EpiGate<0> E{(bf16*)(F.ws + WS_MB), DM, (const bf16*)(F.ws + WS_GATES), 4096};
          pg8::gemm_phase<pg8::EpiGate<0>, pg8::StaticOrder, true, true>(F.lds, g, S, E); }
        { pg8::Gemm g{(const bf16*)(F.ws + WS_YDA), (const bf16*)(F.ws + WS_WDA), SEQ, DM, HYW};
          pg8::EpiGate<1> E{(bf16*)(F.ws + WS_MB), DM, (const bf16*)(F.ws + WS_GATES) + 2048, 4096};
          pg8::gemm_phase<pg8::EpiGate<1>, pg8::StaticOrder, true, true>(F.lds, g, S, E); }
    } SEAM(7);
    if (IN(8)) {
        pg8::Gemm g{(const bf16*)(F.ws + WS_MB), (const bf16*)(F.ws + WS_WO), SEQ, DM, DM}; pg8::StaticOrder S; S.init(SEQ, DM, F.G, (int)blockIdx.x);
        pg8::EpiF32 E{(float*)(F.ws + WS_MIX), DM};
        pg8::gemm_phase<pg8::EpiF32, pg8::StaticOrder, true, true>(F.lds, g, S, E);
    } SEAM(8);
    if (IN(9)) { p8_rows(args, F); } SEAM(9);
    if (IN(10)) {
        pg8::Gemm g{(const bf16*)(F.ws + WS_HB), (const bf16*)(F.ws + WS_WQ), SEQ, DM, DM}; pg8::StaticOrder S; S.init(SEQ, DM, F.G, (int)blockIdx.x);
        pg8::EpiF32 E{(float*)(F.ws + WS_QP), DM};
        pg8::gemm_phase<pg8::EpiF32, pg8::StaticOrder, true, true>(F.lds, g, S, E);
    } SEAM(10);
    if (IN(11)) {
#pragma unroll 1
        for (int it = F.vcu; it < 256; it += F.G) p11_item(args, F, it);
    } SEAM(11);
    if (IN(12)) { p12_coldots(args, F); } SEAM(12);
    if (IN(13)) { p12b_weights(args, F); } SEAM(13);
    if (IN(14)) { p13_colsum(args, F); } SEAM(14);
    if (IN(15)) { p14_final(args, F); }
#undef IN
#undef SEAM
}

#ifndef PROBE_PH
#define PROBE_PH -1
#endif
extern "C" void kernel_launch(void* const* d_in, const int* in_sizes, int n_in, void* d_out, int out_size, void* d_ws, size_t ws_size, hipStream_t stream) {
    static int grid = 0;
    if (grid == 0) {
        if (n_in != 31 || in_sizes[0] != SEQ * DM || out_size != SEQ * DM || ws_size < WS_END) {
            fprintf(stderr, "kernel_launch: built for 31 inputs, x/out of %d floats, >= %zu bytes of workspace; got n_in %d, in0 %d, out %d, ws %zu; nothing launched\n",
                    SEQ * DM, (size_t)WS_END, n_in, n_in > 0 ? in_sizes[0] : -1, out_size, ws_size); grid = -1; return; }
        int dev = 0, cus = 0, per_cu = 0;
        if (hipGetDevice(&dev) != hipSuccess || hipDeviceGetAttribute(&cus, hipDeviceAttributeMultiprocessorCount, dev) != hipSuccess) { fprintf(stderr, "kernel_launch: device query failed\n"); grid = -1; return; }
        if (hipFuncSetAttribute((const void*)hybrid_fwd, hipFuncAttributeMaxDynamicSharedMemorySize, LDS_BYTES) != hipSuccess) { fprintf(stderr, "kernel_launch: hipFuncSetAttribute failed\n"); grid = -1; return; }
        if (hipOccupancyMaxActiveBlocksPerMultiprocessor(&per_cu, (const void*)hybrid_fwd, NTHR, LDS_BYTES) != hipSuccess || per_cu < 1) {
            fprintf(stderr, "kernel_launch: occupancy query reports %d workgroups per CU; nothing launched\n", per_cu); (void)hipGetLastError(); grid = -1; return; }
        grid = cus;
        if (grid != 256) fprintf(stderr, "kernel_launch: note: %d CUs (tuned for 256)\n", grid);
    }
    if (grid < 0) return;
    if (hipMemsetAsync((char*)d_ws + WS_CTL, 0, CTL_ZERO_BYTES, stream) != hipSuccess) { fprintf(stderr, "kernel_launch: hipMemsetAsync failed\n"); return; }
    Args a{};
    for (int i = 0; i < 31; ++i) a.in[i] = (const float*)d_in[i];
    a.out = (float*)d_out; a.ws = (unsigned char*)d_ws;
    constexpr int NL = (PROBE_PH >= 0) ? 3 : 1;
    const int cut[4] = {0, (PROBE_PH >= 0) ? PROBE_PH + 1 : NPH, (PROBE_PH >= 0) ? PROBE_PH + 1 : NPH, NPH};
    for (int li = 0; li < NL; ++li) {
        a.ph_lo = (li == 1) ? PROBE_PH : cut[li]; a.ph_hi = cut[li + 1]; a.li = li;
        if (a.ph_lo >= a.ph_hi) continue;
        hipLaunchKernelGGL(hybrid_fwd, dim3(grid), dim3(NTHR), LDS_BYTES, stream, a);
        const hipError_t le = hipPeekAtLastError();
        if (le != hipSuccess) { fprintf(stderr, "kernel_launch: launch %d failed: %s\n", li, hipGetErrorName(le)); break; }
    }
}
```

```cpp
#include <hip/hip_runtime.h>
#include <hip/hip_bf16.h>
#include <cstdio>
#include <cstdint>
namespace pg8 {
#define PG8_LAS __attribute__((address_space(3)))
typedef unsigned short bf16_t;
typedef short bf16x8 __attribute__((ext_vector_type(8)));
typedef float f32x4 __attribute__((ext_vector_type(4)));
typedef unsigned u32x4 __attribute__((ext_vector_type(4)));
constexpr int BM = 256, BK = 64, HALF = 128, HTB = HALF * BK * 2  , STAGE_BYTES = 8 * HTB, NXCD = 8, WGM = 8;

__host__ __device__ __forceinline__ int lds_byte(int r, int c) { const int st = (r >> 4) * 2 + (c >> 5), rr = r & 15, cc = c & 31, ob = rr * 64 + cc * 2; return st * 1024 + (ob ^ (((ob >> 9) & 1) << 5)); }
__host__ __device__ __forceinline__ void stage_rc(int b, int& R, int& C) { const int st = b / 1024, sb = b % 1024, swz = sb ^ (((sb >> 9) & 1) << 5); R = (st >> 1) * 16 + swz / 64; C = (st & 1) * 32 + (swz % 64) / 2; }
__host__ __device__ __forceinline__ int perm32(int rho) { const int n = rho >> 4, i = rho & 15; return 8 * (i >> 2) + 4 * n + (i & 3); }

struct Unit { int pm, pn; };
struct Gemm { const bf16_t* A; const bf16_t* Bt; int M, N, K; };

struct StaticOrder {
    int nM, nN, nwg, G, c;
    __host__ __device__ void init(int M, int N, int G_, int c_) { nM = M / BM; nN = N / BM; nwg = nM * nN; G = G_; c = c_; }
    __host__ __device__ bool next(int i, Unit& u) const {
        const long L = (long)i * G + c; if (L >= nwg) return false;
        int wgid = (int)L; { const int q = nwg / NXCD, r = nwg % NXCD, xcd = wgid % NXCD, off = wgid / NXCD; wgid = (xcd < r ? xcd * (q + 1) : r * (q + 1) + (xcd - r) * q) + off; }
        const int nig = WGM * nN, gid = wgid / nig, fm = gid * WGM, gsz = (nM - fm) < WGM ? (nM - fm) : WGM;
        u.pm = fm + ((wgid % nig) % gsz); u.pn = (wgid % nig) / gsz; return true;
    }
    __device__ __forceinline__ void a_ready(const Unit&) const {}
    __device__ __forceinline__ void done(const Unit&) const {}
};

__device__ __forceinline__ unsigned cvt_pk_bf16(float lo, float hi) { unsigned r; asm volatile("v_cvt_pk_bf16_f32 %0, %1, %2" : "=v"(r) : "v"(lo), "v"(hi)); return r; }
typedef float f32x2 __attribute__((ext_vector_type(2)));
__device__ __forceinline__ float bflo(unsigned w) { return __builtin_bit_cast(float, w << 16); }
__device__ __forceinline__ float bfhi(unsigned w) { return __builtin_bit_cast(float, w & 0xffff0000u); }
__device__ __forceinline__ float sigm(float x) { return 1.f / (1.f + __expf(-x)); }
struct EpiSplit1 {
    static constexpr bool PERM = true, AFTER_DRAIN = false;
    bf16_t* phy; long dq, dk, dv, dg;
    __device__ __forceinline__ void operator()(const f32x4 (&acc)[2][2][4][2], const Unit& u, int wr, int wc, int fr, int fq) const {
        const int pn = u.pn; const bool ctx = (u.pm == 32);
        const int s1 = pn >= 12, s2 = pn >= 16, s3 = pn >= 20, s4 = pn >= 24;
        bf16_t* base = phy + (long)s1 * dq + (long)s2 * (dk - dq) + (long)s3 * (dv - dk) + (long)s4 * (dg - dv);
        const int ldc = 3072 - s1 * 2048 + s4 * 3072;
        const int colt = (pn - 12 * s1 - 4 * s2 - 4 * s3 - 4 * s4) * 256;
        const bool lat_only = !(s2 && !s4);
        const int rowoff = (s3 && !s4) ? (ctx ? -8192 : 256) : 0;
        if (ctx && lat_only) return;
        const int row0 = u.pm * BM + wr * 64 + fr + rowoff, col0 = colt + wc * 32 + 8 * fq;
#pragma unroll
        for (int ai = 0; ai < 2; ++ai)
#pragma unroll
            for (int m = 0; m < 4; ++m) { bf16_t* rowp = base + (size_t)(row0 + ai * HALF + m * 16) * ldc + col0;
#pragma unroll
                for (int bj = 0; bj < 2; ++bj) { const f32x4 v0 = acc[ai][bj][m][0], v1 = acc[ai][bj][m][1];
                    u32x4 w; w.x = cvt_pk_bf16(v0[0], v0[1]); w.y = cvt_pk_bf16(v0[2], v0[3]); w.z = cvt_pk_bf16(v1[0], v1[1]); w.w = cvt_pk_bf16(v1[2], v1[3]);
                    *(u32x4*)(rowp + bj * HALF) = w; } }
    }
};
template <int MODE> struct EpiGate {
    static constexpr bool PERM = true, AFTER_DRAIN = false;
    bf16_t* O; int ldc; const bf16_t* G; int ldg;
    __device__ __forceinline__ void operator()(const f32x4 (&acc)[2][2][4][2], const Unit& u, int wr, int wc, int fr, int fq) const {
        const int row0 = u.pm * BM + wr * 64 + fr, col0 = u.pn * BM + wc * 32 + 8 * fq;
#pragma unroll
        for (int ai = 0; ai < 2; ++ai)
#pragma unroll
            for (int m = 0; m < 4; ++m) { const size_t r = (size_t)(row0 + ai * HALF + m * 16);
#pragma unroll
                for (int bj = 0; bj < 2; ++bj) { const f32x4 v0 = acc[ai][bj][m][0], v1 = acc[ai][bj][m][1];
                    const u32x4 g = *(const u32x4*)(G + r * ldg + col0 + bj * HALF);
                    float o[8] = { sigm(bflo(g.x)) * v0[0], sigm(bfhi(g.x)) * v0[1], sigm(bflo(g.y)) * v0[2], sigm(bfhi(g.y)) * v0[3],
                                   sigm(bflo(g.z)) * v1[0], sigm(bfhi(g.z)) * v1[1], sigm(bflo(g.w)) * v1[2], sigm(bfhi(g.w)) * v1[3] };
                    u32x4* op = (u32x4*)(O + r * ldc + col0 + bj * HALF);
                    if (MODE == 1) { const u32x4 p = *op; o[0] += bflo(p.x); o[1] += bfhi(p.x); o[2] += bflo(p.y); o[3] += bfhi(p.y); o[4] += bflo(p.z); o[5] += bfhi(p.z); o[6] += bflo(p.w); o[7] += bfhi(p.w); }
                    u32x4 w; w.x = cvt_pk_bf16(o[0], o[1]); w.y = cvt_pk_bf16(o[2], o[3]); w.z = cvt_pk_bf16(o[4], o[5]); w.w = cvt_pk_bf16(o[6], o[7]);
                    *op = w; } }
    }
};
struct EpiF32 {
    static constexpr bool PERM = true, AFTER_DRAIN = false;
    float* O; int ldc;
    __device__ __forceinline__ void operator()(const f32x4 (&acc)[2][2][4][2], const Unit& u, int wr, int wc, int fr, int fq) const {
        const int row0 = u.pm * BM + wr * 64 + fr, col0 = u.pn * BM + wc * 32 + 8 * fq;
#pragma unroll
        for (int ai = 0; ai < 2; ++ai)
#pragma unroll
            for (int m = 0; m < 4; ++m) { float* rowp = O + (size_t)(row0 + ai * HALF + m * 16) * ldc + col0;
#pragma unroll
                for (int bj = 0; bj < 2; ++bj) { *(f32x4*)(rowp + bj * HALF) = acc[ai][bj][m][0]; *(f32x4*)(rowp + bj * HALF + 4) = acc[ai][bj][m][1]; } }
    }
};
struct EpiBf16 {
    static constexpr bool PERM = true, AFTER_DRAIN = false;
    bf16_t* O; int ldc;
    __device__ __forceinline__ void operator()(const f32x4 (&acc)[2][2][4][2], const Unit& u, int wr, int wc, int fr, int fq) const {
        const int row0 = u.pm * BM + wr * 64 + fr, col0 = u.pn * BM + wc * 32 + 8 * fq;
#pragma unroll
        for (int ai = 0; ai < 2; ++ai)
#pragma unroll
            for (int m = 0; m < 4; ++m) { bf16_t* rowp = O + (size_t)(row0 + ai * HALF + m * 16) * ldc + col0;
#pragma unroll
                for (int bj = 0; bj < 2; ++bj) { const f32x4 v0 = acc[ai][bj][m][0], v1 = acc[ai][bj][m][1];
                    u32x4 w; w.x = cvt_pk_bf16(v0[0], v0[1]); w.y = cvt_pk_bf16(v0[2], v0[3]); w.z = cvt_pk_bf16(v1[0], v1[1]); w.w = cvt_pk_bf16(v1[2], v1[3]);
                    *(u32x4*)(rowp + bj * HALF) = w; } }
    }
};
struct EpiCtxKV {
    static constexpr bool PERM = true, AFTER_DRAIN = false;
    bf16_t* k2; long dv;
    __device__ __forceinline__ void operator()(const f32x4 (&acc)[2][2][4][2], const Unit& u, int wr, int wc, int fr, int fq) const {
        const int isv = u.pn >= 20; bf16_t* base = k2 + (long)isv * dv;
        const int row0 = wr * 64 + fr, col0 = (u.pn - 16 - 4 * isv) * 256 + wc * 32 + 8 * fq;
#pragma unroll
        for (int ai = 0; ai < 2; ++ai)
#pragma unroll
            for (int m = 0; m < 4; ++m) { bf16_t* rowp = base + (size_t)(row0 + ai * HALF + m * 16) * 1024 + col0;
#pragma unroll
                for (int bj = 0; bj < 2; ++bj) { const f32x4 v0 = acc[ai][bj][m][0], v1 = acc[ai][bj][m][1];
                    u32x4 w; w.x = cvt_pk_bf16(v0[0], v0[1]); w.y = cvt_pk_bf16(v0[2], v0[3]); w.z = cvt_pk_bf16(v1[0], v1[1]); w.w = cvt_pk_bf16(v1[2], v1[3]);
                    *(u32x4*)(rowp + bj * HALF) = w; } }
    }
};
struct OneUnit {
    int pm, pn;
    __device__ __forceinline__ bool next(int i, Unit& u) const { if (i) return false; u.pm = pm; u.pn = pn; return true; }
    __device__ __forceinline__ void a_ready(const Unit&) const {}
    __device__ __forceinline__ void done(const Unit&) const {}
};
template <class Epi, class Sched, bool ALIGN_EPI = false, bool SP2 = false>
__device__ __forceinline__ void gemm_phase(PG8_LAS unsigned char* lds, const Gemm g, const Sched& S, const Epi& E) {
    const int tid = threadIdx.x, wid = __builtin_amdgcn_readfirstlane(tid >> 6), lane = tid & 63, wr = wid >> 2, wc = wid & 3, fr = lane & 15, fq = lane >> 4;
    const int K = g.K, nt = K / BK;
    unsigned voffA[2], voffB[2];
#pragma unroll
    for (int i = 0; i < 2; ++i) { int R, C; stage_rc(tid * 16 + i * 8192, R, C); const int Rb = Epi::PERM ? ((R & ~31) + perm32(R & 31)) : R;
        voffA[i] = (unsigned)(R * K + C) * 2u; voffB[i] = (unsigned)(Rb * K + C) * 2u; }
    const size_t kstep = (size_t)(BK * 2);
    const size_t hstep = (size_t)HALF * K * 2;
    const size_t tstep = 2 * hstep;
    const unsigned ldsw = (unsigned)wid * 1024u;
    const int aoff = lds_byte(wr * 64 + fr, fq * 8), boff = lds_byte(wc * 32 + fr, fq * 8);
#define PG8_SA(b, h) (((b) * 2 + (h)) * HTB)
#define PG8_SB(b, h) ((4 + (b) * 2 + (h)) * HTB)
#define PG8_STAGE(bufoff, gbase, voff) do { _Pragma("unroll") for (int _i = 0; _i < 2; ++_i) \
        __builtin_amdgcn_global_load_lds((const unsigned*)((const char*)(gbase) + (voff)[_i]), (PG8_LAS unsigned*)(lds + (bufoff) + ldsw + _i * 8192), 16, 0, 0); } while (0)
#define PG8_LDA(dst, b, h) do { _Pragma("unroll") for (int m = 0; m < 4; ++m) _Pragma("unroll") for (int k = 0; k < 2; ++k) dst[m][k] = *(const PG8_LAS bf16x8*)(lds + PG8_SA(b, h) + aoff + m * 2048 + k * 1024); } while (0)
#define PG8_LDB(dst, b, h) do { _Pragma("unroll") for (int n = 0; n < 2; ++n) _Pragma("unroll") for (int k = 0; k < 2; ++k) dst[n][k] = *(const PG8_LAS bf16x8*)(lds + PG8_SB(b, h) + boff + n * 2048 + k * 1024); } while (0)
#define PG8_MMA(ai, bj, At, Bt) do { __builtin_amdgcn_s_setprio(1); _Pragma("unroll") for (int m = 0; m < 4; ++m) _Pragma("unroll") for (int n = 0; n < 2; ++n) _Pragma("unroll") for (int k = 0; k < 2; ++k) \
        acc[ai][bj][m][n] = __builtin_amdgcn_mfma_f32_16x16x32_bf16(Bt[n][k], At[m][k], acc[ai][bj][m][n], 0, 0, 0); __builtin_amdgcn_s_setprio(0); } while (0)
#define PG8_WAIT_V(n) asm volatile("s_waitcnt vmcnt(" #n ")" ::: "memory")
#define PG8_WAIT_L(n) asm volatile("s_waitcnt lgkmcnt(" #n ")" ::: "memory")
#define PG8_BAR __builtin_amdgcn_s_barrier()
#define PG8_SCHED __builtin_amdgcn_sched_barrier(0)
    Unit cur, nxt; int ui = 0;
    if (!S.next(0, cur)) return;
    f32x4 acc[2][2][4][2];
#pragma unroll
    for (int a = 0; a < 2; ++a)
#pragma unroll
        for (int b = 0; b < 2; ++b)
#pragma unroll
            for (int m = 0; m < 4; ++m)
#pragma unroll
                for (int n = 0; n < 2; ++n) acc[a][b][m][n] = (f32x4){0.f, 0.f, 0.f, 0.f};
    bf16x8 At[4][2], B0[2][2], B1[2][2];
    const char* cA = (const char*)g.A + (size_t)cur.pm * tstep; const char* cB = (const char*)g.Bt + (size_t)cur.pn * tstep;
    S.a_ready(cur);
    if constexpr (SP2) {
        PG8_STAGE(PG8_SB(0, 0), cB, voffB); PG8_STAGE(PG8_SB(0, 1), cB + hstep, voffB); PG8_STAGE(PG8_SA(0, 0), cA, voffA); PG8_STAGE(PG8_SA(0, 1), cA + hstep, voffA);
        if (wr == 1) PG8_BAR;
        PG8_WAIT_V(2); PG8_BAR;
        PG8_STAGE(PG8_SB(1, 0), cB + kstep, voffB); PG8_STAGE(PG8_SA(1, 0), cA + kstep, voffA); PG8_STAGE(PG8_SB(1, 1), cB + hstep + kstep, voffB);
        PG8_WAIT_V(6); PG8_BAR;
    } else {
        PG8_STAGE(PG8_SB(0, 0), cB, voffB); PG8_STAGE(PG8_SA(0, 0), cA, voffA); PG8_STAGE(PG8_SB(0, 1), cB + hstep, voffB); PG8_STAGE(PG8_SA(0, 1), cA + hstep, voffA);
        if (wr == 1) PG8_BAR;
        PG8_WAIT_V(4); PG8_BAR;
        PG8_STAGE(PG8_SB(1, 0), cB + kstep, voffB); PG8_STAGE(PG8_SA(1, 0), cA + kstep, voffA); PG8_STAGE(PG8_SB(1, 1), cB + hstep + kstep, voffB);
        PG8_WAIT_V(6); PG8_BAR;
    }
    for (;;) {
        const bool has_next = S.next(ui + 1, nxt);
        const char* nA = has_next ? (const char*)g.A + (size_t)nxt.pm * tstep : cA; const char* nB = has_next ? (const char*)g.Bt + (size_t)nxt.pn * tstep : cB;
        for (int t = 0; t < nt; t += 2) {
            const bool last = (t == nt - 2);
            const char* a1 = cA + (size_t)(t + 1) * kstep;
            const char* a2 = last ? nA : cA + (size_t)(t + 2) * kstep; const char* b2 = last ? nB : cB + (size_t)(t + 2) * kstep;
            const char* a3 = a2 + kstep; const char* b3 = b2 + kstep;
            if (last && has_next) S.a_ready(nxt);
            if constexpr (SP2) {
            PG8_LDB(B0, 0, 0); PG8_LDB(B1, 0, 1); PG8_SCHED; PG8_LDA(At, 0, 0); PG8_STAGE(PG8_SA(1, 1), a1 + hstep, voffA);
            PG8_WAIT_V(8); PG8_WAIT_L(0); PG8_BAR; PG8_MMA(0, 0, At, B0); PG8_MMA(0, 1, At, B1); PG8_BAR; PG8_SCHED;
            PG8_LDA(At, 0, 1); PG8_STAGE(PG8_SB(0, 0), b2, voffB); PG8_STAGE(PG8_SB(0, 1), b2 + hstep, voffB); PG8_STAGE(PG8_SA(0, 0), a2, voffA);
            PG8_WAIT_V(8); PG8_WAIT_L(0); PG8_BAR; PG8_MMA(1, 0, At, B0); PG8_MMA(1, 1, At, B1); PG8_BAR; PG8_SCHED;
            PG8_LDB(B0, 1, 0); PG8_LDB(B1, 1, 1); PG8_SCHED; PG8_LDA(At, 1, 0); PG8_STAGE(PG8_SA(0, 1), a2 + hstep, voffA);
            PG8_WAIT_V(8); PG8_WAIT_L(0); PG8_BAR; PG8_MMA(0, 0, At, B0); PG8_MMA(0, 1, At, B1); PG8_BAR; PG8_SCHED;
            PG8_LDA(At, 1, 1); PG8_STAGE(PG8_SB(1, 0), b3, voffB); PG8_STAGE(PG8_SB(1, 1), b3 + hstep, voffB); PG8_STAGE(PG8_SA(1, 0), a3, voffA);
            PG8_WAIT_V(8); PG8_WAIT_L(0); PG8_BAR; PG8_MMA(1, 0, At, B0); PG8_MMA(1, 1, At, B1); PG8_BAR; PG8_SCHED;
            } else {
            PG8_LDB(B0, 0, 0); PG8_SCHED; PG8_LDA(At, 0, 0); PG8_STAGE(PG8_SA(1, 1), a1 + hstep, voffA);
            PG8_WAIT_L(8); PG8_BAR; PG8_WAIT_L(0); PG8_MMA(0, 0, At, B0); PG8_BAR; PG8_SCHED;
            PG8_LDB(B1, 0, 1); PG8_STAGE(PG8_SB(0, 0), b2, voffB);
            PG8_BAR; PG8_WAIT_L(0); PG8_MMA(0, 1, At, B1); PG8_BAR;
            PG8_LDA(At, 0, 1); PG8_STAGE(PG8_SA(0, 0), a2, voffA);
            PG8_BAR; PG8_WAIT_L(0); PG8_MMA(1, 0, At, B0); PG8_BAR; PG8_SCHED;
            PG8_STAGE(PG8_SB(0, 1), b2 + hstep, voffB);
            PG8_WAIT_V(6); PG8_BAR; PG8_MMA(1, 1, At, B1); PG8_BAR;
            PG8_LDB(B0, 1, 0); PG8_SCHED; PG8_LDA(At, 1, 0); PG8_STAGE(PG8_SA(0, 1), a2 + hstep, voffA);
            PG8_WAIT_L(8); PG8_BAR; PG8_WAIT_L(0); PG8_MMA(0, 0, At, B0); PG8_BAR; PG8_SCHED;
            PG8_LDB(B1, 1, 1); PG8_STAGE(PG8_SB(1, 0), b3, voffB);
            PG8_BAR; PG8_WAIT_L(0); PG8_MMA(0, 1, At, B1); PG8_BAR;
            PG8_LDA(At, 1, 1); PG8_STAGE(PG8_SA(1, 0), a3, voffA);
            PG8_BAR; PG8_WAIT_L(0); PG8_MMA(1, 0, At, B0); PG8_BAR; PG8_SCHED;
            PG8_STAGE(PG8_SB(1, 1), b3 + hstep, voffB);
            PG8_WAIT_V(6); PG8_BAR; PG8_MMA(1, 1, At, B1); PG8_BAR;
            }
        }
        if constexpr (ALIGN_EPI) { if (wr == 0) PG8_BAR; }
        if constexpr (!Epi::AFTER_DRAIN) { E(acc, cur, wr, wc, fr, fq); S.done(cur); }
        if (!has_next) break;
#pragma unroll
        for (int a = 0; a < 2; ++a)
#pragma unroll
            for (int b = 0; b < 2; ++b)
#pragma unroll
                for (int m = 0; m < 4; ++m)
#pragma unroll
                    for (int n = 0; n < 2; ++n) acc[a][b][m][n] = (f32x4){0.f, 0.f, 0.f, 0.f};
        cur = nxt; cA = nA; cB = nB; ++ui;
        if constexpr (ALIGN_EPI) { if (wr == 1) PG8_BAR; }
    }
    PG8_WAIT_V(0);
    if constexpr (!ALIGN_EPI) { if (wr == 0) PG8_BAR; }
    PG8_BAR;
    if constexpr (Epi::AFTER_DRAIN) { E.fused(acc, cur, wr, wc, fr, fq, lds, wid, lane); S.done(cur); }
#undef PG8_SA
#undef PG8_SB
#undef PG8_STAGE
#undef PG8_LDA
#undef PG8_LDB
#undef PG8_MMA
#undef PG8_WAIT_V
#undef PG8_WAIT_L
#undef PG8_BAR
#undef PG8_SCHED
}
}
namespace att {
using bf16x8 = __attribute__((ext_vector_type(8))) short;
using s16x4  = __attribute__((ext_vector_type(4))) short;
using f32x16 = __attribute__((ext_vector_type(16))) float;
using u32x4  = __attribute__((ext_vector_type(4))) unsigned;
constexpr int DQK = 64, DV = 128, NW = 8, QBLK = 32, KVBLK = 64;
constexpr float SCALE = 0.125f;
constexpr float C2 = 0.125f * 1.4426950408889634f;
constexpr float THR2 = 11.5f;
constexpr int LDQ = 1024, LDK = 1024, LDO = 2048;
constexpr size_t SHM_V = KVBLK * DV * 2, SHM_K = KVBLK * DQK * 2, SHM_ATTN = 3 * SHM_V + 3 * SHM_K + NW * 64 * 4;
#define KSWZ64(row, ch) ((row) * 128 + ((((ch) ^ ((row) >> 1)) & 7) << 4))
#define SBAR() __builtin_amdgcn_sched_barrier(0)
__device__ __forceinline__ int crow(int r, int hi) { return (r & 3) + 8 * (r >> 2) + 4 * hi; }
__device__ __forceinline__ unsigned cvtpk(float lo, float hi) { unsigned r; asm volatile("v_cvt_pk_bf16_f32 %0, %1, %2" : "=v"(r) : "v"(lo), "v"(hi)); return r; }

#define MX3(a, b, c) __builtin_fmaxf(__builtin_fmaxf((a), (b)), (c))
__device__ __forceinline__ float rowmax32(const f32x16& p0, const f32x16& p1) {
  float a = MX3(p0[0], p0[1], p1[0]), b = MX3(p0[2], p0[3], p1[1]); a = MX3(a, p1[2], p1[3]);
#pragma unroll
  for (int r = 4; r < 16; r += 4) { a = MX3(a, p0[r], p0[r + 1]); b = MX3(b, p0[r + 2], p0[r + 3]); a = MX3(a, p1[r], p1[r + 1]); b = MX3(b, p1[r + 2], p1[r + 3]); }
  float m = __builtin_fmaxf(a, b);
  { auto rr = __builtin_amdgcn_permlane32_swap(__float_as_uint(m), __float_as_uint(m), false, false);
    m = __builtin_fmaxf(__uint_as_float(rr[0]), __uint_as_float(rr[1])); }
  return m;
}
template <bool FIRST, int VAR = 0> __device__ __forceinline__ void partialSM(f32x16& p0, f32x16& p1, float& m_ref, f32x16& negm, float& alpha) {
  const float pmax = rowmax32(p0, p1);
  alpha = 1.f;
  if (FIRST || __builtin_expect(__any(pmax > THR2), 0)) {
    const float d = FIRST ? pmax : __builtin_fmaxf(pmax, 0.f);
    m_ref += d;
#pragma unroll
    for (int r = 0; r < 16; ++r) { p0[r] -= d; p1[r] -= d; }
#pragma unroll
    for (int r = 0; r < 16; ++r) negm[r] = -m_ref;
    if (!FIRST) alpha = __builtin_amdgcn_exp2f(-d);
  }
#pragma unroll
  for (int r = 0; r < 16; ++r) p0[r] = (VAR == 1) ? p0[r] * 0.001f : __builtin_amdgcn_exp2f(p0[r]);
}
template <int VAR = 0> __device__ __forceinline__ void finishSM(f32x16& p0, f32x16& p1, bf16x8& pa0, bf16x8& pa1, bf16x8& pa2, bf16x8& pa3) {
#pragma unroll
  for (int r = 0; r < 16; ++r) p1[r] = (VAR == 1) ? p1[r] * 0.001f : __builtin_amdgcn_exp2f(p1[r]);
#define PK4(P, BASE, OUT) do { unsigned a0 = cvtpk(P[BASE + 0], P[BASE + 1]), a1 = cvtpk(P[BASE + 2], P[BASE + 3]);   \
    unsigned b0 = cvtpk(P[BASE + 4], P[BASE + 5]), b1 = cvtpk(P[BASE + 6], P[BASE + 7]);                              \
    auto r0 = __builtin_amdgcn_permlane32_swap(a0, b0, false, false); auto r1 = __builtin_amdgcn_permlane32_swap(a1, b1, false, false); \
    u32x4 w = {r0[0], r1[0], r0[1], r1[1]}; OUT = *reinterpret_cast<bf16x8*>(&w); } while (0)
  PK4(p0, 0, pa0); PK4(p0, 8, pa1); PK4(p1, 0, pa2); PK4(p1, 8, pa3);
#undef PK4
}
__device__ __forceinline__ void qkt(f32x16& p0, f32x16& p1, const char* Ks, const bf16x8* qr, const f32x16& negm, int r32, int hi) {
#pragma unroll
  for (int d0 = 0; d0 < 4; ++d0) { const int ch = d0 * 2 + hi;
    bf16x8 b0 = *reinterpret_cast<const bf16x8*>(Ks + KSWZ64(r32, ch));
    bf16x8 b1 = *reinterpret_cast<const bf16x8*>(Ks + KSWZ64(32 + r32, ch));
    if (d0 == 0) { p0 = __builtin_amdgcn_mfma_f32_32x32x16_bf16(b0, qr[0], negm, 0, 0, 0); p1 = __builtin_amdgcn_mfma_f32_32x32x16_bf16(b1, qr[0], negm, 0, 0, 0); }
    else { p0 = __builtin_amdgcn_mfma_f32_32x32x16_bf16(b0, qr[d0], p0, 0, 0, 0); p1 = __builtin_amdgcn_mfma_f32_32x32x16_bf16(b1, qr[d0], p1, 0, 0, 0); } }
}
__device__ __forceinline__ int v_st(int k, int c) { const int kk = (k & ~0xC) | ((k & 4) << 1) | ((k & 8) >> 1); return ((kk >> 3) * 4 + (c >> 5)) * 512 + ((kk & 7) * 32 + (c & 31)) * 2; }
__device__ __forceinline__ int v_rd_base(int lane) { return ((lane & 3) << 3) | (((lane >> 2) & 3) << 6) | (((lane >> 4) & 1) << 5) | (((lane >> 5) & 1) << 8); }
constexpr int v_rd_off(int d0, int ks, int half) { return d0 * 512 + ks * 4096 + half * 2048; }
template <int OFF> __device__ __forceinline__ s16x4 tr_read(int vb) {
  s16x4 r; asm volatile("ds_read_b64_tr_b16 %0, %1 offset:%2" : "=&v"(r) : "v"(vb), "i"(OFF) : "memory"); return r;
}
template <int D0> __device__ __forceinline__ void pv_one(f32x16& od, int vb, bf16x8 pa0, bf16x8 pa1, bf16x8 pa2, bf16x8 pa3) {
  const s16x4 l0 = tr_read<v_rd_off(D0, 0, 0)>(vb), h0 = tr_read<v_rd_off(D0, 0, 1)>(vb), l1 = tr_read<v_rd_off(D0, 1, 0)>(vb), h1 = tr_read<v_rd_off(D0, 1, 1)>(vb);
  const s16x4 l2 = tr_read<v_rd_off(D0, 2, 0)>(vb), h2 = tr_read<v_rd_off(D0, 2, 1)>(vb), l3 = tr_read<v_rd_off(D0, 3, 0)>(vb), h3 = tr_read<v_rd_off(D0, 3, 1)>(vb);
  asm volatile("s_waitcnt lgkmcnt(0)" ::: "memory"); SBAR();
#define PK(L, H) (bf16x8){L[0], L[1], L[2], L[3], H[0], H[1], H[2], H[3]}
  od = __builtin_amdgcn_mfma_f32_32x32x16_bf16(pa0, PK(l0, h0), od, 0, 0, 0);
  od = __builtin_amdgcn_mfma_f32_32x32x16_bf16(pa1, PK(l1, h1), od, 0, 0, 0);
  od = __builtin_amdgcn_mfma_f32_32x32x16_bf16(pa2, PK(l2, h2), od, 0, 0, 0);
  od = __builtin_amdgcn_mfma_f32_32x32x16_bf16(pa3, PK(l3, h3), od, 0, 0, 0);
#undef PK
}
__device__ __forceinline__ void pv_d0(f32x16* o, f32x16& lsum, int vb, bf16x8 pa0, bf16x8 pa1, bf16x8 pa2, bf16x8 pa3) {
  const bf16x8 ones = {0x3F80, 0x3F80, 0x3F80, 0x3F80, 0x3F80, 0x3F80, 0x3F80, 0x3F80};
  pv_one<0>(o[0], vb, pa0, pa1, pa2, pa3); pv_one<1>(o[1], vb, pa0, pa1, pa2, pa3);
  lsum = __builtin_amdgcn_mfma_f32_32x32x16_bf16(pa0, ones, lsum, 0, 0, 0); lsum = __builtin_amdgcn_mfma_f32_32x32x16_bf16(pa1, ones, lsum, 0, 0, 0);
  pv_one<2>(o[2], vb, pa0, pa1, pa2, pa3); pv_one<3>(o[3], vb, pa0, pa1, pa2, pa3);
  lsum = __builtin_amdgcn_mfma_f32_32x32x16_bf16(pa2, ones, lsum, 0, 0, 0); lsum = __builtin_amdgcn_mfma_f32_32x32x16_bf16(pa3, ones, lsum, 0, 0, 0);
}
template <int VAR = 0> __device__ __forceinline__ void attn_unit(const unsigned short* __restrict__ Qb, const unsigned short* __restrict__ Kh, const unsigned short* __restrict__ Vh,
                                          float* __restrict__ Ob, int seq, char* lds) {
  int tid_ = threadIdx.x; asm volatile("" : "+v"(tid_));
  const int tid = tid_, wid = tid >> 6, lane = tid & 63, r32 = lane & 31, hi = lane >> 5;
  char* V_lds = lds; char* K_lds = lds + 3 * SHM_V;
  float* ws = (float*)(lds + 3 * SHM_V + 3 * SHM_K) + wid * 64; float* al_l = ws + 32;
  float m_ref = 0.f; f32x16 o[4] = {}; f32x16 lsum = {}; f32x16 negm = {}; bf16x8 qr[4];
  const unsigned short* Qw = Qb + (long)(wid * QBLK + r32) * LDQ + hi * 8;
#pragma unroll
  for (int d0 = 0; d0 < 4; ++d0) qr[d0] = *reinterpret_cast<const bf16x8*>(Qw + d0 * 16);
  const int vb0 = (int)(uintptr_t)V_lds + v_rd_base(lane);
  int koff, voff0, voff1;
  { const int row = 8 * wid + (lane >> 3), ch = (lane & 7) ^ ((row >> 1) & 7); koff = row * LDK + ch * 8; }
  { const int blk = 4 * wid + (lane >> 5), kk = (blk >> 2) * 8 + ((lane >> 2) & 7), k = (kk & ~0xC) | ((kk & 4) << 1) | ((kk & 8) >> 1); voff0 = k * LDK + (blk & 3) * 32 + (lane & 3) * 8; }
  { const int blk = 4 * wid + 2 + (lane >> 5), kk = (blk >> 2) * 8 + ((lane >> 2) & 7), k = (kk & ~0xC) | ((kk & 4) << 1) | ((kk & 8) >> 1); voff1 = k * LDK + (blk & 3) * 32 + (lane & 3) * 8; }
  typedef __attribute__((address_space(3))) unsigned ldsu32;
  const unsigned widu = (unsigned)__builtin_amdgcn_readfirstlane(wid);
  const unsigned ldsK = (unsigned)(uintptr_t)K_lds + widu * 1024u, ldsV = (unsigned)(uintptr_t)V_lds + widu * 2048u;
#define SDMA(b, k0) do { if (VAR != 4) { \
    __builtin_amdgcn_global_load_lds((const unsigned*)(Kh + (long)(k0) * LDK + koff), (ldsu32*)(uintptr_t)(ldsK + (b) * (unsigned)SHM_K), 16, 0, 0); \
    __builtin_amdgcn_global_load_lds((const unsigned*)(Vh + (long)(k0) * LDK + voff0), (ldsu32*)(uintptr_t)(ldsV + (b) * (unsigned)SHM_V), 16, 0, 0); \
    __builtin_amdgcn_global_load_lds((const unsigned*)(Vh + (long)(k0) * LDK + voff1), (ldsu32*)(uintptr_t)(ldsV + (b) * (unsigned)SHM_V + 1024u), 16, 0, 0); } } while (0)
#define SWAIT() asm volatile("s_waitcnt vmcnt(0)" ::: "memory")
#define RESC(a) do { if (__any((a) < 1.f)) { if (hi == 0) al_l[r32] = (a); asm volatile("s_waitcnt lgkmcnt(0)" ::: "memory"); \
    _Pragma("unroll") for (int r = 0; r < 16; ++r) { const float f_ = al_l[crow(r, hi)]; o[0][r] *= f_; o[1][r] *= f_; o[2][r] *= f_; o[3][r] *= f_; lsum[r] *= f_; } } } while (0)
  f32x16 pA0, pA1, pB0, pB1; float alA, alB; bf16x8 pa0, pa1, pa2, pa3; const int NT = seq / KVBLK;
  SDMA(0, 0); SWAIT(); __syncthreads();
  if (VAR != 3) qkt(pA0, pA1, K_lds, qr, negm, r32, hi); partialSM<true, VAR>(pA0, pA1, m_ref, negm, alA);
  SDMA(1, KVBLK);
  SWAIT(); __syncthreads();
  int bp = 0, bc = 1, bn = 2;
#define ROT3() do { const int t_ = bp; bp = bc; bc = bn; bn = t_; } while (0)
  for (int j = 1; j + 1 < NT; j += 2) {
    SDMA(bn, (j + 1) * KVBLK);
    SBAR(); if (VAR != 3) qkt(pB0, pB1, K_lds + bc * SHM_K, qr, negm, r32, hi);
    finishSM<VAR>(pA0, pA1, pa0, pa1, pa2, pa3); SBAR();
    if (VAR != 2) pv_d0(o, lsum, vb0 + bp * (int)SHM_V, pa0, pa1, pa2, pa3); partialSM<false, VAR>(pB0, pB1, m_ref, negm, alB);
    RESC(alB); SWAIT(); __syncthreads(); ROT3();
    SDMA(bn, (j + 2) * KVBLK);
    SBAR(); if (VAR != 3) qkt(pA0, pA1, K_lds + bc * SHM_K, qr, negm, r32, hi);
    finishSM<VAR>(pB0, pB1, pa0, pa1, pa2, pa3); SBAR();
    if (VAR != 2) pv_d0(o, lsum, vb0 + bp * (int)SHM_V, pa0, pa1, pa2, pa3); partialSM<false, VAR>(pA0, pA1, m_ref, negm, alA);
    RESC(alA); SWAIT(); __syncthreads(); ROT3();
  }
  SBAR(); if (VAR != 3) qkt(pB0, pB1, K_lds + bc * SHM_K, qr, negm, r32, hi);
  finishSM<VAR>(pA0, pA1, pa0, pa1, pa2, pa3); SBAR();
  if (VAR != 2) pv_d0(o, lsum, vb0 + bp * (int)SHM_V, pa0, pa1, pa2, pa3); partialSM<false, VAR>(pB0, pB1, m_ref, negm, alB);
  RESC(alB);
  finishSM<VAR>(pB0, pB1, pa0, pa1, pa2, pa3); SBAR();
  if (VAR != 2) pv_d0(o, lsum, vb0 + bc * (int)SHM_V, pa0, pa1, pa2, pa3);
#undef ROT3
  float rli[16];
#pragma unroll
  for (int r = 0; r < 16; ++r) rli[r] = __builtin_amdgcn_rcpf(lsum[r]);
  float* Ow = Ob + (long)(wid * QBLK) * LDO;
#pragma unroll
  for (int r = 0; r < 16; ++r) { const int orow = crow(r, hi);
#pragma unroll
    for (int d0 = 0; d0 < 4; ++d0) Ow[(long)orow * LDO + d0 * 32 + r32] = o[d0][r] * rli[r]; }
  __syncthreads();
#undef SDMA
#undef SWAIT
#undef RESC
}
#undef SBAR
#undef MX3
}
constexpr int NWAVES = 8, NTHR = 512;
constexpr int DM = 2048, SEQ = 8192, CTXL = 256, MROWS = SEQ + CTXL  , NKEYS = SEQ + CTXL;
constexpr int HYW = 1024, INCOLS = 10240, NMOD = 6 * DM;
constexpr float EPS = 1e-6f;
constexpr int NEXP = 16384;
constexpr size_t MiB = 1u << 20;
constexpr size_t WS_CTL = 0, CTL_ZERO_BYTES = 64 * 1024;
constexpr size_t WS_MODP = 1 * MiB;
constexpr size_t WS_WIN = 2 * MiB;
constexpr size_t WS_WHY = 42 * MiB, WS_WDA = 46 * MiB;
constexpr size_t WS_WO = 50 * MiB, WS_WQ = 58 * MiB;
constexpr size_t WS_UB = 66 * MiB, WS_VB = 130 * MiB;
constexpr size_t WS_USC = 98 * MiB, WS_VSC = 162 * MiB;
constexpr size_t WS_TAPF = 194 * MiB, WS_TAPB = 226 * MiB;
constexpr size_t WS_MB = 194 * MiB;
constexpr size_t WS_HB = 226 * MiB;
constexpr size_t WS_U = 258 * MiB;
constexpr size_t WS_Q2 = 258 * MiB, WS_K2 = 274 * MiB;
constexpr size_t WS_YHY = 258 * MiB, WS_YDA = 274 * MiB;
constexpr size_t WS_PHY = 291 * MiB;
constexpr size_t WS_QRAW = 339 * MiB;
constexpr size_t WS_KRAW = 355 * MiB + 512 * 1024;
constexpr size_t WS_O = 291 * MiB;
constexpr size_t WS_MIX = 291 * MiB;
constexpr size_t WS_YCT = 355 * MiB + 512 * 1024;
constexpr size_t WS_V2 = 372 * MiB;
constexpr size_t WS_GATES = 388 * MiB + 512 * 1024;
constexpr size_t WS_X0 = 452 * MiB + 512 * 1024;
constexpr size_t WS_UHT = 468 * MiB + 512 * 1024;
constexpr size_t WS_QP = 356 * MiB;
constexpr size_t WS_IDX = 420 * MiB, WS_GW = 424 * MiB;
constexpr size_t WS_PD = 258 * MiB;
constexpr size_t WS_OPRE = 290 * MiB;
constexpr size_t WS_WGT = 432 * MiB;
constexpr size_t WS_SSP = 354 * MiB;
constexpr size_t WS_KSPEC = 485 * MiB;
constexpr size_t WS_UCTX = 520 * MiB;
constexpr size_t WS_END = 522 * MiB;
static_assert(WS_UHT + (size_t)1024 * 8192 * 2 <= WS_KSPEC && WS_KSPEC + (size_t)256 * 8320 * 16 <= WS_END && WS_GW + (size_t)8192 * 128 * 4 <= WS_GATES + 64 * MiB, "ws map");

constexpr int LDS_BYTES = 147456;
constexpr int MISC_OFF = 147456 - 256;

#define GAS __attribute__((address_space(1)))
#define LAS __attribute__((address_space(3)))
typedef unsigned short bf16;
typedef unsigned v4u __attribute__((ext_vector_type(4)));
typedef unsigned v2u __attribute__((ext_vector_type(2)));
typedef float f32x4 __attribute__((ext_vector_type(4)));
typedef GAS unsigned gu32;
#define RLX_AGENT __ATOMIC_RELAXED, __HIP_MEMORY_SCOPE_AGENT
#define LDS_WAIT() asm volatile("s_waitcnt lgkmcnt(0)" ::: "memory")
#define VM_WAIT() asm volatile("s_waitcnt vmcnt(0)" ::: "memory")
__device__ __forceinline__ unsigned f2bf(float f) { unsigned u = __builtin_bit_cast(unsigned, f); return (u + 0x7fffu + ((u >> 16) & 1u)) >> 16; }
__device__ __forceinline__ unsigned pk2(float lo, float hi) { return f2bf(lo) | (f2bf(hi) << 16); }
__device__ __forceinline__ float bf2f(unsigned short b) { return __builtin_bit_cast(float, (unsigned)b << 16); }
__device__ __forceinline__ float blo(unsigned w) { return __builtin_bit_cast(float, w << 16); }
__device__ __forceinline__ float bhi(unsigned w) { return __builtin_bit_cast(float, w & 0xffff0000u); }
__device__ __forceinline__ float fsin(float x) { return __builtin_amdgcn_sinf(x * 0.15915494309189535f); }
__device__ __forceinline__ float fcos(float x) { return __builtin_amdgcn_cosf(x * 0.15915494309189535f); }
__device__ __forceinline__ float wave_sum(float v) {
#pragma unroll
    for (int o = 1; o < 64; o <<= 1) v += __shfl_xor(v, o);
    return v;
}
__device__ __forceinline__ float wave_max(float v) {
#pragma unroll
    for (int o = 1; o < 64; o <<= 1) v = fmaxf(v, __shfl_xor(v, o));
    return v;
}
#define XB_TMO      128
#define XB_XCNT(j)  (256  + 64 * (j))
#define XB_XSUB(j)  (1280 + 64 * (j))
#define XB_XGEN(j)  (2304 + 64 * (j))
#define XB_TOP      3328
#define XB_TOPGEN   3392
#define XCD_BAR_WORDS 3456
#define XB_SPIN_CAP (1u << 24)

__device__ __forceinline__ unsigned xb_ld(unsigned* p)              { return __hip_atomic_load(p, __ATOMIC_RELAXED, __HIP_MEMORY_SCOPE_AGENT); }
__device__ __forceinline__ unsigned xb_add(unsigned* p, unsigned v) { return __hip_atomic_fetch_add(p, v, __ATOMIC_RELAXED, __HIP_MEMORY_SCOPE_AGENT); }
__device__ __forceinline__ unsigned xb_xcc_id() { return (unsigned)__builtin_amdgcn_s_getreg((3 << 11) | 20) & 0xFu; }
#define XB_SPIN(cond, bar) do { unsigned _sp = 0; while (cond) { __builtin_amdgcn_s_sleep(1); \
    if ((++_sp & 255u) == 0u) { if (xb_ld(&(bar)[XB_TMO])) break; if (_sp > XB_SPIN_CAP) { atomicAdd(&(bar)[XB_TMO], 1u); break; } } } } while (0)

struct XcdBarrier {
    unsigned* bar; unsigned x;
    volatile LAS unsigned* st;
};

__device__ __forceinline__ XcdBarrier xcd_barrier_post(unsigned* bar, volatile LAS unsigned* st) {
    XcdBarrier b; b.bar = bar; b.x = xb_xcc_id(); b.st = st;
    if (threadIdx.x == 0) (void)xb_add(&bar[XB_XCNT(b.x)], 1u);
    return b;
}
__device__ __forceinline__ void xcd_barrier_complete(unsigned* bar, unsigned x, unsigned& nloc, unsigned& nx) {
    const unsigned G = gridDim.x * gridDim.y * gridDim.z;
    unsigned sum, cnt, mine, sp = 0u;
    for (;;) {
        sum = 0u; cnt = 0u; mine = 0u;
#pragma unroll
        for (unsigned j = 0; j < 16; ++j) { const unsigned c = xb_ld(&bar[XB_XCNT(j)]); sum += c; cnt += (c > 0u) ? 1u : 0u; mine = (j == x) ? c : mine; }
        if (sum == G) break;
        __builtin_amdgcn_s_sleep(1);
        if ((++sp & 255u) == 0u) { if (xb_ld(&bar[XB_TMO])) break; if (sp > XB_SPIN_CAP) { atomicAdd(&bar[XB_TMO], 1u); break; } }
    }
    nloc = mine > 0u ? mine : 1u; nx = cnt > 0u ? cnt : 1u;
}

__device__ __forceinline__ void xcd_barrier(const XcdBarrier& b) {
    asm volatile("s_waitcnt vmcnt(0)" ::: "memory");
    __syncthreads();
    if (threadIdx.x == 0) {
        unsigned* bar = b.bar;
        __builtin_amdgcn_s_waitcnt(0);
        unsigned nloc = b.st[0], nx = b.st[1];
        if (nloc == 0u) { xcd_barrier_complete(bar, b.x, nloc, nx); b.st[0] = nloc; b.st[1] = nx; }
        const unsigned old = xb_add(&bar[XB_XSUB(b.x)], 1u);
        const unsigned gen = old / nloc;
        if (old + 1u == (gen + 1u) * nloc) {
            __builtin_amdgcn_fence(__ATOMIC_RELEASE, "agent");
            asm volatile("s_waitcnt vmcnt(0)" ::: "memory");
            const unsigned og = xb_add(&bar[XB_TOP], 1u);
            const unsigned tg = og / nx;
            if (og + 1u == (tg + 1u) * nx) xb_add(&bar[XB_TOPGEN], 1u);
            else XB_SPIN(xb_ld(&bar[XB_TOPGEN]) == tg, bar);
            __builtin_amdgcn_fence(__ATOMIC_ACQUIRE, "agent");
            xb_add(&bar[XB_XGEN(b.x)], 1u);
            asm volatile("s_waitcnt vmcnt(0)" ::: "memory");
        } else {
            XB_SPIN(xb_ld(&bar[XB_XGEN(b.x)]) == gen, bar);
            __builtin_amdgcn_fence(__ATOMIC_ACQUIRE, "agent");
            asm volatile("s_waitcnt vmcnt(0)" ::: "memory");
        }
    }
    __syncthreads();
}
struct Args { const float* in[31]; float* out; unsigned char* ws; int ph_lo, ph_hi, li, pad; };
struct Frame {
    LAS unsigned char* lds; char* ldsg;
    int tid, lane, wave, vcu, G, gw, NGW;
    float* out; unsigned char* ws;
};
__device__ __forceinline__ const float* modp(const Frame& F) { return (const float*)(F.ws + WS_MODP); }
__device__ __forceinline__ f32x4 mod4(const Args& A, const Frame& F, int which, int i) {
    const float* p = modp(F) + which * NMOD + i; f32x4 v = *(const f32x4*)(A.in[5] + i);
#pragma unroll
    for (int kc = 0; kc < 4; ++kc) v += *(const f32x4*)(p + kc * 2 * NMOD);
    return v;
}
__device__ __forceinline__ float silu(float x) { return x / (1.f + __expf(-x)); }

__device__ __forceinline__ void p0_transpose_pair(const float* Wa, bf16* WTa, int ita, const float* Wb, bf16* WTb, int itb, int K, int N, bool two, LAS float* scr, int lane) {
    const int kka = lane >> 3, nl = (lane & 7) * 4, nb = N / 32;
    const int k0a = 64 * (ita / nb), n0a = 32 * (ita % nb), k0b = 64 * (itb / nb), n0b = 32 * (itb % nb);
    f32x4 va[8], vb_[8];
#pragma unroll
    for (int i = 0; i < 8; ++i) va[i] = *(const f32x4*)(Wa + (size_t)(k0a + 8 * i + kka) * N + n0a + nl);
    if (two) {
#pragma unroll
        for (int i = 0; i < 8; ++i) vb_[i] = *(const f32x4*)(Wb + (size_t)(k0b + 8 * i + kka) * N + n0b + nl); }
#pragma unroll
    for (int i = 0; i < 8; ++i) { LAS float* s = scr + (8 * i + kka) * 33 + nl; s[0] = va[i][0]; s[1] = va[i][1]; s[2] = va[i][2]; s[3] = va[i][3]; }
    if (two) {
#pragma unroll
        for (int i = 0; i < 8; ++i) { LAS float* s = scr + 2176 + (8 * i + kka) * 33 + nl; s[0] = vb_[i][0]; s[1] = vb_[i][1]; s[2] = vb_[i][2]; s[3] = vb_[i][3]; } }
    LDS_WAIT(); asm volatile("" ::: "memory");
    const int c = lane & 7;
#pragma unroll
    for (int j = 0; j < 4; ++j) { const int n = (lane >> 3) + 8 * j; const LAS float* s = scr + (8 * c) * 33 + n;
        v4u o; o.x = pk2(s[0 * 33], s[1 * 33]); o.y = pk2(s[2 * 33], s[3 * 33]); o.z = pk2(s[4 * 33], s[5 * 33]); o.w = pk2(s[6 * 33], s[7 * 33]);
        *(GAS v4u*)(WTa + (size_t)(n0a + n) * K + k0a + 8 * c) = o; }
    if (two) {
#pragma unroll
        for (int j = 0; j < 4; ++j) { const int n = (lane >> 3) + 8 * j; const LAS float* s = scr + 2176 + (8 * c) * 33 + n;
            v4u o; o.x = pk2(s[0 * 33], s[1 * 33]); o.y = pk2(s[2 * 33], s[3 * 33]); o.z = pk2(s[4 * 33], s[5 * 33]); o.w = pk2(s[6 * 33], s[7 * 33]);
            *(GAS v4u*)(WTb + (size_t)(n0b + n) * K + k0b + 8 * c) = o; } }
    LDS_WAIT(); asm volatile("" ::: "memory");
}
__device__ __forceinline__ void p0_filter_item(const Args& A, Frame& F, int pb) {
    LAS float* zb = (LAS float*)F.lds;
    LAS float* hA = zb + 64 * 36;
    LAS float* hB = hA + 64 * 68;
    LAS float* tl = hB + 64 * 68 + F.wave * (64 * 33);
    const int l0 = pb * 64, tid = F.tid;
    const float* w1 = A.in[13]; const float* b1 = A.in[14]; const float* w2 = A.in[15]; const float* b2 = A.in[16];
    const float* w3 = A.in[17]; const float* b3 = A.in[18]; const float* wout = A.in[19]; const float* freq = A.in[20];
    for (int idx = tid; idx < 64 * 33; idx += NTHR) { const int pos = idx / 33, f = idx % 33; const int l = l0 + pos;
        const float w = 6.283185307179586f * (float)l / 8192.f; float v;
        if (f == 0) v = (float)l / 8191.f;
        else { const int j = (f - 1) & 15; const float band = 1e-4f + (float)j * ((15.f - 1e-4f) / 15.f); const float a = band * w; v = (f <= 16) ? fcos(a) : -fsin(a); }
        zb[pos * 36 + f] = v; }
    __syncthreads();
    const int j = tid & 63, pg = tid >> 6;
    { float acc[8]; const float bj = b1[j], fj = freq[j];
#pragma unroll
      for (int i = 0; i < 8; ++i) acc[i] = bj;
      for (int k = 0; k < 33; ++k) { const float w = w1[k * 64 + j];
#pragma unroll
        for (int i = 0; i < 8; ++i) acc[i] += zb[(pg * 8 + i) * 36 + k] * w; }
#pragma unroll
      for (int i = 0; i < 8; ++i) hA[(pg * 8 + i) * 68 + j] = fsin(fj * acc[i]); }
    __syncthreads();
    { float acc[8]; const float bj = b2[j], fj = freq[j];
#pragma unroll
      for (int i = 0; i < 8; ++i) acc[i] = bj;
      for (int k = 0; k < 64; ++k) { const float w = w2[k * 64 + j];
#pragma unroll
        for (int i = 0; i < 8; ++i) acc[i] += hA[(pg * 8 + i) * 68 + k] * w; }
#pragma unroll
      for (int i = 0; i < 8; ++i) hB[(pg * 8 + i) * 68 + j] = fsin(fj * acc[i]); }
    __syncthreads();
    { float acc[8]; const float bj = b3[j], fj = freq[j];
#pragma unroll
      for (int i = 0; i < 8; ++i) acc[i] = bj;
      for (int k = 0; k < 64; ++k) { const float w = w3[k * 64 + j];
#pragma unroll
        for (int i = 0; i < 8; ++i) acc[i] += hB[(pg * 8 + i) * 68 + k] * w; }
      __syncthreads();
#pragma unroll
      for (int i = 0; i < 8; ++i) { const float v = fsin(fj * acc[i]); const unsigned hb_ = f2bf(v);
          LAS unsigned short* hp = (LAS unsigned short*)((LAS unsigned char*)hA + (pg * 8 + i) * 144) + j;
          hp[0] = (unsigned short)hb_; hp[4608] = (unsigned short)f2bf(v - __builtin_bit_cast(float, hb_ << 16)); } }
    __syncthreads();
    typedef short s16x8 __attribute__((ext_vector_type(8))); typedef float f32x16 __attribute__((ext_vector_type(16)));
    const int lane = F.lane, r32 = lane & 31, hi = lane >> 5;
    float* tapF = (float*)(F.ws + WS_TAPF); float* tapB = (float*)(F.ws + WS_TAPB);
    const LAS unsigned char* Hh = (const LAS unsigned char*)hA;
#pragma unroll 1
    for (int nb = 0; nb < 8; ++nb) {
        const int c0 = F.wave * 256 + nb * 32, col = c0 + r32, chan = col & 1023;
        s16x8 bh[4], bl[4];
#pragma unroll
        for (int s = 0; s < 4; ++s) { float x[8];
#pragma unroll
            for (int e = 0; e < 8; ++e) x[e] = wout[(size_t)(16 * s + 8 * hi + e) * 2048 + col];
            unsigned hw[4], lw[4];
#pragma unroll
            for (int e = 0; e < 4; ++e) { const unsigned h0 = f2bf(x[2 * e]), h1 = f2bf(x[2 * e + 1]); hw[e] = h0 | (h1 << 16);
                lw[e] = pk2(x[2 * e] - __builtin_bit_cast(float, h0 << 16), x[2 * e + 1] - __builtin_bit_cast(float, h1 << 16)); }
            const v4u hv = {hw[0], hw[1], hw[2], hw[3]}, lv = {lw[0], lw[1], lw[2], lw[3]};
            bh[s] = __builtin_bit_cast(s16x8, hv); bl[s] = __builtin_bit_cast(s16x8, lv); }
        const float delta = fabsf(-3.0701134573253945f + (-15.350567286626973f + 3.0701134573253945f) * ((float)chan / 1023.f));
#pragma unroll
        for (int mb = 0; mb < 2; ++mb) { f32x16 acc = {};
#pragma unroll
            for (int s = 0; s < 4; ++s) { const LAS unsigned char* ap = Hh + (32 * mb + r32) * 144 + (2 * s + hi) * 16;
                const s16x8 ah = *(const LAS s16x8*)ap, al = *(const LAS s16x8*)(ap + 9216);
                acc = __builtin_amdgcn_mfma_f32_32x32x16_bf16(al, bh[s], acc, 0, 0, 0);
                acc = __builtin_amdgcn_mfma_f32_32x32x16_bf16(ah, bl[s], acc, 0, 0, 0);
                acc = __builtin_amdgcn_mfma_f32_32x32x16_bf16(ah, bh[s], acc, 0, 0, 0); }
#pragma unroll
            for (int r = 0; r < 16; ++r) { const int pos = 32 * mb + (r & 3) + 8 * (r >> 2) + 4 * hi; const float t = (float)(l0 + pos) / 8191.f;
                tl[r32 * 65 + pos] = acc[r] * (__expf(-t * delta) + 0.05f); } }
        LDS_WAIT(); asm volatile("" ::: "memory");
        float* dst = (c0 < 1024) ? tapF : tapB;
#pragma unroll 4
        for (int c = 0; c < 32; ++c) dst[(size_t)((c0 + c) & 1023) * 8192 + l0 + lane] = tl[c * 65 + lane];
        LDS_WAIT(); asm volatile("" ::: "memory");
    }
    __syncthreads();
}
#ifdef P0_MASK
#define P0REP(s) _Pragma("unroll 1") for (int rep_ = 0; rep_ <= ((P0_MASK >> (s)) & 1); ++rep_)
#define P3REP(s) _Pragma("unroll 1") for (int rep3_ = 0; rep3_ <= ((P0_MASK >> (s)) & 1); ++rep3_)
#else
#define P0REP(s)
#define P3REP(s)
#endif
__device__ __forceinline__ void p0_prologue(const Args& A, Frame& F) {
    P0REP(0) if ((int)blockIdx.x < 128) p0_filter_item(A, F, (int)blockIdx.x);
    P0REP(1) { const float* wm = A.in[4]; const float* c = A.in[1]; const float* cc = A.in[3]; float* mp = (float*)(F.ws + WS_MODP);
      LAS float* sl = (LAS float*)F.lds;
      for (int k = F.tid; k < DM; k += NTHR) { sl[k] = silu(c[k]); sl[DM + k] = silu(cc[k]); }
      __syncthreads();
      const int cl = F.lane & 7, rl = F.lane >> 3;
      for (int it = F.gw; it < 384 * 4; it += F.NGW) { const int cg = it % 384, kc = it / 384;
          f32x4 al = {0.f, 0.f, 0.f, 0.f}, ac = {0.f, 0.f, 0.f, 0.f};
#pragma unroll
          for (int h = 0; h < 2; ++h) { f32x4 w[32];
#pragma unroll
              for (int i = 0; i < 32; ++i) w[i] = *(const f32x4*)(wm + (size_t)(kc * 512 + rl + 8 * (32 * h + i)) * NMOD + cg * 32 + cl * 4);
#pragma unroll
              for (int i = 0; i < 32; ++i) { const int k = kc * 512 + rl + 8 * (32 * h + i); al += w[i] * sl[k]; ac += w[i] * sl[DM + k]; } }
#pragma unroll
          for (int o = 8; o < 64; o <<= 1) {
#pragma unroll
              for (int e = 0; e < 4; ++e) { al[e] += __shfl_xor(al[e], o); ac[e] += __shfl_xor(ac[e], o); } }
          if (rl == 0) { *(f32x4*)(mp + (kc * 2 + 0) * NMOD + cg * 32 + cl * 4) = al; *(f32x4*)(mp + (kc * 2 + 1) * NMOD + cg * 32 + cl * 4) = ac; } }
      __syncthreads(); }
    P0REP(2) { LAS float* scr = (LAS float*)(F.lds + F.wave * 17408);
      constexpr int I_IN = (DM / 64) * (INCOLS / 32), I_HY = (HYW / 64) * (DM / 32), I_O = (DM / 64) * (DM / 32);
      for (int it = F.gw; it < I_IN; it += 2 * F.NGW) { const bool two = it + F.NGW < I_IN;
          p0_transpose_pair(A.in[10], (bf16*)(F.ws + WS_WIN), it, A.in[10], (bf16*)(F.ws + WS_WIN), two ? it + F.NGW : it, DM, INCOLS, two, scr, F.lane); }
      for (int it = F.gw; it < I_O; it += F.NGW)
          p0_transpose_pair(A.in[26], (bf16*)(F.ws + WS_WO), it, A.in[27], (bf16*)(F.ws + WS_WQ), it, DM, DM, true, scr, F.lane);
      for (int it = F.gw; it < 2 * I_HY; it += F.NGW) { const bool da = it >= I_HY; const int r = da ? it - I_HY : it;
          const float* W = da ? A.in[25] : A.in[24]; bf16* WT = (bf16*)(F.ws + (da ? WS_WDA : WS_WHY));
          p0_transpose_pair(W, WT, r, W, WT, r, HYW, DM, false, scr, F.lane); } }
    P0REP(3) {
      const int bx = (int)blockIdx.x; const bool bal = (F.G == 256);
      const int rbase = bal ? (bx < 128 ? bx * 128 : 16384 + (bx - 128) * 128) : 0, rcnt = bal ? (bx < 128 ? 128 : 128) : 2 * NEXP;
      const int rstart = bal ? F.wave : F.gw, rstep = bal ? NWAVES : F.NGW;
      for (int ri = rstart; ri < rcnt; ri += 2 * rstep) {
          const int rowa = rbase + ri, rowb = (ri + rstep < rcnt) ? rowa + rstep : rowa; const bool two = rowb != rowa;
          const bool ua = rowa < NEXP, ub_ = rowb < NEXP; const int ra = ua ? rowa : rowa - NEXP, rb = ub_ ? rowb : rowb - NEXP;
          const float* sa = (ua ? A.in[29] : A.in[30]) + (size_t)ra * DM + 16 * F.lane; const float* sb = (ub_ ? A.in[29] : A.in[30]) + (size_t)rb * DM + 16 * F.lane;
          f32x4 xa[8], xb[8];
#pragma unroll
          for (int i = 0; i < 8; ++i) xa[i] = *(const f32x4*)(sa + 1024 * (i >> 2) + 4 * (i & 3));
#pragma unroll
          for (int i = 0; i < 8; ++i) xb[i] = *(const f32x4*)(sb + 1024 * (i >> 2) + 4 * (i & 3));
          float ma = 0.f, mb = 0.f;
#pragma unroll
          for (int i = 0; i < 8; ++i) { ma = fmaxf(ma, fmaxf(fmaxf(fabsf(xa[i][0]), fabsf(xa[i][1])), fmaxf(fabsf(xa[i][2]), fabsf(xa[i][3]))));
              mb = fmaxf(mb, fmaxf(fmaxf(fabsf(xb[i][0]), fabsf(xb[i][1])), fmaxf(fabsf(xb[i][2]), fabsf(xb[i][3])))); }
#pragma unroll
          for (int o = 1; o < 64; o <<= 1) { ma = fmaxf(ma, __shfl_xor(ma, o)); mb = fmaxf(mb, __shfl_xor(mb, o)); }
          const float sca = (ma > 0.f) ? 384.f / ma : 1.f, scb = (mb > 0.f) ? 384.f / mb : 1.f;
          unsigned char* da = F.ws + (ua ? WS_UB : WS_VB) + (size_t)(F.lane >> 4) * ((size_t)NEXP * 256) + (size_t)ra * 256 + 16 * (F.lane & 15);
          unsigned char* db = F.ws + (ub_ ? WS_UB : WS_VB) + (size_t)(F.lane >> 4) * ((size_t)NEXP * 256) + (size_t)rb * 256 + 16 * (F.lane & 15);
#pragma unroll
          for (int q = 0; q < 2; ++q) { v4u o;
#pragma unroll
              for (int e = 0; e < 4; ++e) { const f32x4 t = xa[4 * q + e] * sca; int w = 0;
                  w = __builtin_amdgcn_cvt_pk_fp8_f32(t[0], t[1], w, false); w = __builtin_amdgcn_cvt_pk_fp8_f32(t[2], t[3], w, true); o[e] = (unsigned)w; }
              *(v4u*)(da + (size_t)(4 * q) * ((size_t)NEXP * 256)) = o; }
          if (F.lane == 0) ((float*)(F.ws + (ua ? WS_USC : WS_VSC)))[ra] = 1.f / sca;
          if (two) {
#pragma unroll
              for (int q = 0; q < 2; ++q) { v4u o;
#pragma unroll
                  for (int e = 0; e < 4; ++e) { const f32x4 t = xb[4 * q + e] * scb; int w = 0;
                      w = __builtin_amdgcn_cvt_pk_fp8_f32(t[0], t[1], w, false); w = __builtin_amdgcn_cvt_pk_fp8_f32(t[2], t[3], w, true); o[e] = (unsigned)w; }
                  *(v4u*)(db + (size_t)(4 * q) * ((size_t)NEXP * 256)) = o; }
              if (F.lane == 0) ((float*)(F.ws + (ub_ ? WS_USC : WS_VSC)))[rb] = 1.f / scb; } } }

}

__device__ __forceinline__ void p1_rows(const Args& A, Frame& F) {
    bf16* U = (bf16*)(F.ws + WS_U); const float* gn = A.in[6];
#pragma unroll 1
    for (int which = 0; which < 2; ++which) {
        const int r0 = which ? SEQ : 0, r1 = which ? MROWS : SEQ; const float* src = which ? A.in[2] : A.in[0];
        int r = r0 + F.gw; if (r >= r1) continue;
        f32x4 a[8], b[8];
#pragma unroll
        for (int j = 0; j < 8; ++j) { const int col = 4 * F.lane + 256 * j; const f32x4 g = *(const f32x4*)(gn + col);
            a[j] = g * (mod4(A, F, which, 1 * DM + col) + 1.f); b[j] = mod4(A, F, which, 0 * DM + col); }
        for (; r < r1; r += F.NGW) {
            const f32x4* xr = (const f32x4*)(src + (size_t)(r - r0) * DM) + F.lane; f32x4 v[8]; float s = 0.f;
#pragma unroll
            for (int j = 0; j < 8; ++j) { v[j] = xr[64 * j]; s += (v[j][0] * v[j][0] + v[j][1] * v[j][1]) + (v[j][2] * v[j][2] + v[j][3] * v[j][3]); }
            const float rstd = rsqrtf(wave_sum(s) * (1.f / DM) + EPS);
            unsigned long long* o8 = (unsigned long long*)(U + (size_t)r * DM) + F.lane;
#pragma unroll
            for (int j = 0; j < 8; ++j) { const f32x4 y = v[j] * rstd * a[j] + b[j];
                o8[64 * j] = (unsigned long long)pk2(y[0], y[1]) | ((unsigned long long)pk2(y[2], y[3]) << 32); }
        }
    }
}

__device__ __forceinline__ void p2_ctx_unit(Frame& F) {
    typedef short s16x8 __attribute__((ext_vector_type(8))); typedef float f32x16 __attribute__((ext_vector_type(16)));
    const bf16* U = (const bf16*)(F.ws + WS_U) + (size_t)SEQ * DM; const bf16* W = (const bf16*)(F.ws + WS_WIN);
    LAS float* part = (LAS float*)F.lds;
#pragma unroll 1
    for (int unit = F.vcu; unit < 256; unit += F.G) {
        const int rb = unit >> 5, cb = unit & 31, l31 = F.lane & 31, hi = F.lane >> 5, k0 = 256 * F.wave + 8 * hi;
        const bf16* ap = U + (size_t)(32 * rb + l31) * DM + k0;
        const bf16* bp0 = W + (size_t)(4096 + 64 * cb + l31) * DM + k0; const bf16* bp1 = bp0 + (size_t)32 * DM;
        f32x16 c0, c1;
#pragma unroll
        for (int r = 0; r < 16; ++r) { c0[r] = 0.f; c1[r] = 0.f; }
#pragma unroll
        for (int h = 0; h < 2; ++h) { s16x8 a[8], b0[8], b1[8];
#pragma unroll
            for (int s = 0; s < 8; ++s) { const int ko = 16 * (8 * h + s); a[s] = *(const s16x8*)(ap + ko); b0[s] = *(const s16x8*)(bp0 + ko); b1[s] = *(const s16x8*)(bp1 + ko); }
#pragma unroll
            for (int s = 0; s < 8; ++s) { c0 = __builtin_amdgcn_mfma_f32_32x32x16_bf16(a[s], b0[s], c0, 0, 0, 0); c1 = __builtin_amdgcn_mfma_f32_32x32x16_bf16(a[s], b1[s], c1, 0, 0, 0); } }
#pragma unroll
        for (int r = 0; r < 16; ++r) { const int row = (r & 3) + 8 * (r >> 2) + 4 * hi; part[F.wave * 2048 + row * 64 + l31] = c0[r]; part[F.wave * 2048 + row * 64 + 32 + l31] = c1[r]; }
        __syncthreads();
        { const int row = F.tid >> 4, c4 = 4 * (F.tid & 15); f32x4 s = {0.f, 0.f, 0.f, 0.f};
#pragma unroll
          for (int w = 0; w < 8; ++w) s += *(const LAS f32x4*)(part + w * 2048 + row * 64 + c4);
          bf16* dst = (bf16*)(F.ws + (cb < 16 ? WS_KRAW + (size_t)SEQ * 1024 * 2 : WS_V2)) + (size_t)(32 * rb + row) * 1024 + 64 * (cb & 15) + c4;
          *(unsigned long long*)dst = (unsigned long long)pk2(s[0], s[1]) | ((unsigned long long)pk2(s[2], s[3]) << 32); }
        __syncthreads();
    }
}

__device__ __forceinline__ void p3_post(const Args& A, Frame& F, const int gw, const int NGW) {
    const bf16* qraw = (const bf16*)(F.ws + WS_QRAW); const bf16* kraw = (const bf16*)(F.ws + WS_KRAW);
    bf16* q2 = (bf16*)(F.ws + WS_Q2); bf16* k2 = (bf16*)(F.ws + WS_K2);
    P3REP(4) { const int hm = F.lane >> 2, ax = (F.lane >> 1) & 1, jh = F.lane & 1; const int e0 = hm * 64 + 32 * ax + 8 * jh;
      float inv[8];
#pragma unroll
      for (int j = 0; j < 8; ++j) inv[j] = __builtin_amdgcn_exp2f(-(float)(8 * jh + j) * (13.287712379549449f / 16.f));
      for (int t = gw; t < SEQ; t += NGW) {
          const float pos = (float)(ax ? (t & 63) : (t >> 6));
          float cs[8], sn[8];
#pragma unroll
          for (int j = 0; j < 8; ++j) { const float a = pos * inv[j]; cs[j] = fcos(a); sn[j] = fsin(a); }
#pragma unroll
          for (int w = 0; w < 2; ++w) {
              const bf16* src = (w ? kraw : qraw) + (size_t)t * 1024 + e0; bf16* dst = (w ? k2 + (size_t)(CTXL + t) * 1024 : q2 + (size_t)t * 1024) + e0;
              const v4u x1 = *(const v4u*)src, x2 = *(const v4u*)(src + 16);
              float a1[8] = { blo(x1.x), bhi(x1.x), blo(x1.y), bhi(x1.y), blo(x1.z), bhi(x1.z), blo(x1.w), bhi(x1.w) };
              float a2[8] = { blo(x2.x), bhi(x2.x), blo(x2.y), bhi(x2.y), blo(x2.z), bhi(x2.z), blo(x2.w), bhi(x2.w) };
              float o1[8], o2[8];
              const float qs = w ? 1.f : att::C2;
#pragma unroll
              for (int j = 0; j < 8; ++j) { o1[j] = (a1[j] * cs[j] - a2[j] * sn[j]) * qs; o2[j] = (a2[j] * cs[j] + a1[j] * sn[j]) * qs; }
              v4u w1, w2; w1.x = pk2(o1[0], o1[1]); w1.y = pk2(o1[2], o1[3]); w1.z = pk2(o1[4], o1[5]); w1.w = pk2(o1[6], o1[7]);
              w2.x = pk2(o2[0], o2[1]); w2.y = pk2(o2[2], o2[3]); w2.z = pk2(o2[4], o2[5]); w2.w = pk2(o2[6], o2[7]);
              *(v4u*)dst = w1; *(v4u*)(dst + 16) = w2; }
      }
      for (int i = gw * 64 + F.lane; i < CTXL * 1024 / 8; i += NGW * 64) *((v4u*)k2 + i) = *((const v4u*)(kraw + (size_t)SEQ * 1024) + i);
    }
    P3REP(5) { const bf16* phy = (const bf16*)(F.ws + WS_PHY); const float* cw = A.in[11]; const float* cb = A.in[12];
      bf16* x0o = (bf16*)(F.ws + WS_X0); bf16* uht = (bf16*)(F.ws + WS_UHT);
      LAS unsigned char* tile = F.lds;
#pragma unroll 1
      for (int it = F.vcu; it < 256; it += F.G) { int ln = F.lane; asm volatile("" : "+v"(ln));
          const int t0 = (it >> 1) * 64, cbase = (it & 1) * 512, c = cbase + 8 * ln, tw = t0 + 8 * F.wave;
#pragma unroll 1
          for (int pass = 0; pass < 2; ++pass) {
              const int ns = pass ? 1 : 2, sb = pass ? 2 : 0;
              f32x4 wt[2][3][2], bs[2][2];
#pragma unroll
              for (int s = 0; s < 2; ++s) if (s < ns) { const int col = (sb + s) * 1024 + c;
#pragma unroll
                  for (int k = 0; k < 3; ++k) { wt[s][k][0] = *(const f32x4*)(cw + k * 3072 + col); wt[s][k][1] = *(const f32x4*)(cw + k * 3072 + col + 4); }
                  bs[s][0] = *(const f32x4*)(cb + col); bs[s][1] = *(const f32x4*)(cb + col + 4); }
              v4u row[2][10];
#pragma unroll
              for (int s = 0; s < 2; ++s) if (s < ns) {
#pragma unroll
                  for (int r = 0; r < 10; ++r) { const int t = tw - 1 + r;
                      row[s][r] = (t >= 0 && t < SEQ) ? *(const v4u*)(phy + (size_t)t * 3072 + (sb + s) * 1024 + c) : (v4u){0u, 0u, 0u, 0u}; } }
#pragma unroll
              for (int tt = 0; tt < 8; ++tt) { float z[2][8];
#pragma unroll
                  for (int s = 0; s < 2; ++s) if (s < ns) {
#pragma unroll
                      for (int h = 0; h < 4; ++h) { const unsigned a = row[s][tt][h], m = row[s][tt + 1][h], n = row[s][tt + 2][h]; const int q = h >> 1, e = 2 * (h & 1);
                          z[s][2 * h]     = blo(a) * wt[s][0][q][e]     + blo(m) * wt[s][1][q][e]     + blo(n) * wt[s][2][q][e]     + bs[s][q][e];
                          z[s][2 * h + 1] = bhi(a) * wt[s][0][q][e + 1] + bhi(m) * wt[s][1][q][e + 1] + bhi(n) * wt[s][2][q][e + 1] + bs[s][q][e + 1]; } }
                  if (pass == 0) { const int tl = 8 * F.wave + tt;
                      LAS unsigned short* tp = (LAS unsigned short*)(tile + (size_t)(8 * ln) * 128 + ((((tl >> 3) ^ ln) & 7) << 4) + 2 * (tl & 7));
#pragma unroll
                      for (int e = 0; e < 8; ++e) tp[e * 64] = (unsigned short)f2bf(z[0][e] * z[1][e]);
                  } else { v4u o; o.x = pk2(z[0][0], z[0][1]); o.y = pk2(z[0][2], z[0][3]); o.z = pk2(z[0][4], z[0][5]); o.w = pk2(z[0][6], z[0][7]);
                      *(v4u*)(x0o + (size_t)(tw + tt) * 1024 + c) = o; } }
          }
          __syncthreads();
          { const int csub = ln >> 3, piece = ln & 7;
#pragma unroll
            for (int i = 0; i < 8; ++i) { const int cl = 64 * F.wave + 8 * i + csub;
                const v4u v = *(const LAS v4u*)(tile + (size_t)cl * 128 + (((piece ^ (cl >> 3)) & 7) << 4));
                *(v4u*)(uht + (size_t)(cbase + cl) * SEQ + t0 + 8 * piece) = v; } }
          __syncthreads();
      } }
}

__device__ __forceinline__ void p4_conv_channel(Frame& F, int c) {
    LAS float* T = (LAS float*)F.lds;
    LAS float* uh = T + 16384;
    const float* tapF = (const float*)(F.ws + WS_TAPF) + (size_t)c * 8192; const float* tapB = (const float*)(F.ws + WS_TAPB) + (size_t)c * 8192;
    const bf16* uht = (const bf16*)(F.ws + WS_UHT) + (size_t)c * 8192;
    for (int i = F.tid; i < 8192; i += NTHR) { T[8192 + i] = tapF[i]; T[8192 - i] = (i == 0) ? tapF[0] : tapB[i]; uh[i] = bf2f(uht[i]); }
    if (F.tid == 0) T[0] = 0.f;
    __syncthreads();
    float acc[16];
#pragma unroll
    for (int i = 0; i < 16; ++i) acc[i] = 0.f;
    const int tid = F.tid;
    for (int S = 0; S < 512; ++S) {
        const int base = 16 * (tid - S) + 8192 - 16;
        float W[32], u[16];
#pragma unroll
        for (int q = 0; q < 32; q += 4) { const f32x4 w4 = *(const LAS f32x4*)(T + base + q); W[q] = w4[0]; W[q + 1] = w4[1]; W[q + 2] = w4[2]; W[q + 3] = w4[3]; }
#pragma unroll
        for (int q = 0; q < 16; q += 4) { const f32x4 u4 = *(const LAS f32x4*)(uh + 16 * S + q); u[q] = u4[0]; u[q + 1] = u4[1]; u[q + 2] = u4[2]; u[q + 3] = u4[3]; }
#pragma unroll
        for (int j = 0; j < 16; ++j)
#pragma unroll
            for (int i = 0; i < 16; ++i) acc[i] += W[16 + i - j] * u[j];
    }
    bf16* yo = (bf16*)(F.ws + WS_YCT) + (size_t)c * 8192 + 16 * tid;
    v4u o0, o1; o0.x = pk2(acc[0], acc[1]); o0.y = pk2(acc[2], acc[3]); o0.z = pk2(acc[4], acc[5]); o0.w = pk2(acc[6], acc[7]);
    o1.x = pk2(acc[8], acc[9]); o1.y = pk2(acc[10], acc[11]); o1.z = pk2(acc[12], acc[13]); o1.w = pk2(acc[14], acc[15]);
    *(v4u*)yo = o0; *(v4u*)(yo + 8) = o1;
    __syncthreads();
}
namespace fftc {
constexpr int N = 16384, LH = 8192, KSTR = 8320;
typedef float c32 __attribute__((ext_vector_type(2)));
__device__ __forceinline__ int rev4(int k) {
    unsigned r = __brev((unsigned)k) >> 18; return (int)(((r & 0x2AAAu) >> 1) | ((r & 0x1555u) << 1));
}
__device__ __forceinline__ int sw(int e) { const int t = e >> 4; return e ^ ((t & 3) * 5) ^ ((t & 4) << 2); }
__device__ __forceinline__ int rev4b(int m) { const unsigned r = __brev((unsigned)m) >> 24; return (int)(((r & 0xAAu) >> 1) | ((r & 0x55u) << 1)); }
__device__ __forceinline__ c32 cmul(c32 a, c32 b) { return (c32){a.x * b.x - a.y * b.y, a.x * b.y + a.y * b.x}; }
__device__ __forceinline__ c32 cadd(c32 a, c32 b) { c32 r; asm("v_pk_add_f32 %0, %1, %2" : "=v"(r) : "v"(a), "v"(b)); return r; }
__device__ __forceinline__ c32 csub(c32 a, c32 b) { c32 r; asm("v_pk_add_f32 %0, %1, %2 neg_lo:[0,1] neg_hi:[0,1]" : "=v"(r) : "v"(a), "v"(b)); return r; }
__device__ __forceinline__ c32 csubi(c32 a, c32 b) { c32 r; asm("v_pk_add_f32 %0, %1, %2 op_sel:[0,1] op_sel_hi:[1,0] neg_hi:[0,1]" : "=v"(r) : "v"(a), "v"(b)); return r; }
__device__ __forceinline__ c32 caddi(c32 a, c32 b) { c32 r; asm("v_pk_add_f32 %0, %1, %2 op_sel:[0,1] op_sel_hi:[1,0] neg_lo:[0,1]" : "=v"(r) : "v"(a), "v"(b)); return r; }
__device__ __forceinline__ c32 cmulw(c32 a, c32 w, c32 wr) { c32 t, r;
    asm("v_pk_mul_f32 %0, %1, %2 op_sel_hi:[0,1]" : "=v"(t) : "v"(a), "v"(w));
    asm("v_pk_fma_f32 %0, %1, %2, %3 op_sel:[1,0,0] op_sel_hi:[1,1,1]" : "=v"(r) : "v"(a), "v"(wr), "v"(t)); return r; }
struct Tw { c32 w1, r1, w2, r2, w3, r3; };
template <bool INV> __device__ __forceinline__ Tw make_tw(float ang) {
    float c, s; Tw t;
    asm("s_nop 1\n\tv_cos_f32 %0, %2\n\tv_sin_f32 %1, %2\n\ts_nop 1" : "=&v"(c), "=&v"(s) : "v"(ang));
    t.w1 = INV ? (c32){c, s} : (c32){c, -s}; t.r1 = INV ? (c32){-s, c} : (c32){s, c};
    t.w2 = cmulw(t.w1, t.w1, t.r1); t.r2 = cmulw(t.r1, t.w1, t.r1); t.w3 = cmulw(t.w2, t.w1, t.r1); t.r3 = cmulw(t.r2, t.w1, t.r1); return t;
}
template <bool INV, bool TW> __device__ __forceinline__ void bfly(c32& a0, c32& a1, c32& a2, c32& a3, const Tw& t) {
    if (INV) {
        if (TW) { a1 = cmulw(a1, t.w1, t.r1); a2 = cmulw(a2, t.w2, t.r2); a3 = cmulw(a3, t.w3, t.r3); }
        const c32 s0 = cadd(a0, a2), s1 = csub(a0, a2), s2 = cadd(a1, a3), s3 = csub(a1, a3);
        a0 = cadd(s0, s2); a2 = csub(s0, s2); a1 = caddi(s1, s3); a3 = csubi(s1, s3);
    } else {
        const c32 t0 = cadd(a0, a2), t1 = csub(a0, a2), t2 = cadd(a1, a3), t3 = csub(a1, a3);
        a0 = cadd(t0, t2); a2 = csub(t0, t2); a1 = csubi(t1, t3); a3 = caddi(t1, t3);
        if (TW) { a1 = cmulw(a1, t.w1, t.r1); a2 = cmulw(a2, t.w2, t.r2); a3 = cmulw(a3, t.w3, t.r3); }
    }
}
template <int S, bool INV> __device__ __forceinline__ void stage(LAS c32* x, int tid) {
    constexpr int L = N >> (2 * S), q = L / 4;
    asm volatile("" : "+v"(tid));
    if constexpr (q >= 512) {
        LAS c32* xs = x + sw(tid); constexpr int R = q / 512;
#pragma unroll
        for (int i = 0; i < 8; ++i) { const int off = (i / R) * L + 512 * (i % R);
            c32 a0 = xs[off], a1 = xs[off + q], a2 = xs[off + 2 * q], a3 = xs[off + 3 * q];
            const Tw t = make_tw<INV>((float)(tid + 512 * (i % R)) * (1.f / (float)L));
            bfly<INV, true>(a0, a1, a2, a3, t);
            xs[off] = a0; xs[off + q] = a1; xs[off + 2 * q] = a2; xs[off + 3 * q] = a3; }
    } else {
        const int j = tid & (q - 1), base = (tid / q) * L + j;
        LAS c32* p0 = x + sw(base); LAS c32* p1 = x + sw(base + q); LAS c32* p2 = x + sw(base + 2 * q); LAS c32* p3 = x + sw(base + 3 * q);
        Tw t; if constexpr (q > 1) t = make_tw<INV>((float)j * (1.f / (float)L));
#pragma unroll
        for (int i = 0; i < 8; ++i) { c32 a0 = p0[2048 * i], a1 = p1[2048 * i], a2 = p2[2048 * i], a3 = p3[2048 * i];
            bfly<INV, (q > 1)>(a0, a1, a2, a3, t);
            p0[2048 * i] = a0; p1[2048 * i] = a1; p2[2048 * i] = a2; p3[2048 * i] = a3; }
    }
    __syncthreads();
}
template <int S> __device__ __forceinline__ void fwd_stage(LAS c32* x, int tid) { stage<S, false>(x, tid); }
template <int S> __device__ __forceinline__ void inv_stage(LAS c32* x, int tid) { stage<S, true>(x, tid); }
__device__ __forceinline__ void fwd_all(LAS c32* x, int tid) { fwd_stage<0>(x, tid); fwd_stage<1>(x, tid); fwd_stage<2>(x, tid); fwd_stage<3>(x, tid); fwd_stage<4>(x, tid); fwd_stage<5>(x, tid); fwd_stage<6>(x, tid); }
__device__ __forceinline__ void inv_all(LAS c32* x, int tid) { inv_stage<6>(x, tid); inv_stage<5>(x, tid); inv_stage<4>(x, tid); inv_stage<3>(x, tid); inv_stage<2>(x, tid); inv_stage<1>(x, tid); inv_stage<0>(x, tid); }
__device__ __forceinline__ void conv_pair(LAS unsigned char* lds, int tid, int pr, const float* tapF, const float* tapB, const unsigned short* uht, unsigned short* yct) {
    LAS c32* x = (LAS c32*)lds;
    const size_t o1 = (size_t)(2 * pr) * LH, o2 = o1 + LH;
#pragma unroll 1
    for (int h = 0; h < 2; ++h) { f32x4 f1[2], f2[2], b1[2], b2[2];
#pragma unroll
      for (int i = 0; i < 2; ++i) { const int n = 4 * (tid + 512 * (2 * h + i)); f1[i] = *(const f32x4*)(tapF + o1 + n); f2[i] = *(const f32x4*)(tapF + o2 + n); b1[i] = *(const f32x4*)(tapB + o1 + n); b2[i] = *(const f32x4*)(tapB + o2 + n); }
#pragma unroll
      for (int i = 0; i < 2; ++i) {
#pragma unroll
          for (int e = 0; e < 4; ++e) { const int n = 4 * (tid + 512 * (2 * h + i)) + e; const bool z = (n == 0);
              x[sw(n)] = (c32){f1[i][e], f2[i][e]}; x[sw(z ? LH : N - n)] = z ? (c32){0.f, 0.f} : (c32){b1[i][e], b2[i][e]}; } } }
    __syncthreads();
    fwd_all(x, tid);
    const int lane = tid & 63, wv = tid >> 6, khi = ((lane & 3) << 4) | (lane & 12) | (lane >> 4);
    f32x4 Kr[17];
#pragma unroll
    for (int it = 0; it < 17; ++it) { const int m = wv + 8 * it;
        const bool act = (it == 16) ? (wv == 0 && khi < 32) : ((it == 0 && wv == 0) ? (khi <= 32) : true);
        const int kp = (N - (256 * khi + m)) & (N - 1);
        const int pk = sw((rev4b(m) << 6) | lane), pkp = sw(rev4(kp));
        Kr[it] = (f32x4){0.f, 0.f, 0.f, 0.f};
        if (act) { const c32 A = x[pk], Bq = x[pkp]; const c32 B = (c32){Bq.x, -Bq.y};
            const c32 sm = A + B, df = A - B; constexpr float h = 0.5f / (float)N;
            Kr[it] = (f32x4){sm.x * h, sm.y * h, df.y * h, -df.x * h}; } }
    __syncthreads();
    { v2u u1[4], u2[4];
#pragma unroll
      for (int i = 0; i < 4; ++i) { const int n = 4 * (tid + 512 * i); u1[i] = *(const v2u*)(uht + o1 + n); u2[i] = *(const v2u*)(uht + o2 + n); }
#pragma unroll
      for (int i = 0; i < 4; ++i) { const int n = 4 * (tid + 512 * i);
          x[sw(n)] = (c32){blo(u1[i].x), blo(u2[i].x)}; x[sw(n + 1)] = (c32){bhi(u1[i].x), bhi(u2[i].x)}; x[sw(n + 2)] = (c32){blo(u1[i].y), blo(u2[i].y)}; x[sw(n + 3)] = (c32){bhi(u1[i].y), bhi(u2[i].y)};
#pragma unroll
          for (int e = 0; e < 4; ++e) x[sw(LH + n + e)] = (c32){0.f, 0.f}; } }
    __syncthreads();
    fwd_all(x, tid);
#pragma unroll
    for (int it = 0; it < 17; ++it) { const int m = wv + 8 * it;
        const bool act = (it == 16) ? (wv == 0 && khi < 32) : ((it == 0 && wv == 0) ? (khi <= 32) : true);
        const int kp = (N - (256 * khi + m)) & (N - 1);
        const int pk = sw((rev4b(m) << 6) | lane), pkp = sw(rev4(kp));
        if (act) { const c32 A = x[pk], Bq = x[pkp]; const c32 B = (c32){Bq.x, -Bq.y};
            const c32 sm = A + B, df = A - B; const c32 U1 = sm * 0.5f, U2 = (c32){df.y * 0.5f, -df.x * 0.5f};
            const f32x4 K = Kr[it];
            const c32 Y1 = cmul(U1, (c32){K[0], K[1]}), Y2 = cmul(U2, (c32){K[2], K[3]});
            x[pkp] = (c32){Y1.x + Y2.y, Y2.x - Y1.y};
            x[pk]  = (c32){Y1.x - Y2.y, Y1.y + Y2.x}; } }
    __syncthreads();
    inv_all(x, tid);
#pragma unroll
    for (int i = 0; i < 4; ++i) { const int n = 4 * (tid + 512 * i); const c32 v0 = x[sw(n)], v1 = x[sw(n + 1)], v2 = x[sw(n + 2)], v3 = x[sw(n + 3)];
        *(v2u*)(yct + o1 + n) = (v2u){pk2(v0.x, v1.x), pk2(v2.x, v3.x)}; *(v2u*)(yct + o2 + n) = (v2u){pk2(v0.y, v1.y), pk2(v2.y, v3.y)}; }
    __syncthreads();
}
}
__device__ __forceinline__ float da_lambda(const Args& A, const Frame& F) {
    const float* lp = A.in[22]; const int l = F.lane;
    const float sa = wave_sum(lp[l] * lp[64 + l]), sb = wave_sum(lp[128 + l] * lp[192 + l]);
    return __expf(sa) - __expf(sb) + 0.2f;
}
__device__ __forceinline__ void p5_finalize(const Args& A, Frame& F) {
    { const float lam = da_lambda(A, F); const float* O = (const float*)(F.ws + WS_O); bf16* yda = (bf16*)(F.ws + WS_YDA); const float* sub = A.in[23];
      const int head = F.lane >> 3, e0 = (F.lane & 7) * 16;
      float sl[16];
#pragma unroll
      for (int i = 0; i < 16; ++i) sl[i] = sub[e0 + i] * 0.8f;
      for (int t = F.gw; t < SEQ; t += F.NGW) {
          const float* o0 = O + (size_t)t * 2048 + (2 * head) * 128 + e0; const float* o1 = o0 + 128;
          float y[16]; float ss = 0.f;
#pragma unroll
          for (int q = 0; q < 4; ++q) { const f32x4 a = *(const f32x4*)(o0 + 4 * q), b = *(const f32x4*)(o1 + 4 * q);
#pragma unroll
              for (int e = 0; e < 4; ++e) { const float v = a[e] - lam * b[e]; y[4 * q + e] = v; ss += v * v; } }
          ss += __shfl_xor(ss, 1); ss += __shfl_xor(ss, 2); ss += __shfl_xor(ss, 4);
          const float rstd = rsqrtf(ss * (1.f / 128.f) + EPS);
          v4u w0, w1; w0.x = pk2(y[0] * rstd * sl[0], y[1] * rstd * sl[1]); w0.y = pk2(y[2] * rstd * sl[2], y[3] * rstd * sl[3]);
          w0.z = pk2(y[4] * rstd * sl[4], y[5] * rstd * sl[5]); w0.w = pk2(y[6] * rstd * sl[6], y[7] * rstd * sl[7]);
          w1.x = pk2(y[8] * rstd * sl[8], y[9] * rstd * sl[9]); w1.y = pk2(y[10] * rstd * sl[10], y[11] * rstd * sl[11]);
          w1.z = pk2(y[12] * rstd * sl[12], y[13] * rstd * sl[13]); w1.w = pk2(y[14] * rstd * sl[14], y[15] * rstd * sl[15]);
          bf16* dst = yda + (size_t)t * 1024 + head * 128 + e0; *(v4u*)dst = w0; *(v4u*)(dst + 8) = w1; } }
    { const bf16* yct = (const bf16*)(F.ws + WS_YCT); const bf16* uht = (const bf16*)(F.ws + WS_UHT); const bf16* x0 = (const bf16*)(F.ws + WS_X0);
      bf16* yhy = (bf16*)(F.ws + WS_YHY); const float* bias = A.in[21];
      LAS unsigned char* tile = F.lds;
#pragma unroll 1
      for (int it = F.vcu; it < 256; it += F.G) { int ln = F.lane; asm volatile("" : "+v"(ln));
          const int t0 = (it >> 1) * 64, cbase = (it & 1) * 512, csub = ln >> 3, piece = ln & 7;
          v4u yv[8], uv[8]; float bv[8];
#pragma unroll
          for (int i = 0; i < 8; ++i) { const int cl = 64 * F.wave + 8 * i + csub; const size_t o = (size_t)(cbase + cl) * SEQ + t0 + 8 * piece;
              yv[i] = *(const v4u*)(yct + o); uv[i] = *(const v4u*)(uht + o); bv[i] = bias[cbase + cl]; }
#pragma unroll
          for (int i = 0; i < 8; ++i) { const int cl = 64 * F.wave + 8 * i + csub;
              LAS unsigned short* tp = (LAS unsigned short*)(tile + (size_t)(8 * piece) * 1024 + ((((cl >> 3) ^ piece) & 63) << 4) + 2 * (cl & 7));
#pragma unroll
              for (int h = 0; h < 4; ++h) { tp[(2 * h) * 512] = (unsigned short)f2bf(blo(yv[i][h]) + blo(uv[i][h]) * bv[i]); tp[(2 * h + 1) * 512] = (unsigned short)f2bf(bhi(yv[i][h]) + bhi(uv[i][h]) * bv[i]); } }
          __syncthreads();
          v4u xv[8];
#pragma unroll
          for (int tt = 0; tt < 8; ++tt) xv[tt] = *(const v4u*)(x0 + (size_t)(t0 + 8 * F.wave + tt) * 1024 + cbase + 8 * ln);
#pragma unroll
          for (int tt = 0; tt < 8; ++tt) { const int tl = 8 * F.wave + tt;
              const v4u m = *(const LAS v4u*)(tile + (size_t)tl * 1024 + (((ln ^ (tl >> 3)) & 63) << 4)); v4u o;
#pragma unroll
              for (int h = 0; h < 4; ++h) o[h] = pk2(blo(xv[tt][h]) * blo(m[h]), bhi(xv[tt][h]) * bhi(m[h]));
              *(v4u*)(yhy + (size_t)(t0 + tl) * 1024 + cbase + 8 * ln) = o; }
          __syncthreads();
      } }
}

__device__ __forceinline__ void p8_rows(const Args& A, Frame& F) {
    const float* mix = (const float*)(F.ws + WS_MIX); bf16* hb = (bf16*)(F.ws + WS_HB);
    int r = F.gw; if (r >= SEQ) return;
    f32x4 ga[8], a2[8], b2[8];
#pragma unroll
    for (int j = 0; j < 8; ++j) { const int col = 4 * F.lane + 256 * j;
        ga[j] = mod4(A, F, 0, 2 * DM + col) * *(const f32x4*)(A.in[7] + col);
        a2[j] = *(const f32x4*)(A.in[8] + col) * (mod4(A, F, 0, 4 * DM + col) + 1.f); b2[j] = mod4(A, F, 0, 3 * DM + col); }
    for (; r < SEQ; r += F.NGW) {
        const f32x4* mr = (const f32x4*)(mix + (size_t)r * DM) + F.lane; const f32x4* xr = (const f32x4*)(A.in[0] + (size_t)r * DM) + F.lane;
        f32x4 v[8], xv[8]; float s = 0.f;
#pragma unroll
        for (int j = 0; j < 8; ++j) { v[j] = mr[64 * j]; xv[j] = xr[64 * j]; }
#pragma unroll
        for (int j = 0; j < 8; ++j) s += (v[j][0] * v[j][0] + v[j][1] * v[j][1]) + (v[j][2] * v[j][2] + v[j][3] * v[j][3]);
        const float rstd = rsqrtf(wave_sum(s) * (1.f / DM) + EPS); float s2 = 0.f;
        f32x4* orow = (f32x4*)(F.out + (size_t)r * DM) + F.lane;
#pragma unroll
        for (int j = 0; j < 8; ++j) { v[j] = xv[j] + v[j] * rstd * ga[j]; orow[64 * j] = v[j];
            s2 += (v[j][0] * v[j][0] + v[j][1] * v[j][1]) + (v[j][2] * v[j][2] + v[j][3] * v[j][3]); }
        const float rstd2 = rsqrtf(wave_sum(s2) * (1.f / DM) + EPS);
        unsigned long long* o8 = (unsigned long long*)(hb + (size_t)r * DM) + F.lane;
#pragma unroll
        for (int j = 0; j < 8; ++j) { const f32x4 y = v[j] * rstd2 * a2[j] + b2[j];
            o8[64 * j] = (unsigned long long)pk2(y[0], y[1]) | ((unsigned long long)pk2(y[2], y[3]) << 32); }
    }
}

typedef float f32x16 __attribute__((ext_vector_type(16)));
#define TK_CS(A, B) do { const float hi_ = __builtin_fmaxf(v[A], v[B]), lo_ = __builtin_fminf(v[A], v[B]); v[A] = hi_; v[B] = lo_; } while (0)
__device__ __forceinline__ float tk_tag(float x, unsigned mask, unsigned id) { return __uint_as_float((__float_as_uint(x) & ~mask) | id); }
__device__ __forceinline__ void tk_sort16(float (&v)[16]) {
#pragma unroll
    for (int k = 2; k <= 16; k <<= 1)
#pragma unroll
        for (int j = k >> 1; j >= 1; j >>= 1)
#pragma unroll
            for (int i = 0; i < 16; ++i) { const int l = i ^ j; if (l > i) { if ((i & k) == 0) TK_CS(i, l); else TK_CS(l, i); } }
}
__device__ __forceinline__ void tk_merge16(float (&v)[16], const float (&o)[16]) {
#pragma unroll
    for (int t = 0; t < 16; ++t) v[t] = __builtin_fmaxf(v[t], o[15 - t]);
#pragma unroll
    for (int st = 8; st >= 1; st >>= 1)
#pragma unroll
        for (int t = 0; t < 16; ++t) if ((t & st) == 0) TK_CS(t, t + st);
}
__device__ __forceinline__ void p11_item(const Args& A, Frame& F, int item) {
    const int tb = item & 31, h = item >> 5;
    typedef short s16x8 __attribute__((ext_vector_type(8)));
    LAS unsigned char* KH = F.lds;
    const float* keys = A.in[28];
    for (int i = F.tid; i < 2 * 128 * 16; i += NTHR) { const int ch = i & 15, k = (i >> 4) & 127, p = i >> 11;
        const float* src = keys + ((size_t)(p * 8 + h) * 128 + k) * 128 + ch * 8; const f32x4 a = *(const f32x4*)src, b = *(const f32x4*)(src + 4);
        const float x[8] = {a[0], a[1], a[2], a[3], b[0], b[1], b[2], b[3]}; unsigned hw[4], lw[4];
#pragma unroll
        for (int e = 0; e < 4; ++e) { const unsigned h0 = f2bf(x[2 * e]), h1 = f2bf(x[2 * e + 1]); hw[e] = h0 | (h1 << 16);
            lw[e] = pk2(x[2 * e] - __builtin_bit_cast(float, h0 << 16), x[2 * e + 1] - __builtin_bit_cast(float, h1 << 16)); }
        LAS unsigned char* d = KH + (size_t)p * 65536 + (size_t)k * 256 + ((ch ^ (k & 15)) << 4);
        *(LAS v4u*)d = (v4u){hw[0], hw[1], hw[2], hw[3]}; *(LAS v4u*)(d + 32768) = (v4u){lw[0], lw[1], lw[2], lw[3]}; }
    __syncthreads();
    const int lane = F.lane, r32 = lane & 31, hi = lane >> 5;
    const int n = tb * 256 + F.wave * 32 + r32;
    const float* qrow = (const float*)(F.ws + WS_QP) + (size_t)n * DM + h * 256;
    f32x16 acc[2][4];
#pragma unroll
    for (int p = 0; p < 2; ++p) {
#pragma unroll
        for (int kt = 0; kt < 4; ++kt) acc[p][kt] = f32x16{};
        const LAS unsigned char* kb = KH + (size_t)p * 65536 + (size_t)r32 * 256;
        const float* qp = qrow + p * 128 + 8 * hi;
        f32x4 qa = *(const f32x4*)qp, qb = *(const f32x4*)(qp + 4);
#pragma unroll 1
        for (int s = 0; s < 8; ++s) {
            const f32x4 ca = qa, cb = qb; { const int sn = (s + 1) & 7; qa = *(const f32x4*)(qp + 16 * sn); qb = *(const f32x4*)(qp + 16 * sn + 4); }
            const float x[8] = {ca[0], ca[1], ca[2], ca[3], cb[0], cb[1], cb[2], cb[3]}; unsigned hw[4], lw[4];
#pragma unroll
            for (int e = 0; e < 4; ++e) { const unsigned h0 = f2bf(x[2 * e]), h1 = f2bf(x[2 * e + 1]); hw[e] = h0 | (h1 << 16);
                lw[e] = pk2(x[2 * e] - __builtin_bit_cast(float, h0 << 16), x[2 * e + 1] - __builtin_bit_cast(float, h1 << 16)); }
            const v4u bhv = {hw[0], hw[1], hw[2], hw[3]}, blv = {lw[0], lw[1], lw[2], lw[3]};
            const s16x8 bh = __builtin_bit_cast(s16x8, bhv), bl = __builtin_bit_cast(s16x8, blv);
            const int co = (((2 * s + hi) ^ (r32 & 15)) << 4);
#pragma unroll
            for (int kt = 0; kt < 4; ++kt) { const s16x8 ah = *(const LAS s16x8*)(kb + kt * 8192 + co), al = *(const LAS s16x8*)(kb + kt * 8192 + co + 32768);
                acc[p][kt] = __builtin_amdgcn_mfma_f32_32x32x16_bf16(al, bh, acc[p][kt], 0, 0, 0);
                acc[p][kt] = __builtin_amdgcn_mfma_f32_32x32x16_bf16(ah, bl, acc[p][kt], 0, 0, 0);
                acc[p][kt] = __builtin_amdgcn_mfma_f32_32x32x16_bf16(ah, bh, acc[p][kt], 0, 0, 0); }
        }
    }
    __syncthreads();
    float lv[2][16];
#pragma unroll
    for (int p = 0; p < 2; ++p) {
        float v[16];
#pragma unroll
        for (int r = 0; r < 16; ++r) v[r] = tk_tag(acc[p][0][r], 127u, (unsigned)((r & 3) + 8 * (r >> 2) + 4 * hi));
        tk_sort16(v);
#pragma unroll
        for (int kt = 1; kt < 4; ++kt) { float w[16];
#pragma unroll
            for (int r = 0; r < 16; ++r) w[r] = tk_tag(acc[p][kt][r], 127u, (unsigned)(32 * kt + (r & 3) + 8 * (r >> 2) + 4 * hi));
            tk_sort16(w); tk_merge16(v, w); }
        { float ov[16];
#pragma unroll
          for (int t = 0; t < 16; ++t) ov[t] = __shfl_xor(v[t], 32);
          tk_merge16(v, ov); }
#pragma unroll
        for (int t = 0; t < 16; ++t) lv[p][t] = v[t];
    }
    LAS int* cidl = (LAS int*)F.lds + (F.wave * 32 + r32) * 65;
    float blk[4][16]; { int c = 0;
#pragma unroll
        for (int i = 0; i < 16; ++i)
#pragma unroll
            for (int j = 0; j < 16; ++j) if ((i + 1) * (j + 1) <= 16) {
                blk[c >> 4][c & 15] = tk_tag(lv[0][i] + lv[1][j], 63u, (unsigned)c);
                if (hi == 0) cidl[c] = (int)((__float_as_uint(lv[0][i]) & 127u) * 128u + (__float_as_uint(lv[1][j]) & 127u));
                ++c; }
#pragma unroll
        for (; c < 64; ++c) blk[c >> 4][c & 15] = tk_tag(-3.0e38f, 63u, (unsigned)c); }
    tk_sort16(blk[0]); tk_sort16(blk[1]); tk_sort16(blk[2]); tk_sort16(blk[3]);
    tk_merge16(blk[0], blk[1]); tk_merge16(blk[2], blk[3]); tk_merge16(blk[0], blk[2]);
    float e[16], sum = 0.f;
#pragma unroll
    for (int t = 0; t < 16; ++t) { e[t] = __expf(blk[0][t] - blk[0][0]); sum += e[t]; }
    const float rs = 1.f / sum;
    if (hi == 0) { int* io = (int*)(F.ws + WS_IDX) + (size_t)n * 128 + h * 16; float* go = (float*)(F.ws + WS_GW) + (size_t)n * 128 + h * 16;
        int id[16];
#pragma unroll
        for (int t = 0; t < 16; ++t) id[t] = cidl[__float_as_uint(blk[0][t]) & 63u];
#pragma unroll
        for (int t = 0; t < 16; t += 4) { *(v4u*)(io + t) = (v4u){(unsigned)id[t], (unsigned)id[t + 1], (unsigned)id[t + 2], (unsigned)id[t + 3]};
            *(f32x4*)(go + t) = (f32x4){e[t] * rs, e[t + 1] * rs, e[t + 2] * rs, e[t + 3] * rs}; } }
    __syncthreads();
}
#undef TK_CS

__device__ __forceinline__ float gelu_erf(float x) { return 0.5f * x * (1.f + erff(x * 0.7071067811865476f)); }
__device__ __forceinline__ void fmac1(float& acc, float a, float b) { asm("v_fmac_f32 %0, %1, %2" : "+v"(acc) : "v"(a), "v"(b)); }
typedef _Float16 h2 __attribute__((ext_vector_type(2)));
__device__ __forceinline__ void p12_coldots(const Args& A, Frame& F) {
    typedef float f32x2 __attribute__((ext_vector_type(2)));
    const bf16* hb = (const bf16*)(F.ws + WS_HB); const unsigned char* ub = F.ws + WS_UB; const int* idx = (const int*)(F.ws + WS_IDX);
    const int lane = F.lane, wpg = F.NGW >> 3, x = F.gw / wpg, wl = F.gw - x * wpg, rs = lane >> 4, cc = lane & 15;
    float* pdx = (float*)(F.ws + WS_PD) + (size_t)x * SEQ * 128;
    const size_t coff = 256 * x + 16 * cc;
    const unsigned char* usl = ub + (size_t)x * ((size_t)NEXP * 256) + 16 * cc;
#define P12_LOADH(HF, ID0, ID1, nn) do { const v4u a_ = *(const v4u*)(hb + (size_t)(nn) * DM + coff), b_ = *(const v4u*)(hb + (size_t)(nn) * DM + coff + 8); \
        HF[0] = (h2){(_Float16)blo(a_.x), (_Float16)bhi(a_.x)}; HF[1] = (h2){(_Float16)blo(a_.y), (_Float16)bhi(a_.y)}; HF[2] = (h2){(_Float16)blo(a_.z), (_Float16)bhi(a_.z)}; HF[3] = (h2){(_Float16)blo(a_.w), (_Float16)bhi(a_.w)}; \
        HF[4] = (h2){(_Float16)blo(b_.x), (_Float16)bhi(b_.x)}; HF[5] = (h2){(_Float16)blo(b_.y), (_Float16)bhi(b_.y)}; HF[6] = (h2){(_Float16)blo(b_.z), (_Float16)bhi(b_.z)}; HF[7] = (h2){(_Float16)blo(b_.w), (_Float16)bhi(b_.w)}; \
        ID0 = idx[(size_t)(nn) * 128 + lane]; ID1 = idx[(size_t)(nn) * 128 + 64 + lane]; } while (0)
#define P12_LOADW(W, ID) do { _Pragma("unroll") for (int i = 0; i < 16; ++i) { const int e_ = __shfl((ID), 4 * i + rs); W[i] = *(const v4u*)(usl + (size_t)e_ * 256); } } while (0)
#define P12_DOTS(W, HF, B) do { _Pragma("unroll") for (int i = 0; i < 16; ++i) { float a0 = 0.f, a1 = 0.f; \
        _Pragma("unroll") for (int e = 0; e < 4; ++e) { const h2 lo = __builtin_amdgcn_cvt_scalef32_pk_f16_fp8((int)W[i][e], 1.0f, false), hi2 = __builtin_amdgcn_cvt_scalef32_pk_f16_fp8((int)W[i][e], 1.0f, true); \
            a0 = __builtin_amdgcn_fdot2(lo, HF[2 * e], a0, false); a1 = __builtin_amdgcn_fdot2(hi2, HF[2 * e + 1], a1, false); } \
        acc[16 * (B) + i] = a0 + a1; } } while (0)
    h2 hf[8], hfn[8]; int id0, id1, idn0 = 0, idn1 = 0; v4u wA[16], wB[16];
    if (wl < SEQ) { P12_LOADH(hf, id0, id1, wl); P12_LOADW(wA, id0); }
#pragma unroll 1
    for (int n = wl; n < SEQ; n += wpg) {
        const int nn = n + wpg; const bool more = nn < SEQ;
        float acc[32];
        if (more) P12_LOADH(hfn, idn0, idn1, nn);
        P12_LOADW(wB, id1);
        __builtin_amdgcn_sched_barrier(0);
        P12_DOTS(wA, hf, 0);
        __builtin_amdgcn_sched_barrier(0);
        if (more) P12_LOADW(wA, idn0);
        __builtin_amdgcn_sched_barrier(0);
        P12_DOTS(wB, hf, 1);
        __builtin_amdgcn_sched_barrier(0);
        float r16[16], r8[8], r4[4], r2[2];
        { const bool t = cc & 8;
#pragma unroll
          for (int k = 0; k < 16; ++k) r16[k] = (t ? acc[k + 16] : acc[k]) + __shfl_xor(t ? acc[k] : acc[k + 16], 8); }
        { const bool t = cc & 4;
#pragma unroll
          for (int k = 0; k < 8; ++k) r8[k] = (t ? r16[k + 8] : r16[k]) + __shfl_xor(t ? r16[k] : r16[k + 8], 4); }
        { const bool t = cc & 2;
#pragma unroll
          for (int k = 0; k < 4; ++k) r4[k] = (t ? r8[k + 4] : r8[k]) + __shfl_xor(t ? r8[k] : r8[k + 4], 2); }
        { const bool t = cc & 1;
#pragma unroll
          for (int k = 0; k < 2; ++k) r2[k] = (t ? r4[k + 2] : r4[k]) + __shfl_xor(t ? r4[k] : r4[k + 2], 1); }
        const int I0 = 2 * (cc & 1) + 4 * ((cc >> 1) & 1) + 8 * ((cc >> 2) & 1) + 16 * (cc >> 3);
        pdx[(size_t)n * 128 + 4 * I0 + rs] = r2[0]; pdx[(size_t)n * 128 + 4 * (I0 + 1) + rs] = r2[1];
#pragma unroll
        for (int i = 0; i < 8; ++i) hf[i] = hfn[i];
        id0 = idn0; id1 = idn1;
    }
#undef P12_LOADH
#undef P12_LOADW
#undef P12_DOTS
}
__device__ __forceinline__ void p12b_weights(const Args& A, Frame& F) {
    const int* idx = (const int*)(F.ws + WS_IDX); const float* gwp = (const float*)(F.ws + WS_GW); const float* pd = (const float*)(F.ws + WS_PD);
    const float* usc = (const float*)(F.ws + WS_USC); const float* vsc = (const float*)(F.ws + WS_VSC); float* wgt = (float*)(F.ws + WS_WGT);
    const int lane = F.lane;
    for (int n = F.gw; n < SEQ; n += F.NGW) {
        const int id0 = idx[(size_t)n * 128 + lane], id1 = idx[(size_t)n * 128 + 64 + lane];
        float d0 = 0.f, d1 = 0.f;
#pragma unroll
        for (int g = 0; g < 8; ++g) { d0 += pd[((size_t)g * SEQ + n) * 128 + lane]; d1 += pd[((size_t)g * SEQ + n) * 128 + 64 + lane]; }
        wgt[(size_t)n * 128 + lane] = gwp[(size_t)n * 128 + lane] * gelu_erf(d0 * usc[id0]) * vsc[id0];
        wgt[(size_t)n * 128 + 64 + lane] = gwp[(size_t)n * 128 + 64 + lane] * gelu_erf(d1 * usc[id1]) * vsc[id1];
    }
}
__device__ __forceinline__ void p13_colsum(const Args& A, Frame& F) {
    typedef float f32x2 __attribute__((ext_vector_type(2)));
    const unsigned char* vb = F.ws + WS_VB; const int* idx = (const int*)(F.ws + WS_IDX); const float* gwp = (const float*)(F.ws + WS_GW);
    const float* wgt = (const float*)(F.ws + WS_WGT);
    float* opre = (float*)(F.ws + WS_OPRE); float* ssp = (float*)(F.ws + WS_SSP);
    const int lane = F.lane, wpg = F.NGW >> 3, x = F.gw / wpg, wl = F.gw - x * wpg, rs = lane >> 4, cc = lane & 15;
    const size_t coff = 256 * x + 16 * cc;
    const unsigned char* vsl = vb + (size_t)x * ((size_t)NEXP * 256) + 16 * cc;
#pragma unroll 1
    for (int n = wl; n < SEQ; n += wpg) {
        const int id0 = idx[(size_t)n * 128 + lane], id1 = idx[(size_t)n * 128 + 64 + lane];
        const float wg0 = wgt[(size_t)n * 128 + lane], wg1 = wgt[(size_t)n * 128 + 64 + lane];
        h2 o2[8];
#pragma unroll
        for (int i = 0; i < 8; ++i) o2[i] = (h2){(_Float16)0.f, (_Float16)0.f};
#pragma unroll
        for (int b = 0; b < 2; ++b) {
            v4u w[16]; h2 wv[16];
#pragma unroll
            for (int i = 0; i < 16; ++i) { const int e = __shfl(b ? id1 : id0, 4 * i + rs); const _Float16 t = (_Float16)(__shfl(b ? wg1 : wg0, 4 * i + rs) * 4096.f); wv[i] = (h2){t, t};
                w[i] = *(const v4u*)(vsl + (size_t)e * 256); }
#pragma unroll
            for (int i = 0; i < 16; ++i) {
#pragma unroll
                for (int e = 0; e < 4; ++e) { const h2 lo = __builtin_amdgcn_cvt_scalef32_pk_f16_fp8((int)w[i][e], 1.0f, false), hi2 = __builtin_amdgcn_cvt_scalef32_pk_f16_fp8((int)w[i][e], 1.0f, true);
                    o2[2 * e] = lo * wv[i] + o2[2 * e]; o2[2 * e + 1] = hi2 * wv[i] + o2[2 * e + 1]; } }
            __builtin_amdgcn_sched_barrier(0);
        }
        float o[16];
#pragma unroll
        for (int i = 0; i < 8; ++i) { o[2 * i] = (float)o2[i][0] * (1.f / 4096.f); o[2 * i + 1] = (float)o2[i][1] * (1.f / 4096.f); }
        float t8[8]; f32x4 t4;
        { const bool t = lane & 32;
#pragma unroll
          for (int k = 0; k < 8; ++k) t8[k] = (t ? o[k + 8] : o[k]) + __shfl_xor(t ? o[k] : o[k + 8], 32); }
        { const bool t = lane & 16;
#pragma unroll
          for (int k = 0; k < 4; ++k) t4[k] = (t ? t8[k + 4] : t8[k]) + __shfl_xor(t ? t8[k] : t8[k + 4], 16); }
        *(f32x4*)(opre + (size_t)n * DM + coff + 8 * (lane >> 5) + 4 * ((lane >> 4) & 1)) = t4;
        const float ss = wave_sum((t4[0] * t4[0] + t4[1] * t4[1]) + (t4[2] * t4[2] + t4[3] * t4[3]));
        if (lane == 0) ssp[(size_t)x * SEQ + n] = ss;
    }
}
__device__ __forceinline__ void p14_final(const Args& A, Frame& F) {
    const float* opre = (const float*)(F.ws + WS_OPRE); const float* ssp = (const float*)(F.ws + WS_SSP);
    int n = F.gw; if (n >= SEQ) return;
    f32x4 gnp[8];
#pragma unroll
    for (int j = 0; j < 8; ++j) { const int col = 4 * F.lane + 256 * j; gnp[j] = mod4(A, F, 0, 5 * DM + col) * *(const f32x4*)(A.in[9] + col); }
    for (; n < SEQ; n += F.NGW) {
        const float ss = wave_sum(F.lane < 8 ? ssp[(size_t)F.lane * SEQ + n] : 0.f);
        const float rstd = rsqrtf(ss * (1.f / DM) + EPS);
        const f32x4* pr = (const f32x4*)(opre + (size_t)n * DM) + F.lane; f32x4* orow = (f32x4*)(F.out + (size_t)n * DM) + F.lane;
        f32x4 p[8], xo[8];
#pragma unroll
        for (int j = 0; j < 8; ++j) { p[j] = pr[64 * j]; xo[j] = orow[64 * j]; }
#pragma unroll
        for (int j = 0; j < 8; ++j) orow[64 * j] = xo[j] + gnp[j] * p[j] * rstd;
    }
}
constexpr int NPH = 16;
constexpr int CW_BAR = 4096;
constexpr int MAX_LAUNCHES = 3;
static_assert((CW_BAR + MAX_LAUNCHES * XCD_BAR_WORDS) * 4 <= (int)CTL_ZERO_BYTES, "barrier words inside the memset region");
__device__ __forceinline__ bool refresh_ids(Frame& F) { int t = threadIdx.x; asm volatile("" : "+v"(t)); F.tid = t; F.lane = t & 63; return true; }
__global__ void __launch_bounds__(NTHR, 2) hybrid_fwd(Args args) {
    extern __shared__ __attribute__((aligned(16))) unsigned char lds[];
    Frame F;
    F.lds = (LAS unsigned char*)lds; F.ldsg = (char*)lds;
    F.tid = threadIdx.x; F.lane = F.tid & 63; F.wave = __builtin_amdgcn_readfirstlane(F.tid >> 6);
    F.G = gridDim.x; { const int bx = blockIdx.x; F.vcu = (F.G % 8 == 0) ? (bx % 8) * (F.G / 8) + bx / 8 : bx; }
    F.gw = F.vcu * NWAVES + F.wave; F.NGW = F.G * NWAVES;
    F.out = args.out; F.ws = args.ws;
    volatile LAS unsigned* MISC = (volatile LAS unsigned*)(F.lds + MISC_OFF);
    for (int u = F.tid; u < 64; u += NTHR) MISC[u] = 0u;
    __syncthreads();
    unsigned* ctl = (unsigned*)(F.ws + WS_CTL);
    XcdBarrier bar = xcd_barrier_post(ctl + CW_BAR + args.li * XCD_BAR_WORDS, MISC + 8);
    const int lo = args.ph_lo, hi = args.ph_hi;
#define IN(k) (lo <= (k) && (k) < hi && refresh_ids(F))
#define SEAM(k) do { if (IN(k) && IN((k) + 1)) xcd_barrier(bar); } while (0)

    if (IN(0)) { p0_prologue(args, F); } SEAM(0);
    if (IN(1)) { p1_rows(args, F); } SEAM(1);
    if (IN(2)) {
        p2_ctx_unit(F);
        pg8::Gemm g{(const bf16*)(F.ws + WS_U), (const bf16*)(F.ws + WS_WIN), SEQ, INCOLS, DM}; pg8::StaticOrder S; S.init(SEQ, INCOLS, F.G, (int)blockIdx.x);
        pg8::EpiSplit1 E{(bf16*)(F.ws + WS_PHY), (long)(WS_QRAW - WS_PHY) / 2, (long)(WS_KRAW - WS_PHY) / 2, (long)(WS_V2 - WS_PHY) / 2, (long)(WS_GATES - WS_PHY) / 2};
        pg8::gemm_phase<pg8::EpiSplit1, pg8::StaticOrder, true, true>(F.lds, g, S, E);
    } SEAM(2);
    if (IN(3)) { p3_post(args, F, F.gw, F.NGW); } SEAM(3);
    if (IN(4)) {
        const int x = F.vcu >> 5, qb = F.vcu & 31;
        if (F.G == 256) {
#pragma unroll 1
            for (int i = 0; i < 2; ++i) { const int hm = 2 * x + i;
                att::attn_unit((const bf16*)(F.ws + WS_Q2) + (size_t)(qb * 256) * 1024 + hm * 64, (const bf16*)(F.ws + WS_K2) + hm * 64,
                               (const bf16*)(F.ws + WS_V2) + (hm >> 1) * 128, (float*)(F.ws + WS_O) + (size_t)(qb * 256) * 2048 + hm * 128, NKEYS, F.ldsg); }
#ifdef ATT_VAR
            { const int hm = 2 * x;
                att::attn_unit<ATT_VAR>((const bf16*)(F.ws + WS_Q2) + (size_t)(qb * 256) * 1024 + hm * 64, (const bf16*)(F.ws + WS_K2) + hm * 64,
                               (const bf16*)(F.ws + WS_V2) + (hm >> 1) * 128, (float*)(F.ws + WS_KSPEC), NKEYS, F.ldsg); }
#endif
        }
    }
    if (IN(5)) {
#pragma unroll 1
        for (int pr = F.vcu; pr < HYW / 2; pr += F.G)
            fftc::conv_pair(F.lds, F.tid, pr, (const float*)(F.ws + WS_TAPF), (const float*)(F.ws + WS_TAPB), (const bf16*)(F.ws + WS_UHT), (bf16*)(F.ws + WS_YCT));
    } SEAM(5);
    if (IN(6)) { p5_finalize(args, F); } SEAM(6);
    if (IN(7)) {
        pg8::StaticOrder S; S.init(SEQ, DM, F.G, (int)blockIdx.x);
        { pg8::Gemm g{(const bf16*)(F.ws + WS_YHY), (const bf16*)(F.ws + WS_WHY), SEQ, DM, HYW};
          pg8::EpiGate<0> E{(bf16*)(F.ws + WS_MB), DM, (const bf16*)(F.ws + WS_GATES), 4096};
          pg8::gemm_phase<pg8::EpiGate<0>, pg8::StaticOrder, true, true>(F.lds, g, S, E); }
        { pg8::Gemm g{(const bf16*)(F.ws + WS_YDA), (const bf16*)(F.ws + WS_WDA), SEQ, DM, HYW};
          pg8::EpiGate<1> E{(bf16*)(F.ws + WS_MB), DM, (const bf16*)(F.ws + WS_GATES) + 2048, 4096};
          pg8::gemm_phase<pg8::EpiGate<1>, pg8::StaticOrder, true, true>(F.lds, g, S, E); }
    } SEAM(7);
    if (IN(8)) {
        pg8::Gemm g{(const bf16*)(F.ws + WS_MB), (const bf16*)(F.ws + WS_WO), SEQ, DM, DM}; pg8::StaticOrder S; S.init(SEQ, DM, F.G, (int)blockIdx.x);
        pg8::EpiF32 E{(float*)(F.ws + WS_MIX), DM};
        pg8::gemm_phase<pg8::EpiF32, pg8::StaticOrder, true, true>(F.lds, g, S, E);
    } SEAM(8);
    if (IN(9)) { p8_rows(args, F); } SEAM(9);
    if (IN(10)) {
        pg8::Gemm g{(const bf16*)(F.ws + WS_HB), (const bf16*)(F.ws + WS_WQ), SEQ, DM, DM}; pg8::StaticOrder S; S.init(SEQ, DM, F.G, (int)blockIdx.x);
        pg8::EpiF32 E{(float*)(F.ws + WS_QP), DM};
        pg8::gemm_phase<pg8::EpiF32, pg8::StaticOrder, true, true>(F.lds, g, S, E);
    } SEAM(10);
    if (IN(11)) {
#pragma unroll 1
        for (int it = F.vcu; it < 256; it += F.G) p11_item(args, F, it);
    } SEAM(11);
    if (IN(12)) { p12_coldots(args, F); } SEAM(12);
    if (IN(13)) { p12b_weights(args, F); } SEAM(13);
    if (IN(14)) { p13_colsum(args, F); } SEAM(14);
    if (IN(15)) { p14_final(args, F); }
#undef IN
#undef SEAM
}

#ifndef PROBE_PH
#define PROBE_PH -1
#endif
extern "C" void kernel_launch(void* const* d_in, const int* in_sizes, int n_in, void* d_out, int out_size, void* d_ws, size_t ws_size, hipStream_t stream) {
    static int grid = 0;
    if (grid == 0) {
        if (n_in != 31 || in_sizes[0] != SEQ * DM || out_size != SEQ * DM || ws_size < WS_END) {
            fprintf(stderr, "kernel_launch: built for 31 inputs, x/out of %d floats, >= %zu bytes of workspace; got n_in %d, in0 %d, out %d, ws %zu; nothing launched\n",
                    SEQ * DM, (size_t)WS_END, n_in, n_in > 0 ? in_sizes[0] : -1, out_size, ws_size); grid = -1; return; }
        int dev = 0, cus = 0, per_cu = 0;
        if (hipGetDevice(&dev) != hipSuccess || hipDeviceGetAttribute(&cus, hipDeviceAttributeMultiprocessorCount, dev) != hipSuccess) { fprintf(stderr, "kernel_launch: device query failed\n"); grid = -1; return; }
        if (hipFuncSetAttribute((const void*)hybrid_fwd, hipFuncAttributeMaxDynamicSharedMemorySize, LDS_BYTES) != hipSuccess) { fprintf(stderr, "kernel_launch: hipFuncSetAttribute failed\n"); grid = -1; return; }
        if (hipOccupancyMaxActiveBlocksPerMultiprocessor(&per_cu, (const void*)hybrid_fwd, NTHR, LDS_BYTES) != hipSuccess || per_cu < 1) {
            fprintf(stderr, "kernel_launch: occupancy query reports %d workgroups per CU; nothing launched\n", per_cu); (void)hipGetLastError(); grid = -1; return; }
        grid = cus;
        if (grid != 256) fprintf(stderr, "kernel_launch: note: %d CUs (tuned for 256)\n", grid);
    }
    if (grid < 0) return;
    if (hipMemsetAsync((char*)d_ws + WS_CTL, 0, CTL_ZERO_BYTES, stream) != hipSuccess) { fprintf(stderr, "kernel_launch: hipMemsetAsync failed\n"); return; }
    Args a{};
    for (int i = 0; i < 31; ++i) a.in[i] = (const float*)d_in[i];
    a.out = (float*)d_out; a.ws = (unsigned char*)d_ws;
    constexpr int NL = (PROBE_PH >= 0) ? 3 : 1;
    const int cut[4] = {0, (PROBE_PH >= 0) ? PROBE_PH + 1 : NPH, (PROBE_PH >= 0) ? PROBE_PH + 1 : NPH, NPH};
    for (int li = 0; li < NL; ++li) {
        a.ph_lo = (li == 1) ? PROBE_PH : cut[li]; a.ph_hi = cut[li + 1]; a.li = li;
        if (a.ph_lo >= a.ph_hi) continue;
        hipLaunchKernelGGL(hybrid_fwd, dim3(grid), dim3(NTHR), LDS_BYTES, stream, a);
        const hipError_t le = hipPeekAtLastError();
        if (le != hipSuccess) { fprintf(stderr, "kernel_launch: launch %d failed: %s\n", li, hipGetErrorName(le)); break; }
    }
}
```

```cpp
#include <hip/hip_runtime.h>
#include <hip/hip_bf16.h>
#include <cstdio>
#include <cstdint>
namespace pg8 {
#define PG8_LAS __attribute__((address_space(3)))
typedef unsigned short bf16_t;
typedef short bf16x8 __attribute__((ext_vector_type(8)));
typedef float f32x4 __attribute__((ext_vector_type(4)));
typedef unsigned u32x4 __attribute__((ext_vector_type(4)));
constexpr int BM = 256, BK = 64, HALF = 128, HTB = HALF * BK * 2  , STAGE_BYTES = 8 * HTB, NXCD = 8, WGM = 8;

__host__ __device__ __forceinline__ int lds_byte(int r, int c) { const int st = (r >> 4) * 2 + (c >> 5), rr = r & 15, cc = c & 31, ob = rr * 64 + cc * 2; return st * 1024 + (ob ^ (((ob >> 9) & 1) << 5)); }
__host__ __device__ __forceinline__ void stage_rc(int b, int& R, int& C) { const int st = b / 1024, sb = b % 1024, swz = sb ^ (((sb >> 9) & 1) << 5); R = (st >> 1) * 16 + swz / 64; C = (st & 1) * 32 + (swz % 64) / 2; }
__host__ __device__ __forceinline__ int perm32(int rho) { const int n = rho >> 4, i = rho & 15; return 8 * (i >> 2) + 4 * n + (i & 3); }

struct Unit { int pm, pn; };
struct Gemm { const bf16_t* A; const bf16_t* Bt; int M, N, K; };

struct StaticOrder {
    int nM, nN, nwg, G, c;
    __host__ __device__ void init(int M, int N, int G_, int c_) { nM = M / BM; nN = N / BM; nwg = nM * nN; G = G_; c = c_; }
    __host__ __device__ bool next(int i, Unit& u) const {
        const long L = (long)i * G + c; if (L >= nwg) return false;
        int wgid = (int)L; { const int q = nwg / NXCD, r = nwg % NXCD, xcd = wgid % NXCD, off = wgid / NXCD; wgid = (xcd < r ? xcd * (q + 1) : r * (q + 1) + (xcd - r) * q) + off; }
        const int nig = WGM * nN, gid = wgid / nig, fm = gid * WGM, gsz = (nM - fm) < WGM ? (nM - fm) : WGM;
        u.pm = fm + ((wgid % nig) % gsz); u.pn = (wgid % nig) / gsz; return true;
    }
    __device__ __forceinline__ void a_ready(const Unit&) const {}
    __device__ __forceinline__ void done(const Unit&) const {}
};

__device__ __forceinline__ unsigned cvt_pk_bf16(float lo, float hi) { unsigned r; asm volatile("v_cvt_pk_bf16_f32 %0, %1, %2" : "=v"(r) : "v"(lo), "v"(hi)); return r; }
typedef float f32x2 __attribute__((ext_vector_type(2)));
__device__ __forceinline__ float bflo(unsigned w) { return __builtin_bit_cast(float, w << 16); }
__device__ __forceinline__ float bfhi(unsigned w) { return __builtin_bit_cast(float, w & 0xffff0000u); }
__device__ __forceinline__ float sigm(float x) { return 1.f / (1.f + __expf(-x)); }
struct EpiSplit1 {
    static constexpr bool PERM = true, AFTER_DRAIN = false;
    bf16_t* phy; long dq, dk, dv, dg;
    __device__ __forceinline__ void operator()(const f32x4 (&acc)[2][2][4][2], const Unit& u, int wr, int wc, int fr, int fq) const {
        const int pn = u.pn; const bool ctx = (u.pm == 32);
        const int s1 = pn >= 12, s2 = pn >= 16, s3 = pn >= 20, s4 = pn >= 24;
        bf16_t* base = phy + (long)s1 * dq + (long)s2 * (dk - dq) + (long)s3 * (dv - dk) + (long)s4 * (dg - dv);
        const int ldc = 3072 - s1 * 2048 + s4 * 3072;
        const int colt = (pn - 12 * s1 - 4 * s2 - 4 * s3 - 4 * s4) * 256;
        const bool lat_only = !(s2 && !s4);
        const int rowoff = (s3 && !s4) ? (ctx ? -8192 : 256) : 0;
        if (ctx && lat_only) return;
        const int row0 = u.pm * BM + wr * 64 + fr + rowoff, col0 = colt + wc * 32 + 8 * fq;
#pragma unroll
        for (int ai = 0; ai < 2; ++ai)
#pragma unroll
            for (int m = 0; m < 4; ++m) { bf16_t* rowp = base + (size_t)(row0 + ai * HALF + m * 16) * ldc + col0;
#pragma unroll
                for (int bj = 0; bj < 2; ++bj) { const f32x4 v0 = acc[ai][bj][m][0], v1 = acc[ai][bj][m][1];
                    u32x4 w; w.x = cvt_pk_bf16(v0[0], v0[1]); w.y = cvt_pk_bf16(v0[2], v0[3]); w.z = cvt_pk_bf16(v1[0], v1[1]); w.w = cvt_pk_bf16(v1[2], v1[3]);
                    *(u32x4*)(rowp + bj * HALF) = w; } }
    }
};
template <int MODE> struct EpiGate {
    static constexpr bool PERM = true, AFTER_DRAIN = false;
    bf16_t* O; int ldc; const bf16_t* G; int ldg;
    __device__ __forceinline__ void operator()(const f32x4 (&acc)[2][2][4][2], const Unit& u, int wr, int wc, int fr, int fq) const {
        const int row0 = u.pm * BM + wr * 64 + fr, col0 = u.pn * BM + wc * 32 + 8 * fq;
#pragma unroll
        for (int ai = 0; ai < 2; ++ai)
#pragma unroll
            for (int m = 0; m < 4; ++m) { const size_t r = (size_t)(row0 + ai * HALF + m * 16);
#pragma unroll
                for (int bj = 0; bj < 2; ++bj) { const f32x4 v0 = acc[ai][bj][m][0], v1 = acc[ai][bj][m][1];
                    const u32x4 g = *(const u32x4*)(G + r * ldg + col0 + bj * HALF);
                    float o[8] = { sigm(bflo(g.x)) * v0[0], sigm(bfhi(g.x)) * v0[1], sigm(bflo(g.y)) * v0[2], sigm(bfhi(g.y)) * v0[3],
                                   sigm(bflo(g.z)) * v1[0], sigm(bfhi(g.z)) * v1[1], sigm(bflo(g.w)) * v1[2], sigm(bfhi(g.w)) * v1[3] };
                    u32x4* op = (u32x4*)(O + r * ldc + col0 + bj * HALF);
                    if (MODE == 1) { const u32x4 p = *op; o[0] += bflo(p.x); o[1] += bfhi(p.x); o[2] += bflo(p.y); o[3] += bfhi(p.y); o[4] += bflo(p.z); o[5] += bfhi(p.z); o[6] += bflo(p.w); o[7] += bfhi(p.w); }
                    u32x4 w; w.x = cvt_pk_bf16(o[0], o[1]); w.y = cvt_pk_bf16(o[2], o[3]); w.z = cvt_pk_bf16(o[4], o[5]); w.w = cvt_pk_bf16(o[6], o[7]);
                    *op = w; } }
    }
};
struct EpiF32 {
    static constexpr bool PERM = true, AFTER_DRAIN = false;
    float* O; int ldc;
    __device__ __forceinline__ void operator()(const f32x4 (&acc)[2][2][4][2], const Unit& u, int wr, int wc, int fr, int fq) const {
        const int row0 = u.pm * BM + wr * 64 + fr, col0 = u.pn * BM + wc * 32 + 8 * fq;
#pragma unroll
        for (int ai = 0; ai < 2; ++ai)
#pragma unroll
            for (int m = 0; m < 4; ++m) { float* rowp = O + (size_t)(row0 + ai * HALF + m * 16) * ldc + col0;
#pragma unroll
                for (int bj = 0; bj < 2; ++bj) { *(f32x4*)(rowp + bj * HALF) = acc[ai][bj][m][0]; *(f32x4*)(rowp + bj * HALF + 4) = acc[ai][bj][m][1]; } }
    }
};
struct EpiBf16 {
    static constexpr bool PERM = true, AFTER_DRAIN = false;
    bf16_t* O; int ldc;
    __device__ __forceinline__ void operator()(const f32x4 (&acc)[2][2][4][2], const Unit& u, int wr, int wc, int fr, int fq) const {
        const int row0 = u.pm * BM + wr * 64 + fr, col0 = u.pn * BM + wc * 32 + 8 * fq;
#pragma unroll
        for (int ai = 0; ai < 2; ++ai)
#pragma unroll
            for (int m = 0; m < 4; ++m) { bf16_t* rowp = O + (size_t)(row0 + ai * HALF + m * 16) * ldc + col0;
#pragma unroll
                for (int bj = 0; bj < 2; ++bj) { const f32x4 v0 = acc[ai][bj][m][0], v1 = acc[ai][bj][m][1];
                    u32x4 w; w.x = cvt_pk_bf16(v0[0], v0[1]); w.y = cvt_pk_bf16(v0[2], v0[3]); w.z = cvt_pk_bf16(v1[0], v1[1]); w.w = cvt_pk_bf16(v1[2], v1[3]);
                    *(u32x4*)(rowp + bj * HALF) = w; } }
    }
};
struct EpiCtxKV {
    static constexpr bool PERM = true, AFTER_DRAIN = false;
    bf16_t* k2; long dv;
    __device__ __forceinline__ void operator()(const f32x4 (&acc)[2][2][4][2], const Unit& u, int wr, int wc, int fr, int fq) const {
        const int isv = u.pn >= 20; bf16_t* base = k2 + (long)isv * dv;
        const int row0 = wr * 64 + fr, col0 = (u.pn - 16 - 4 * isv) * 256 + wc * 32 + 8 * fq;
#pragma unroll
        for (int ai = 0; ai < 2; ++ai)
#pragma unroll
            for (int m = 0; m < 4; ++m) { bf16_t* rowp = base + (size_t)(row0 + ai * HALF + m * 16) * 1024 + col0;
#pragma unroll
                for (int bj = 0; bj < 2; ++bj) { const f32x4 v0 = acc[ai][bj][m][0], v1 = acc[ai][bj][m][1];
                    u32x4 w; w.x = cvt_pk_bf16(v0[0], v0[1]); w.y = cvt_pk_bf16(v0[2], v0[3]); w.z = cvt_pk_bf16(v1[0], v1[1]); w.w = cvt_pk_bf16(v1[2], v1[3]);
                    *(u32x4*)(rowp + bj * HALF) = w; } }
    }
};
struct OneUnit {
    int pm, pn;
    __device__ __forceinline__ bool next(int i, Unit& u) const { if (i) return false; u.pm = pm; u.pn = pn; return true; }
    __device__ __forceinline__ void a_ready(const Unit&) const {}
    __device__ __forceinline__ void done(const Unit&) const {}
};
template <class Epi, class Sched, bool ALIGN_EPI = false, bool SP2 = false>
__device__ __forceinline__ void gemm_phase(PG8_LAS unsigned char* lds, const Gemm g, const Sched& S, const Epi& E) {
    const int tid = threadIdx.x, wid = __builtin_amdgcn_readfirstlane(tid >> 6), lane = tid & 63, wr = wid >> 2, wc = wid & 3, fr = lane & 15, fq = lane >> 4;
    const int K = g.K, nt = K / BK;
    unsigned voffA[2], voffB[2];
#pragma unroll
    for (int i = 0; i < 2; ++i) { int R, C; stage_rc(tid * 16 + i * 8192, R, C); const int Rb = Epi::PERM ? ((R & ~31) + perm32(R & 31)) : R;
        voffA[i] = (unsigned)(R * K + C) * 2u; voffB[i] = (unsigned)(Rb * K + C) * 2u; }
    const size_t kstep = (size_t)(BK * 2);
    const size_t hstep = (size_t)HALF * K * 2;
    const size_t tstep = 2 * hstep;
    const unsigned ldsw = (unsigned)wid * 1024u;
    const int aoff = lds_byte(wr * 64 + fr, fq * 8), boff = lds_byte(wc * 32 + fr, fq * 8);
#define PG8_SA(b, h) (((b) * 2 + (h)) * HTB)
#define PG8_SB(b, h) ((4 + (b) * 2 + (h)) * HTB)
#define PG8_STAGE(bufoff, gbase, voff) do { _Pragma("unroll") for (int _i = 0; _i < 2; ++_i) \
        __builtin_amdgcn_global_load_lds((const unsigned*)((const char*)(gbase) + (voff)[_i]), (PG8_LAS unsigned*)(lds + (bufoff) + ldsw + _i * 8192), 16, 0, 0); } while (0)
#define PG8_LDA(dst, b, h) do { _Pragma("unroll") for (int m = 0; m < 4; ++m) _Pragma("unroll") for (int k = 0; k < 2; ++k) dst[m][k] = *(const PG8_LAS bf16x8*)(lds + PG8_SA(b, h) + aoff + m * 2048 + k * 1024); } while (0)
#define PG8_LDB(dst, b, h) do { _Pragma("unroll") for (int n = 0; n < 2; ++n) _Pragma("unroll") for (int k = 0; k < 2; ++k) dst[n][k] = *(const PG8_LAS bf16x8*)(lds + PG8_SB(b, h) + boff + n * 2048 + k * 1024); } while (0)
#define PG8_MMA(ai, bj, At, Bt) do { __builtin_amdgcn_s_setprio(1); _Pragma("unroll") for (int m = 0; m < 4; ++m) _Pragma("unroll") for (int n = 0; n < 2; ++n) _Pragma("unroll") for (int k = 0; k < 2; ++k) \
        acc[ai][bj][m][n] = __builtin_amdgcn_mfma_f32_16x16x32_bf16(Bt[n][k], At[m][k], acc[ai][bj][m][n], 0, 0, 0); __builtin_amdgcn_s_setprio(0); } while (0)
#define PG8_WAIT_V(n) asm volatile("s_waitcnt vmcnt(" #n ")" ::: "memory")
#define PG8_WAIT_L(n) asm volatile("s_waitcnt lgkmcnt(" #n ")" ::: "memory")
#define PG8_BAR __builtin_amdgcn_s_barrier()
#define PG8_SCHED __builtin_amdgcn_sched_barrier(0)
    Unit cur, nxt; int ui = 0;
    if (!S.next(0, cur)) return;
    f32x4 acc[2][2][4][2];
#pragma unroll
    for (int a = 0; a < 2; ++a)
#pragma unroll
        for (int b = 0; b < 2; ++b)
#pragma unroll
            for (int m = 0; m < 4; ++m)
#pragma unroll
                for (int n = 0; n < 2; ++n) acc[a][b][m][n] = (f32x4){0.f, 0.f, 0.f, 0.f};
    bf16x8 At[4][2], B0[2][2], B1[2][2];
    const char* cA = (const char*)g.A + (size_t)cur.pm * tstep; const char* cB = (const char*)g.Bt + (size_t)cur.pn * tstep;
    S.a_ready(cur);
    if constexpr (SP2) {
        PG8_STAGE(PG8_SB(0, 0), cB, voffB); PG8_STAGE(PG8_SB(0, 1), cB + hstep, voffB); PG8_STAGE(PG8_SA(0, 0), cA, voffA); PG8_STAGE(PG8_SA(0, 1), cA + hstep, voffA);
        if (wr == 1) PG8_BAR;
        PG8_WAIT_V(2); PG8_BAR;
        PG8_STAGE(PG8_SB(1, 0), cB + kstep, voffB); PG8_STAGE(PG8_SA(1, 0), cA + kstep, voffA); PG8_STAGE(PG8_SB(1, 1), cB + hstep + kstep, voffB);
        PG8_WAIT_V(6); PG8_BAR;
    } else {
        PG8_STAGE(PG8_SB(0, 0), cB, voffB); PG8_STAGE(PG8_SA(0, 0), cA, voffA); PG8_STAGE(PG8_SB(0, 1), cB + hstep, voffB); PG8_STAGE(PG8_SA(0, 1), cA + hstep, voffA);
        if (wr == 1) PG8_BAR;
        PG8_WAIT_V(4); PG8_BAR;
        PG8_STAGE(PG8_SB(1, 0), cB + kstep, voffB); PG8_STAGE(PG8_SA(1, 0), cA + kstep, voffA); PG8_STAGE(PG8_SB(1, 1), cB + hstep + kstep, voffB);
        PG8_WAIT_V(6); PG8_BAR;
    }
    for (;;) {
        const bool has_next = S.next(ui + 1, nxt);
        const char* nA = has_next ? (const char*)g.A + (size_t)nxt.pm * tstep : cA; const char* nB = has_next ? (const char*)g.Bt + (size_t)nxt.pn * tstep : cB;
        for (int t = 0; t < nt; t += 2) {
            const bool last = (t == nt - 2);
            const char* a1 = cA + (size_t)(t + 1) * kstep;
            const char* a2 = last ? nA : cA + (size_t)(t + 2) * kstep; const char* b2 = last ? nB : cB + (size_t)(t + 2) * kstep;
            const char* a3 = a2 + kstep; const char* b3 = b2 + kstep;
            if (last && has_next) S.a_ready(nxt);
            if constexpr (SP2) {
            PG8_LDB(B0, 0, 0); PG8_LDB(B1, 0, 1); PG8_SCHED; PG8_LDA(At, 0, 0); PG8_STAGE(PG8_SA(1, 1), a1 + hstep, voffA);
            PG8_WAIT_V(8); PG8_WAIT_L(0); PG8_BAR; PG8_MMA(0, 0, At, B0); PG8_MMA(0, 1, At, B1); PG8_BAR; PG8_SCHED;
            PG8_LDA(At, 0, 1); PG8_STAGE(PG8_SB(0, 0), b2, voffB); PG8_STAGE(PG8_SB(0, 1), b2 + hstep, voffB); PG8_STAGE(PG8_SA(0, 0), a2, voffA);
            PG8_WAIT_V(8); PG8_WAIT_L(0); PG8_BAR; PG8_MMA(1, 0, At, B0); PG8_MMA(1, 1, At, B1); PG8_BAR; PG8_SCHED;
            PG8_LDB(B0, 1, 0); PG8_LDB(B1, 1, 1); PG8_SCHED; PG8_LDA(At, 1, 0); PG8_STAGE(PG8_SA(0, 1), a2 + hstep, voffA);
            PG8_WAIT_V(8); PG8_WAIT_L(0); PG8_BAR; PG8_MMA(0, 0, At, B0); PG8_MMA(0, 1, At, B1); PG8_BAR; PG8_SCHED;
            PG8_LDA(At, 1, 1); PG8_STAGE(PG8_SB(1, 0), b3, voffB); PG8_STAGE(PG8_SB(1, 1), b3 + hstep, voffB); PG8_STAGE(PG8_SA(1, 0), a3, voffA);
            PG8_WAIT_V(8); PG8_WAIT_L(0); PG8_BAR; PG8_MMA(1, 0, At, B0); PG8_MMA(1, 1, At, B1); PG8_BAR; PG8_SCHED;
            } else {
            PG8_LDB(B0, 0, 0); PG8_SCHED; PG8_LDA(At, 0, 0); PG8_STAGE(PG8_SA(1, 1), a1 + hstep, voffA);
            PG8_WAIT_L(8); PG8_BAR; PG8_WAIT_L(0); PG8_MMA(0, 0, At, B0); PG8_BAR; PG8_SCHED;
            PG8_LDB(B1, 0, 1); PG8_STAGE(PG8_SB(0, 0), b2, voffB);
            PG8_BAR; PG8_WAIT_L(0); PG8_MMA(0, 1, At, B1); PG8_BAR;
            PG8_LDA(At, 0, 1); PG8_STAGE(PG8_SA(0, 0), a2, voffA);
            PG8_BAR; PG8_WAIT_L(0); PG8_MMA(1, 0, At, B0); PG8_BAR; PG8_SCHED;
            PG8_STAGE(PG8_SB(0, 1), b2 + hstep, voffB);
            PG8_WAIT_V(6); PG8_BAR; PG8_MMA(1, 1, At, B1); PG8_BAR;
            PG8_LDB(B0, 1, 0); PG8_SCHED; PG8_LDA(At, 1, 0); PG8_STAGE(PG8_SA(0, 1), a2 + hstep, voffA);
            PG8_WAIT_L(8); PG8_BAR; PG8_WAIT_L(0); PG8_MMA(0, 0, At, B0); PG8_BAR; PG8_SCHED;
            PG8_LDB(B1, 1, 1); PG8_STAGE(PG8_SB(1, 0), b3, voffB);
            PG8_BAR; PG8_WAIT_L(0); PG8_MMA(0, 1, At, B1); PG8_BAR;
            PG8_LDA(At, 1, 1); PG8_STAGE(PG8_SA(1, 0), a3, voffA);
            PG8_BAR; PG8_WAIT_L(0); PG8_MMA(1, 0, At, B0); PG8_BAR; PG8_SCHED;
            PG8_STAGE(PG8_SB(1, 1), b3 + hstep, voffB);
            PG8_WAIT_V(6); PG8_BAR; PG8_MMA(1, 1, At, B1); PG8_BAR;
            }
        }
        if constexpr (ALIGN_EPI) { if (wr == 0) PG8_BAR; }
        if constexpr (!Epi::AFTER_DRAIN) { E(acc, cur, wr, wc, fr, fq); S.done(cur); }
        if (!has_next) break;
#pragma unroll
        for (int a = 0; a < 2; ++a)
#pragma unroll
            for (int b = 0; b < 2; ++b)
#pragma unroll
                for (int m = 0; m < 4; ++m)
#pragma unroll
                    for (int n = 0; n < 2; ++n) acc[a][b][m][n] = (f32x4){0.f, 0.f, 0.f, 0.f};
        cur = nxt; cA = nA; cB = nB; ++ui;
        if constexpr (ALIGN_EPI) { if (wr == 1) PG8_BAR; }
    }
    PG8_WAIT_V(0);
    if constexpr (!ALIGN_EPI) { if (wr == 0) PG8_BAR; }
    PG8_BAR;
    if constexpr (Epi::AFTER_DRAIN) { E.fused(acc, cur, wr, wc, fr, fq, lds, wid, lane); S.done(cur); }
#undef PG8_SA
#undef PG8_SB
#undef PG8_STAGE
#undef PG8_LDA
#undef PG8_LDB
#undef PG8_MMA
#undef PG8_WAIT_V
#undef PG8_WAIT_L
#undef PG8_BAR
#undef PG8_SCHED
}
}
namespace att {
using bf16x8 = __attribute__((ext_vector_type(8))) short;
using s16x4  = __attribute__((ext_vector_type(4))) short;
using f32x16 = __attribute__((ext_vector_type(16))) float;
using u32x4  = __attribute__((ext_vector_type(4))) unsigned;
constexpr int DQK = 64, DV = 128, NW = 8, QBLK = 32, KVBLK = 64;
constexpr float SCALE = 0.125f;
constexpr float C2 = 0.125f * 1.4426950408889634f;
constexpr float THR2 = 11.5f;
constexpr int LDQ = 1024, LDK = 1024, LDO = 2048;
constexpr size_t SHM_V = KVBLK * DV * 2, SHM_K = KVBLK * DQK * 2, SHM_ATTN = 3 * SHM_V + 3 * SHM_K + NW * 64 * 4;
#define KSWZ64(row, ch) ((row) * 128 + ((((ch) ^ ((row) >> 1)) & 7) << 4))
#define SBAR() __builtin_amdgcn_sched_barrier(0)
__device__ __forceinline__ int crow(int r, int hi) { return (r & 3) + 8 * (r >> 2) + 4 * hi; }
__device__ __forceinline__ unsigned cvtpk(float lo, float hi) { unsigned r; asm volatile("v_cvt_pk_bf16_f32 %0, %1, %2" : "=v"(r) : "v"(lo), "v"(hi)); return r; }

#define MX3(a, b, c) __builtin_fmaxf(__builtin_fmaxf((a), (b)), (c))
__device__ __forceinline__ float rowmax32(const f32x16& p0, const f32x16& p1) {
  float a = MX3(p0[0], p0[1], p1[0]), b = MX3(p0[2], p0[3], p1[1]); a = MX3(a, p1[2], p1[3]);
#pragma unroll
  for (int r = 4; r < 16; r += 4) { a = MX3(a, p0[r], p0[r + 1]); b = MX3(b, p0[r + 2], p0[r + 3]); a = MX3(a, p1[r], p1[r + 1]); b = MX3(b, p1[r + 2], p1[r + 3]); }
  float m = __builtin_fmaxf(a, b);
  { auto rr = __builtin_amdgcn_permlane32_swap(__float_as_uint(m), __float_as_uint(m), false, false);
    m = __builtin_fmaxf(__uint_as_float(rr[0]), __uint_as_float(rr[1])); }
  return m;
}
template <bool FIRST, int VAR = 0> __device__ __forceinline__ void partialSM(f32x16& p0, f32x16& p1, float& m_ref, f32x16& negm, float& alpha) {
  const float pmax = rowmax32(p0, p1);
  alpha = 1.f;
  if (FIRST || __builtin_expect(__any(pmax > THR2), 0)) {
    const float d = FIRST ? pmax : __builtin_fmaxf(pmax, 0.f);
    m_ref += d;
#pragma unroll
    for (int r = 0; r < 16; ++r) { p0[r] -= d; p1[r] -= d; }
#pragma unroll
    for (int r = 0; r < 16; ++r) negm[r] = -m_ref;
    if (!FIRST) alpha = __builtin_amdgcn_exp2f(-d);
  }
#pragma unroll
  for (int r = 0; r < 16; ++r) p0[r] = (VAR == 1) ? p0[r] * 0.001f : __builtin_amdgcn_exp2f(p0[r]);
}
template <int VAR = 0> __device__ __forceinline__ void finishSM(f32x16& p0, f32x16& p1, bf16x8& pa0, bf16x8& pa1, bf16x8& pa2, bf16x8& pa3) {
#pragma unroll
  for (int r = 0; r < 16; ++r) p1[r] = (VAR == 1) ? p1[r] * 0.001f : __builtin_amdgcn_exp2f(p1[r]);
#define PK4(P, BASE, OUT) do { unsigned a0 = cvtpk(P[BASE + 0], P[BASE + 1]), a1 = cvtpk(P[BASE + 2], P[BASE + 3]);   \
    unsigned b0 = cvtpk(P[BASE + 4], P[BASE + 5]), b1 = cvtpk(P[BASE + 6], P[BASE + 7]);                              \
    auto r0 = __builtin_amdgcn_permlane32_swap(a0, b0, false, false); auto r1 = __builtin_amdgcn_permlane32_swap(a1, b1, false, false); \
    u32x4 w = {r0[0], r1[0], r0[1], r1[1]}; OUT = *reinterpret_cast<bf16x8*>(&w); } while (0)
  PK4(p0, 0, pa0); PK4(p0, 8, pa1); PK4(p1, 0, pa2); PK4(p1, 8, pa3);
#undef PK4
}
__device__ __forceinline__ void qkt(f32x16& p0, f32x16& p1, const char* Ks, const bf16x8* qr, const f32x16& negm, int r32, int hi) {
#pragma unroll
  for (int d0 = 0; d0 < 4; ++d0) { const int ch = d0 * 2 + hi;
    bf16x8 b0 = *reinterpret_cast<const bf16x8*>(Ks + KSWZ64(r32, ch));
    bf16x8 b1 = *reinterpret_cast<const bf16x8*>(Ks + KSWZ64(32 + r32, ch));
    if (d0 == 0) { p0 = __builtin_amdgcn_mfma_f32_32x32x16_bf16(b0, qr[0], negm, 0, 0, 0); p1 = __builtin_amdgcn_mfma_f32_32x32x16_bf16(b1, qr[0], negm, 0, 0, 0); }
    else { p0 = __builtin_amdgcn_mfma_f32_32x32x16_bf16(b0, qr[d0], p0, 0, 0, 0); p1 = __builtin_amdgcn_mfma_f32_32x32x16_bf16(b1, qr[d0], p1, 0, 0, 0); } }
}
__device__ __forceinline__ int v_st(int k, int c) { const int kk = (k & ~0xC) | ((k & 4) << 1) | ((k & 8) >> 1); return ((kk >> 3) * 4 + (c >> 5)) * 512 + ((kk & 7) * 32 + (c & 31)) * 2; }
__device__ __forceinline__ int v_rd_base(int lane) { return ((lane & 3) << 3) | (((lane >> 2) & 3) << 6) | (((lane >> 4) & 1) << 5) | (((lane >> 5) & 1) << 8); }
constexpr int v_rd_off(int d0, int ks, int half) { return d0 * 512 + ks * 4096 + half * 2048; }
template <int OFF> __device__ __forceinline__ s16x4 tr_read(int vb) {
  s16x4 r; asm volatile("ds_read_b64_tr_b16 %0, %1 offset:%2" : "=&v"(r) : "v"(vb), "i"(OFF) : "memory"); return r;
}
template <int D0> __device__ __forceinline__ void pv_one(f32x16& od, int vb, bf16x8 pa0, bf16x8 pa1, bf16x8 pa2, bf16x8 pa3) {
  const s16x4 l0 = tr_read<v_rd_off(D0, 0, 0)>(vb), h0 = tr_read<v_rd_off(D0, 0, 1)>(vb), l1 = tr_read<v_rd_off(D0, 1, 0)>(vb), h1 = tr_read<v_rd_off(D0, 1, 1)>(vb);
  const s16x4 l2 = tr_read<v_rd_off(D0, 2, 0)>(vb), h2 = tr_read<v_rd_off(D0, 2, 1)>(vb), l3 = tr_read<v_rd_off(D0, 3, 0)>(vb), h3 = tr_read<v_rd_off(D0, 3, 1)>(vb);
  asm volatile("s_waitcnt lgkmcnt(0)" ::: "memory"); SBAR();
#define PK(L, H) (bf16x8){L[0], L[1], L[2], L[3], H[0], H[1], H[2], H[3]}
  od = __builtin_amdgcn_mfma_f32_32x32x16_bf16(pa0, PK(l0, h0), od, 0, 0, 0);
  od = __builtin_amdgcn_mfma_f32_32x32x16_bf16(pa1, PK(l1, h1), od, 0, 0, 0);
  od = __builtin_amdgcn_mfma_f32_32x32x16_bf16(pa2, PK(l2, h2), od, 0, 0, 0);
  od = __builtin_amdgcn_mfma_f32_32x32x16_bf16(pa3, PK(l3, h3), od, 0, 0, 0);
#undef PK
}
__device__ __forceinline__ void pv_d0(f32x16* o, f32x16& lsum, int vb, bf16x8 pa0, bf16x8 pa1, bf16x8 pa2, bf16x8 pa3) {
  const bf16x8 ones = {0x3F80, 0x3F80, 0x3F80, 0x3F80, 0x3F80, 0x3F80, 0x3F80, 0x3F80};
  pv_one<0>(o[0], vb, pa0, pa1, pa2, pa3); pv_one<1>(o[1], vb, pa0, pa1, pa2, pa3);
  lsum = __builtin_amdgcn_mfma_f32_32x32x16_bf16(pa0, ones, lsum, 0, 0, 0); lsum = __builtin_amdgcn_mfma_f32_32x32x16_bf16(pa1, ones, lsum, 0, 0, 0);
  pv_one<2>(o[2], vb, pa0, pa1, pa2, pa3); pv_one<3>(o[3], vb, pa0, pa1, pa2, pa3);
  lsum = __builtin_amdgcn_mfma_f32_32x32x16_bf16(pa2, ones, lsum, 0, 0, 0); lsum = __builtin_amdgcn_mfma_f32_32x32x16_bf16(pa3, ones, lsum, 0, 0, 0);
}
template <int VAR = 0> __device__ __forceinline__ void attn_unit(const unsigned short* __restrict__ Qb, const unsigned short* __restrict__ Kh, const unsigned short* __restrict__ Vh,
                                          float* __restrict__ Ob, int seq, char* lds) {
  int tid_ = threadIdx.x; asm volatile("" : "+v"(tid_));
  const int tid = tid_, wid = tid >> 6, lane = tid & 63, r32 = lane & 31, hi = lane >> 5;
  char* V_lds = lds; char* K_lds = lds + 3 * SHM_V;
  float* ws = (float*)(lds + 3 * SHM_V + 3 * SHM_K) + wid * 64; float* al_l = ws + 32;
  float m_ref = 0.f; f32x16 o[4] = {}; f32x16 lsum = {}; f32x16 negm = {}; bf16x8 qr[4];
  const unsigned short* Qw = Qb + (long)(wid * QBLK + r32) * LDQ + hi * 8;
#pragma unroll
  for (int d0 = 0; d0 < 4; ++d0) qr[d0] = *reinterpret_cast<const bf16x8*>(Qw + d0 * 16);
  const int vb0 = (int)(uintptr_t)V_lds + v_rd_base(lane);
  int koff, voff0, voff1;
  { const int row = 8 * wid + (lane >> 3), ch = (lane & 7) ^ ((row >> 1) & 7); koff = row * LDK + ch * 8; }
  { const int blk = 4 * wid + (lane >> 5), kk = (blk >> 2) * 8 + ((lane >> 2) & 7), k = (kk & ~0xC) | ((kk & 4) << 1) | ((kk & 8) >> 1); voff0 = k * LDK + (blk & 3) * 32 + (lane & 3) * 8; }
  { const int blk = 4 * wid + 2 + (lane >> 5), kk = (blk >> 2) * 8 + ((lane >> 2) & 7), k = (kk & ~0xC) | ((kk & 4) << 1) | ((kk & 8) >> 1); voff1 = k * LDK + (blk & 3) * 32 + (lane & 3) * 8; }
  typedef __attribute__((address_space(3))) unsigned ldsu32;
  const unsigned widu = (unsigned)__builtin_amdgcn_readfirstlane(wid);
  const unsigned ldsK = (unsigned)(uintptr_t)K_lds + widu * 1024u, ldsV = (unsigned)(uintptr_t)V_lds + widu * 2048u;
#define SDMA(b, k0) do { if (VAR != 4) { \
    __builtin_amdgcn_global_load_lds((const unsigned*)(Kh + (long)(k0) * LDK + koff), (ldsu32*)(uintptr_t)(ldsK + (b) * (unsigned)SHM_K), 16, 0, 0); \
    __builtin_amdgcn_global_load_lds((const unsigned*)(Vh + (long)(k0) * LDK + voff0), (ldsu32*)(uintptr_t)(ldsV + (b) * (unsigned)SHM_V), 16, 0, 0); \
    __builtin_amdgcn_global_load_lds((const unsigned*)(Vh + (long)(k0) * LDK + voff1), (ldsu32*)(uintptr_t)(ldsV + (b) * (unsigned)SHM_V + 1024u), 16, 0, 0); } } while (0)
#define SWAIT() asm volatile("s_waitcnt vmcnt(0)" ::: "memory")
#define RESC(a) do { if (__any((a) < 1.f)) { if (hi == 0) al_l[r32] = (a); asm volatile("s_waitcnt lgkmcnt(0)" ::: "memory"); \
    _Pragma("unroll") for (int r = 0; r < 16; ++r) { const float f_ = al_l[crow(r, hi)]; o[0][r] *= f_; o[1][r] *= f_; o[2][r] *= f_; o[3][r] *= f_; lsum[r] *= f_; } } } while (0)
  f32x16 pA0, pA1, pB0, pB1; float alA, alB; bf16x8 pa0, pa1, pa2, pa3; const int NT = seq / KVBLK;
  SDMA(0, 0); SWAIT(); __syncthreads();
  if (VAR != 3) qkt(pA0, pA1, K_lds, qr, negm, r32, hi); partialSM<true, VAR>(pA0, pA1, m_ref, negm, alA);
  SDMA(1, KVBLK);
  SWAIT(); __syncthreads();
  int bp = 0, bc = 1, bn = 2;
#define ROT3() do { const int t_ = bp; bp = bc; bc = bn; bn = t_; } while (0)
  for (int j = 1; j + 1 < NT; j += 2) {
    SDMA(bn, (j + 1) * KVBLK);
    SBAR(); if (VAR != 3) qkt(pB0, pB1, K_lds + bc * SHM_K, qr, negm, r32, hi);
    finishSM<VAR>(pA0, pA1, pa0, pa1, pa2, pa3); SBAR();
    if (VAR != 2) pv_d0(o, lsum, vb0 + bp * (int)SHM_V, pa0, pa1, pa2, pa3); partialSM<false, VAR>(pB0, pB1, m_ref, negm, alB);
    RESC(alB); SWAIT(); __syncthreads(); ROT3();
    SDMA(bn, (j + 2) * KVBLK);
    SBAR(); if (VAR != 3) qkt(pA0, pA1, K_lds + bc * SHM_K, qr, negm, r32, hi);
    finishSM<VAR>(pB0, pB1, pa0, pa1, pa2, pa3); SBAR();
    if (VAR != 2) pv_d0(o, lsum, vb0 + bp * (int)SHM_V, pa0, pa1, pa2, pa3); partialSM<false, VAR>(pA0, pA1, m_ref, negm, alA);
    RESC(alA); SWAIT(); __syncthreads(); ROT3();
  }
  SBAR(); if (VAR != 3) qkt(pB0, pB1, K_lds + bc * SHM_K, qr, negm, r32, hi);
  finishSM<VAR>(pA0, pA1, pa0, pa1, pa2, pa3); SBAR();
  if (VAR != 2) pv_d0(o, lsum, vb0 + bp * (int)SHM_V, pa0, pa1, pa2, pa3); partialSM<false, VAR>(pB0, pB1, m_ref, negm, alB);
  RESC(alB);
  finishSM<VAR>(pB0, pB1, pa0, pa1, pa2, pa3); SBAR();
  if (VAR != 2) pv_d0(o, lsum, vb0 + bc * (int)SHM_V, pa0, pa1, pa2, pa3);
#undef ROT3
  float rli[16];
#pragma unroll
  for (int r = 0; r < 16; ++r) rli[r] = __builtin_amdgcn_rcpf(lsum[r]);
  float* Ow = Ob + (long)(wid * QBLK) * LDO;
#pragma unroll
  for (int r = 0; r < 16; ++r) { const int orow = crow(r, hi);
#pragma unroll
    for (int d0 = 0; d0 < 4; ++d0) Ow[(long)orow * LDO + d0 * 32 + r32] = o[d0][r] * rli[r]; }
  __syncthreads();
#undef SDMA
#undef SWAIT
#undef RESC
}
#undef SBAR
#undef MX3
}
constexpr int NWAVES = 8, NTHR = 512;
constexpr int DM = 2048, SEQ = 8192, CTXL = 256, MROWS = SEQ + CTXL  , NKEYS = SEQ + CTXL;
constexpr int HYW = 1024, INCOLS = 10240, NMOD = 6 * DM;
constexpr float EPS = 1e-6f;
constexpr int NEXP = 16384;
constexpr size_t MiB = 1u << 20;
constexpr size_t WS_CTL = 0, CTL_ZERO_BYTES = 64 * 1024;
constexpr size_t WS_MODP = 1 * MiB;
constexpr size_t WS_WIN = 2 * MiB;
constexpr size_t WS_WHY = 42 * MiB, WS_WDA = 46 * MiB;
constexpr size_t WS_WO = 50 * MiB, WS_WQ = 58 * MiB;
constexpr size_t WS_UB = 66 * MiB, WS_VB = 130 * MiB;
constexpr size_t WS_USC = 98 * MiB, WS_VSC = 162 * MiB;
constexpr size_t WS_TAPF = 194 * MiB, WS_TAPB = 226 * MiB;
constexpr size_t WS_MB = 194 * MiB;
constexpr size_t WS_HB = 226 * MiB;
constexpr size_t WS_U = 258 * MiB;
constexpr size_t WS_Q2 = 258 * MiB, WS_K2 = 274 * MiB;
constexpr size_t WS_YHY = 258 * MiB, WS_YDA = 274 * MiB;
constexpr size_t WS_PHY = 291 * MiB;
constexpr size_t WS_QRAW = 339 * MiB;
constexpr size_t WS_KRAW = 355 * MiB + 512 * 1024;
constexpr size_t WS_O = 291 * MiB;
constexpr size_t WS_MIX = 291 * MiB;
constexpr size_t WS_YCT = 355 * MiB + 512 * 1024;
constexpr size_t WS_V2 = 372 * MiB;
constexpr size_t WS_GATES = 388 * MiB + 512 * 1024;
constexpr size_t WS_X0 = 452 * MiB + 512 * 1024;
constexpr size_t WS_UHT = 468 * MiB + 512 * 1024;
constexpr size_t WS_QP = 356 * MiB;
constexpr size_t WS_IDX = 420 * MiB, WS_GW = 424 * MiB;
constexpr size_t WS_PD = 258 * MiB;
constexpr size_t WS_OPRE = 290 * MiB;
constexpr size_t WS_WGT = 432 * MiB;
constexpr size_t WS_SSP = 354 * MiB;
constexpr size_t WS_KSPEC = 485 * MiB;
constexpr size_t WS_UCTX = 520 * MiB;
constexpr size_t WS_END = 522 * MiB;
static_assert(WS_UHT + (size_t)1024 * 8192 * 2 <= WS_KSPEC && WS_KSPEC + (size_t)256 * 8320 * 16 <= WS_END && WS_GW + (size_t)8192 * 128 * 4 <= WS_GATES + 64 * MiB, "ws map");

constexpr int LDS_BYTES = 147456;
constexpr int MISC_OFF = 147456 - 256;

#define GAS __attribute__((address_space(1)))
#define LAS __attribute__((address_space(3)))
typedef unsigned short bf16;
typedef unsigned v4u __attribute__((ext_vector_type(4)));
typedef unsigned v2u __attribute__((ext_vector_type(2)));
typedef float f32x4 __attribute__((ext_vector_type(4)));
typedef GAS unsigned gu32;
#define RLX_AGENT __ATOMIC_RELAXED, __HIP_MEMORY_SCOPE_AGENT
#define LDS_WAIT() asm volatile("s_waitcnt lgkmcnt(0)" ::: "memory")
#define VM_WAIT() asm volatile("s_waitcnt vmcnt(0)" ::: "memory")
__device__ __forceinline__ unsigned f2bf(float f) { unsigned u = __builtin_bit_cast(unsigned, f); return (u + 0x7fffu + ((u >> 16) & 1u)) >> 16; }
__device__ __forceinline__ unsigned pk2(float lo, float hi) { return f2bf(lo) | (f2bf(hi) << 16); }
__device__ __forceinline__ float bf2f(unsigned short b) { return __builtin_bit_cast(float, (unsigned)b << 16); }
__device__ __forceinline__ float blo(unsigned w) { return __builtin_bit_cast(float, w << 16); }
__device__ __forceinline__ float bhi(unsigned w) { return __builtin_bit_cast(float, w & 0xffff0000u); }
__device__ __forceinline__ float fsin(float x) { return __builtin_amdgcn_sinf(x * 0.15915494309189535f); }
__device__ __forceinline__ float fcos(float x) { return __builtin_amdgcn_cosf(x * 0.15915494309189535f); }
__device__ __forceinline__ float wave_sum(float v) {
#pragma unroll
    for (int o = 1; o < 64; o <<= 1) v += __shfl_xor(v, o);
    return v;
}
__device__ __forceinline__ float wave_max(float v) {
#pragma unroll
    for (int o = 1; o < 64; o <<= 1) v = fmaxf(v, __shfl_xor(v, o));
    return v;
}
#define XB_TMO      128
#define XB_XCNT(j)  (256  + 64 * (j))
#define XB_XSUB(j)  (1280 + 64 * (j))
#define XB_XGEN(j)  (2304 + 64 * (j))
#define XB_TOP      3328
#define XB_TOPGEN   3392
#define XCD_BAR_WORDS 3456
#define XB_SPIN_CAP (1u << 24)

__device__ __forceinline__ unsigned xb_ld(unsigned* p)              { return __hip_atomic_load(p, __ATOMIC_RELAXED, __HIP_MEMORY_SCOPE_AGENT); }
__device__ __forceinline__ unsigned xb_add(unsigned* p, unsigned v) { return __hip_atomic_fetch_add(p, v, __ATOMIC_RELAXED, __HIP_MEMORY_SCOPE_AGENT); }
__device__ __forceinline__ unsigned xb_xcc_id() { return (unsigned)__builtin_amdgcn_s_getreg((3 << 11) | 20) & 0xFu; }
#define XB_SPIN(cond, bar) do { unsigned _sp = 0; while (cond) { __builtin_amdgcn_s_sleep(1); \
    if ((++_sp & 255u) == 0u) { if (xb_ld(&(bar)[XB_TMO])) break; if (_sp > XB_SPIN_CAP) { atomicAdd(&(bar)[XB_TMO], 1u); break; } } } } while (0)

struct XcdBarrier {
    unsigned* bar; unsigned x;
    volatile LAS unsigned* st;
};

__device__ __forceinline__ XcdBarrier xcd_barrier_post(unsigned* bar, volatile LAS unsigned* st) {
    XcdBarrier b; b.bar = bar; b.x = xb_xcc_id(); b.st = st;
    if (threadIdx.x == 0) (void)xb_add(&bar[XB_XCNT(b.x)], 1u);
    return b;
}
__device__ __forceinline__ void xcd_barrier_complete(unsigned* bar, unsigned x, unsigned& nloc, unsigned& nx) {
    const unsigned G = gridDim.x * gridDim.y * gridDim.z;
    unsigned sum, cnt, mine, sp = 0u;
    for (;;) {
        sum = 0u; cnt = 0u; mine = 0u;
#pragma unroll
        for (unsigned j = 0; j < 16; ++j) { const unsigned c = xb_ld(&bar[XB_XCNT(j)]); sum += c; cnt += (c > 0u) ? 1u : 0u; mine = (j == x) ? c : mine; }
        if (sum == G) break;
        __builtin_amdgcn_s_sleep(1);
        if ((++sp & 255u) == 0u) { if (xb_ld(&bar[XB_TMO])) break; if (sp > XB_SPIN_CAP) { atomicAdd(&bar[XB_TMO], 1u); break; } }
    }
    nloc = mine > 0u ? mine : 1u; nx = cnt > 0u ? cnt : 1u;
}

__device__ __forceinline__ void xcd_barrier(const XcdBarrier& b) {
    asm volatile("s_waitcnt vmcnt(0)" ::: "memory");
    __syncthreads();
    if (threadIdx.x == 0) {
        unsigned* bar = b.bar;
        __builtin_amdgcn_s_waitcnt(0);
        unsigned nloc = b.st[0], nx = b.st[1];
        if (nloc == 0u) { xcd_barrier_complete(bar, b.x, nloc, nx); b.st[0] = nloc; b.st[1] = nx; }
        const unsigned old = xb_add(&bar[XB_XSUB(b.x)], 1u);
        const unsigned gen = old / nloc;
        if (old + 1u == (gen + 1u) * nloc) {
            __builtin_amdgcn_fence(__ATOMIC_RELEASE, "agent");
            asm volatile("s_waitcnt vmcnt(0)" ::: "memory");
            const unsigned og = xb_add(&bar[XB_TOP], 1u);
            const unsigned tg = og / nx;
            if (og + 1u == (tg + 1u) * nx) xb_add(&bar[XB_TOPGEN], 1u);
            else XB_SPIN(xb_ld(&bar[XB_TOPGEN]) == tg, bar);
            __builtin_amdgcn_fence(__ATOMIC_ACQUIRE, "agent");
            xb_add(&bar[XB_XGEN(b.x)], 1u);
            asm volatile("s_waitcnt vmcnt(0)" ::: "memory");
        } else {
            XB_SPIN(xb_ld(&bar[XB_XGEN(b.x)]) == gen, bar);
            __builtin_amdgcn_fence(__ATOMIC_ACQUIRE, "agent");
            asm volatile("s_waitcnt vmcnt(0)" ::: "memory");
        }
    }
    __syncthreads();
}
struct Args { const float* in[31]; float* out; unsigned char* ws; int ph_lo, ph_hi, li, pad; };
struct Frame {
    LAS unsigned char* lds; char* ldsg;
    int tid, lane, wave, vcu, G, gw, NGW;
    float* out; unsigned char* ws;
};
__device__ __forceinline__ const float* modp(const Frame& F) { return (const float*)(F.ws + WS_MODP); }
__device__ __forceinline__ f32x4 mod4(const Args& A, const Frame& F, int which, int i) {
    const float* p = modp(F) + which * NMOD + i; f32x4 v = *(const f32x4*)(A.in[5] + i);
#pragma unroll
    for (int kc = 0; kc < 4; ++kc) v += *(const f32x4*)(p + kc * 2 * NMOD);
    return v;
}
__device__ __forceinline__ float silu(float x) { return x / (1.f + __expf(-x)); }

__device__ __forceinline__ void p0_transpose_pair(const float* Wa, bf16* WTa, int ita, const float* Wb, bf16* WTb, int itb, int K, int N, bool two, LAS float* scr, int lane) {
    const int kka = lane >> 3, nl = (lane & 7) * 4, nb = N / 32;
    const int k0a = 64 * (ita / nb), n0a = 32 * (ita % nb), k0b = 64 * (itb / nb), n0b = 32 * (itb % nb);
    f32x4 va[8], vb_[8];
#pragma unroll
    for (int i = 0; i < 8; ++i) va[i] = *(const f32x4*)(Wa + (size_t)(k0a + 8 * i + kka) * N + n0a + nl);
    if (two) {
#pragma unroll
        for (int i = 0; i < 8; ++i) vb_[i] = *(const f32x4*)(Wb + (size_t)(k0b + 8 * i + kka) * N + n0b + nl); }
#pragma unroll
    for (int i = 0; i < 8; ++i) { LAS float* s = scr + (8 * i + kka) * 33 + nl; s[0] = va[i][0]; s[1] = va[i][1]; s[2] = va[i][2]; s[3] = va[i][3]; }
    if (two) {
#pragma unroll
        for (int i = 0; i < 8; ++i) { LAS float* s = scr + 2176 + (8 * i + kka) * 33 + nl; s[0] = vb_[i][0]; s[1] = vb_[i][1]; s[2] = vb_[i][2]; s[3] = vb_[i][3]; } }
    LDS_WAIT(); asm volatile("" ::: "memory");
    const int c = lane & 7;
#pragma unroll
    for (int j = 0; j < 4; ++j) { const int n = (lane >> 3) + 8 * j; const LAS float* s = scr + (8 * c) * 33 + n;
        v4u o; o.x = pk2(s[0 * 33], s[1 * 33]); o.y = pk2(s[2 * 33], s[3 * 33]); o.z = pk2(s[4 * 33], s[5 * 33]); o.w = pk2(s[6 * 33], s[7 * 33]);
        *(GAS v4u*)(WTa + (size_t)(n0a + n) * K + k0a + 8 * c) = o; }
    if (two) {
#pragma unroll
        for (int j = 0; j < 4; ++j) { const int n = (lane >> 3) + 8 * j; const LAS float* s = scr + 2176 + (8 * c) * 33 + n;
            v4u o; o.x = pk2(s[0 * 33], s[1 * 33]); o.y = pk2(s[2 * 33], s[3 * 33]); o.z = pk2(s[4 * 33], s[5 * 33]); o.w = pk2(s[6 * 33], s[7 * 33]);
            *(GAS v4u*)(WTb + (size_t)(n0b + n) * K + k0b + 8 * c) = o; } }
    LDS_WAIT(); asm volatile("" ::: "memory");
}
__device__ __forceinline__ void p0_filter_item(const Args& A, Frame& F, int pb) {
    LAS float* zb = (LAS float*)F.lds;
    LAS float* hA = zb + 64 * 36;
    LAS float* hB = hA + 64 * 68;
    LAS float* tl = hB + 64 * 68 + F.wave * (64 * 33);
    const int l0 = pb * 64, tid = F.tid;
    const float* w1 = A.in[13]; const float* b1 = A.in[14]; const float* w2 = A.in[15]; const float* b2 = A.in[16];
    const float* w3 = A.in[17]; const float* b3 = A.in[18]; const float* wout = A.in[19]; const float* freq = A.in[20];
    for (int idx = tid; idx < 64 * 33; idx += NTHR) { const int pos = idx / 33, f = idx % 33; const int l = l0 + pos;
        const float w = 6.283185307179586f * (float)l / 8192.f; float v;
        if (f == 0) v = (float)l / 8191.f;
        else { const int j = (f - 1) & 15; const float band = 1e-4f + (float)j * ((15.f - 1e-4f) / 15.f); const float a = band * w; v = (f <= 16) ? fcos(a) : -fsin(a); }
        zb[pos * 36 + f] = v; }
    __syncthreads();
    const int j = tid & 63, pg = tid >> 6;
    { float acc[8]; const float bj = b1[j], fj = freq[j];
#pragma unroll
      for (int i = 0; i < 8; ++i) acc[i] = bj;
      for (int k = 0; k < 33; ++k) { const float w = w1[k * 64 + j];
#pragma unroll
        for (int i = 0; i < 8; ++i) acc[i] += zb[(pg * 8 + i) * 36 + k] * w; }
#pragma unroll
      for (int i = 0; i < 8; ++i) hA[(pg * 8 + i) * 68 + j] = fsin(fj * acc[i]); }
    __syncthreads();
    { float acc[8]; const float bj = b2[j], fj = freq[j];
#pragma unroll
      for (int i = 0; i < 8; ++i) acc[i] = bj;
      for (int k = 0; k < 64; ++k) { const float w = w2[k * 64 + j];
#pragma unroll
        for (int i = 0; i < 8; ++i) acc[i] += hA[(pg * 8 + i) * 68 + k] * w; }
#pragma unroll
      for (int i = 0; i < 8; ++i) hB[(pg * 8 + i) * 68 + j] = fsin(fj * acc[i]); }
    __syncthreads();
    { float acc[8]; const float bj = b3[j], fj = freq[j];
#pragma unroll
      for (int i = 0; i < 8; ++i) acc[i] = bj;
      for (int k = 0; k < 64; ++k) { const float w = w3[k * 64 + j];
#pragma unroll
        for (int i = 0; i < 8; ++i) acc[i] += hB[(pg * 8 + i) * 68 + k] * w; }
      __syncthreads();
#pragma unroll
      for (int i = 0; i < 8; ++i) { const float v = fsin(fj * acc[i]); const unsigned hb_ = f2bf(v);
          LAS unsigned short* hp = (LAS unsigned short*)((LAS unsigned char*)hA + (pg * 8 + i) * 144) + j;
          hp[0] = (unsigned short)hb_; hp[4608] = (unsigned short)f2bf(v - __builtin_bit_cast(float, hb_ << 16)); } }
    __syncthreads();
    typedef short s16x8 __attribute__((ext_vector_type(8))); typedef float f32x16 __attribute__((ext_vector_type(16)));
    const int lane = F.lane, r32 = lane & 31, hi = lane >> 5;
    float* tapF = (float*)(F.ws + WS_TAPF); float* tapB = (float*)(F.ws + WS_TAPB);
    const LAS unsigned char* Hh = (const LAS unsigned char*)hA;
#pragma unroll 1
    for (int nb = 0; nb < 8; ++nb) {
        const int c0 = F.wave * 256 + nb * 32, col = c0 + r32, chan = col & 1023;
        s16x8 bh[4], bl[4];
#pragma unroll
        for (int s = 0; s < 4; ++s) { float x[8];
#pragma unroll
            for (int e = 0; e < 8; ++e) x[e] = wout[(size_t)(16 * s + 8 * hi + e) * 2048 + col];
            unsigned hw[4], lw[4];
#pragma unroll
            for (int e = 0; e < 4; ++e) { const unsigned h0 = f2bf(x[2 * e]), h1 = f2bf(x[2 * e + 1]); hw[e] = h0 | (h1 << 16);
                lw[e] = pk2(x[2 * e] - __builtin_bit_cast(float, h0 << 16), x[2 * e + 1] - __builtin_bit_cast(float, h1 << 16)); }
            const v4u hv = {hw[0], hw[1], hw[2], hw[3]}, lv = {lw[0], lw[1], lw[2], lw[3]};
            bh[s] = __builtin_bit_cast(s16x8, hv); bl[s] = __builtin_bit_cast(s16x8, lv); }
        const float delta = fabsf(-3.0701134573253945f + (-15.350567286626973f + 3.0701134573253945f) * ((float)chan / 1023.f));
#pragma unroll
        for (int mb = 0; mb < 2; ++mb) { f32x16 acc = {};
#pragma unroll
            for (int s = 0; s < 4; ++s) { const LAS unsigned char* ap = Hh + (32 * mb + r32) * 144 + (2 * s + hi) * 16;
                const s16x8 ah = *(const LAS s16x8*)ap, al = *(const LAS s16x8*)(ap + 9216);
                acc = __builtin_amdgcn_mfma_f32_32x32x16_bf16(al, bh[s], acc, 0, 0, 0);
                acc = __builtin_amdgcn_mfma_f32_32x32x16_bf16(ah, bl[s], acc, 0, 0, 0);
                acc = __builtin_amdgcn_mfma_f32_32x32x16_bf16(ah, bh[s], acc, 0, 0, 0); }
#pragma unroll
            for (int r = 0; r < 16; ++r) { const int pos = 32 * mb + (r & 3) + 8 * (r >> 2) + 4 * hi; const float t = (float)(l0 + pos) / 8191.f;
                tl[r32 * 65 + pos] = acc[r] * (__expf(-t * delta) + 0.05f); } }
        LDS_WAIT(); asm volatile("" ::: "memory");
        float* dst = (c0 < 1024) ? tapF : tapB;
#pragma unroll 4
        for (int c = 0; c < 32; ++c) dst[(size_t)((c0 + c) & 1023) * 8192 + l0 + lane] = tl[c * 65 + lane];
        LDS_WAIT(); asm volatile("" ::: "memory");
    }
    __syncthreads();
}
#ifdef P0_MASK
#define P0REP(s) _Pragma("unroll 1") for (int rep_ = 0; rep_ <= ((P0_MASK >> (s)) & 1); ++rep_)
#define P3REP(s) _Pragma("unroll 1") for (int rep3_ = 0; rep3_ <= ((P0_MASK >> (s)) & 1); ++rep3_)
#else
#define P0REP(s)
#define P3REP(s)
#endif
__device__ __forceinline__ void p0_prologue(const Args& A, Frame& F) {
    P0REP(0) if ((int)blockIdx.x < 128) p0_filter_item(A, F, (int)blockIdx.x);
    P0REP(1) { const float* wm = A.in[4]; const float* c = A.in[1]; const float* cc = A.in[3]; float* mp = (float*)(F.ws + WS_MODP);
      LAS float* sl = (LAS float*)F.lds;
      for (int k = F.tid; k < DM; k += NTHR) { sl[k] = silu(c[k]); sl[DM + k] = silu(cc[k]); }
      __syncthreads();
      const int cl = F.lane & 7, rl = F.lane >> 3;
      for (int it = F.gw; it < 384 * 4; it += F.NGW) { const int cg = it % 384, kc = it / 384;
          f32x4 al = {0.f, 0.f, 0.f, 0.f}, ac = {0.f, 0.f, 0.f, 0.f};
#pragma unroll
          for (int h = 0; h < 2; ++h) { f32x4 w[32];
#pragma unroll
              for (int i = 0; i < 32; ++i) w[i] = *(const f32x4*)(wm + (size_t)(kc * 512 + rl + 8 * (32 * h + i)) * NMOD + cg * 32 + cl * 4);
#pragma unroll
              for (int i = 0; i < 32; ++i) { const int k = kc * 512 + rl + 8 * (32 * h + i); al += w[i] * sl[k]; ac += w[i] * sl[DM + k]; } }
#pragma unroll
          for (int o = 8; o < 64; o <<= 1) {
#pragma unroll
              for (int e = 0; e < 4; ++e) { al[e] += __shfl_xor(al[e], o); ac[e] += __shfl_xor(ac[e], o); } }
          if (rl == 0) { *(f32x4*)(mp + (kc * 2 + 0) * NMOD + cg * 32 + cl * 4) = al; *(f32x4*)(mp + (kc * 2 + 1) * NMOD + cg * 32 + cl * 4) = ac; } }
      __syncthreads(); }
    P0REP(2) { LAS float* scr = (LAS float*)(F.lds + F.wave * 17408);
      constexpr int I_IN = (DM / 64) * (INCOLS / 32), I_HY = (HYW / 64) * (DM / 32), I_O = (DM / 64) * (DM / 32);
      for (int it = F.gw; it < I_IN; it += 2 * F.NGW) { const bool two = it + F.NGW < I_IN;
          p0_transpose_pair(A.in[10], (bf16*)(F.ws + WS_WIN), it, A.in[10], (bf16*)(F.ws + WS_WIN), two ? it + F.NGW : it, DM, INCOLS, two, scr, F.lane); }
      for (int it = F.gw; it < I_O; it += F.NGW)
          p0_transpose_pair(A.in[26], (bf16*)(F.ws + WS_WO), it, A.in[27], (bf16*)(F.ws + WS_WQ), it, DM, DM, true, scr, F.lane);
      for (int it = F.gw; it < 2 * I_HY; it += F.NGW) { const bool da = it >= I_HY; const int r = da ? it - I_HY : it;
          const float* W = da ? A.in[25] : A.in[24]; bf16* WT = (bf16*)(F.ws + (da ? WS_WDA : WS_WHY));
          p0_transpose_pair(W, WT, r, W, WT, r, HYW, DM, false, scr, F.lane); } }
    P0REP(3) {
      const int bx = (int)blockIdx.x; const bool bal = (F.G == 256);
      const int rbase = bal ? (bx < 128 ? bx * 120 : 15360 + (bx - 128) * 136) : 0, rcnt = bal ? (bx < 128 ? 120 : 136) : 2 * NEXP;
      const int rstart = bal ? F.wave : F.gw, rstep = bal ? NWAVES : F.NGW;
      for (int ri = rstart; ri < rcnt; ri += 2 * rstep) {
          const int rowa = rbase + ri, rowb = (ri + rstep < rcnt) ? rowa + rstep : rowa; const bool two = rowb != rowa;
          const bool ua = rowa < NEXP, ub_ = rowb < NEXP; const int ra = ua ? rowa : rowa - NEXP, rb = ub_ ? rowb : rowb - NEXP;
          const float* sa = (ua ? A.in[29] : A.in[30]) + (size_t)ra * DM + 16 * F.lane; const float* sb = (ub_ ? A.in[29] : A.in[30]) + (size_t)rb * DM + 16 * F.lane;
          f32x4 xa[8], xb[8];
#pragma unroll
          for (int i = 0; i < 8; ++i) xa[i] = *(const f32x4*)(sa + 1024 * (i >> 2) + 4 * (i & 3));
#pragma unroll
          for (int i = 0; i < 8; ++i) xb[i] = *(const f32x4*)(sb + 1024 * (i >> 2) + 4 * (i & 3));
          float ma = 0.f, mb = 0.f;
#pragma unroll
          for (int i = 0; i < 8; ++i) { ma = fmaxf(ma, fmaxf(fmaxf(fabsf(xa[i][0]), fabsf(xa[i][1])), fmaxf(fabsf(xa[i][2]), fabsf(xa[i][3]))));
              mb = fmaxf(mb, fmaxf(fmaxf(fabsf(xb[i][0]), fabsf(xb[i][1])), fmaxf(fabsf(xb[i][2]), fabsf(xb[i][3])))); }
#pragma unroll
          for (int o = 1; o < 64; o <<= 1) { ma = fmaxf(ma, __shfl_xor(ma, o)); mb = fmaxf(mb, __shfl_xor(mb, o)); }
          const float sca = (ma > 0.f) ? 384.f / ma : 1.f, scb = (mb > 0.f) ? 384.f / mb : 1.f;
          unsigned char* da = F.ws + (ua ? WS_UB : WS_VB) + (size_t)(F.lane >> 4) * ((size_t)NEXP * 256) + (size_t)ra * 256 + 16 * (F.lane & 15);
          unsigned char* db = F.ws + (ub_ ? WS_UB : WS_VB) + (size_t)(F.lane >> 4) * ((size_t)NEXP * 256) + (size_t)rb * 256 + 16 * (F.lane & 15);
#pragma unroll
          for (int q = 0; q < 2; ++q) { v4u o;
#pragma unroll
              for (int e = 0; e < 4; ++e) { const f32x4 t = xa[4 * q + e] * sca; int w = 0;
                  w = __builtin_amdgcn_cvt_pk_fp8_f32(t[0], t[1], w, false); w = __builtin_amdgcn_cvt_pk_fp8_f32(t[2], t[3], w, true); o[e] = (unsigned)w; }
              *(v4u*)(da + (size_t)(4 * q) * ((size_t)NEXP * 256)) = o; }
          if (F.lane == 0) ((float*)(F.ws + (ua ? WS_USC : WS_VSC)))[ra] = 1.f / sca;
          if (two) {
#pragma unroll
              for (int q = 0; q < 2; ++q) { v4u o;
#pragma unroll
                  for (int e = 0; e < 4; ++e) { const f32x4 t = xb[4 * q + e] * scb; int w = 0;
                      w = __builtin_amdgcn_cvt_pk_fp8_f32(t[0], t[1], w, false); w = __builtin_amdgcn_cvt_pk_fp8_f32(t[2], t[3], w, true); o[e] = (unsigned)w; }
                  *(v4u*)(db + (size_t)(4 * q) * ((size_t)NEXP * 256)) = o; }
              if (F.lane == 0) ((float*)(F.ws + (ub_ ? WS_USC : WS_VSC)))[rb] = 1.f / scb; } } }

}

__device__ __forceinline__ void p1_rows(const Args& A, Frame& F) {
    bf16* U = (bf16*)(F.ws + WS_U); const float* gn = A.in[6];
#pragma unroll 1
    for (int which = 0; which < 2; ++which) {
        const int r0 = which ? SEQ : 0, r1 = which ? MROWS : SEQ; const float* src = which ? A.in[2] : A.in[0];
        int r = r0 + F.gw; if (r >= r1) continue;
        f32x4 a[8], b[8];
#pragma unroll
        for (int j = 0; j < 8; ++j) { const int col = 4 * F.lane + 256 * j; const f32x4 g = *(const f32x4*)(gn + col);
            a[j] = g * (mod4(A, F, which, 1 * DM + col) + 1.f); b[j] = mod4(A, F, which, 0 * DM + col); }
        for (; r < r1; r += F.NGW) {
            const f32x4* xr = (const f32x4*)(src + (size_t)(r - r0) * DM) + F.lane; f32x4 v[8]; float s = 0.f;
#pragma unroll
            for (int j = 0; j < 8; ++j) { v[j] = xr[64 * j]; s += (v[j][0] * v[j][0] + v[j][1] * v[j][1]) + (v[j][2] * v[j][2] + v[j][3] * v[j][3]); }
            const float rstd = rsqrtf(wave_sum(s) * (1.f / DM) + EPS);
            unsigned long long* o8 = (unsigned long long*)(U + (size_t)r * DM) + F.lane;
#pragma unroll
            for (int j = 0; j < 8; ++j) { const f32x4 y = v[j] * rstd * a[j] + b[j];
                o8[64 * j] = (unsigned long long)pk2(y[0], y[1]) | ((unsigned long long)pk2(y[2], y[3]) << 32); }
        }
    }
}

__device__ __forceinline__ void p2_ctx_unit(Frame& F) {
    typedef short s16x8 __attribute__((ext_vector_type(8))); typedef float f32x16 __attribute__((ext_vector_type(16)));
    const bf16* U = (const bf16*)(F.ws + WS_U) + (size_t)SEQ * DM; const bf16* W = (const bf16*)(F.ws + WS_WIN);
    LAS float* part = (LAS float*)F.lds;
#pragma unroll 1
    for (int unit = F.vcu; unit < 256; unit += F.G) {
        const int rb = unit >> 5, cb = unit & 31, l31 = F.lane & 31, hi = F.lane >> 5, k0 = 256 * F.wave + 8 * hi;
        const bf16* ap = U + (size_t)(32 * rb + l31) * DM + k0;
        const bf16* bp0 = W + (size_t)(4096 + 64 * cb + l31) * DM + k0; const bf16* bp1 = bp0 + (size_t)32 * DM;
        f32x16 c0, c1;
#pragma unroll
        for (int r = 0; r < 16; ++r) { c0[r] = 0.f; c1[r] = 0.f; }
#pragma unroll
        for (int h = 0; h < 2; ++h) { s16x8 a[8], b0[8], b1[8];
#pragma unroll
            for (int s = 0; s < 8; ++s) { const int ko = 16 * (8 * h + s); a[s] = *(const s16x8*)(ap + ko); b0[s] = *(const s16x8*)(bp0 + ko); b1[s] = *(const s16x8*)(bp1 + ko); }
#pragma unroll
            for (int s = 0; s < 8; ++s) { c0 = __builtin_amdgcn_mfma_f32_32x32x16_bf16(a[s], b0[s], c0, 0, 0, 0); c1 = __builtin_amdgcn_mfma_f32_32x32x16_bf16(a[s], b1[s], c1, 0, 0, 0); } }
#pragma unroll
        for (int r = 0; r < 16; ++r) { const int row = (r & 3) + 8 * (r >> 2) + 4 * hi; part[F.wave * 2048 + row * 64 + l31] = c0[r]; part[F.wave * 2048 + row * 64 + 32 + l31] = c1[r]; }
        __syncthreads();
        { const int row = F.tid >> 4, c4 = 4 * (F.tid & 15); f32x4 s = {0.f, 0.f, 0.f, 0.f};
#pragma unroll
          for (int w = 0; w < 8; ++w) s += *(const LAS f32x4*)(part + w * 2048 + row * 64 + c4);
          bf16* dst = (bf16*)(F.ws + (cb < 16 ? WS_KRAW + (size_t)SEQ * 1024 * 2 : WS_V2)) + (size_t)(32 * rb + row) * 1024 + 64 * (cb & 15) + c4;
          *(unsigned long long*)dst = (unsigned long long)pk2(s[0], s[1]) | ((unsigned long long)pk2(s[2], s[3]) << 32); }
        __syncthreads();
    }
}

__device__ __forceinline__ void p3_post(const Args& A, Frame& F, const int gw, const int NGW) {
    const bf16* qraw = (const bf16*)(F.ws + WS_QRAW); const bf16* kraw = (const bf16*)(F.ws + WS_KRAW);
    bf16* q2 = (bf16*)(F.ws + WS_Q2); bf16* k2 = (bf16*)(F.ws + WS_K2);
    P3REP(4) { const int hm = F.lane >> 2, ax = (F.lane >> 1) & 1, jh = F.lane & 1; const int e0 = hm * 64 + 32 * ax + 8 * jh;
      float inv[8];
#pragma unroll
      for (int j = 0; j < 8; ++j) inv[j] = __builtin_amdgcn_exp2f(-(float)(8 * jh + j) * (13.287712379549449f / 16.f));
      for (int t = gw; t < SEQ; t += NGW) {
          const float pos = (float)(ax ? (t & 63) : (t >> 6));
          float cs[8], sn[8];
#pragma unroll
          for (int j = 0; j < 8; ++j) { const float a = pos * inv[j]; cs[j] = fcos(a); sn[j] = fsin(a); }
#pragma unroll
          for (int w = 0; w < 2; ++w) {
              const bf16* src = (w ? kraw : qraw) + (size_t)t * 1024 + e0; bf16* dst = (w ? k2 + (size_t)(CTXL + t) * 1024 : q2 + (size_t)t * 1024) + e0;
              const v4u x1 = *(const v4u*)src, x2 = *(const v4u*)(src + 16);
              float a1[8] = { blo(x1.x), bhi(x1.x), blo(x1.y), bhi(x1.y), blo(x1.z), bhi(x1.z), blo(x1.w), bhi(x1.w) };
              float a2[8] = { blo(x2.x), bhi(x2.x), blo(x2.y), bhi(x2.y), blo(x2.z), bhi(x2.z), blo(x2.w), bhi(x2.w) };
              float o1[8], o2[8];
              const float qs = w ? 1.f : att::C2;
#pragma unroll
              for (int j = 0; j < 8; ++j) { o1[j] = (a1[j] * cs[j] - a2[j] * sn[j]) * qs; o2[j] = (a2[j] * cs[j] + a1[j] * sn[j]) * qs; }
              v4u w1, w2; w1.x = pk2(o1[0], o1[1]); w1.y = pk2(o1[2], o1[3]); w1.z = pk2(o1[4], o1[5]); w1.w = pk2(o1[6], o1[7]);
              w2.x = pk2(o2[0], o2[1]); w2.y = pk2(o2[2], o2[3]); w2.z = pk2(o2[4], o2[5]); w2.w = pk2(o2[6], o2[7]);
              *(v4u*)dst = w1; *(v4u*)(dst + 16) = w2; }
      }
      for (int i = gw * 64 + F.lane; i < CTXL * 1024 / 8; i += NGW * 64) *((v4u*)k2 + i) = *((const v4u*)(kraw + (size_t)SEQ * 1024) + i);
    }
    P3REP(5) { const bf16* phy = (const bf16*)(F.ws + WS_PHY); const float* cw = A.in[11]; const float* cb = A.in[12];
      bf16* x0o = (bf16*)(F.ws + WS_X0); bf16* uht = (bf16*)(F.ws + WS_UHT);
      LAS unsigned char* tile = F.lds;
#pragma unroll 1
      for (int it = F.vcu; it < 256; it += F.G) { int ln = F.lane; asm volatile("" : "+v"(ln));
          const int t0 = (it >> 1) * 64, cbase = (it & 1) * 512, c = cbase + 8 * ln, tw = t0 + 8 * F.wave;
#pragma unroll 1
          for (int pass = 0; pass < 2; ++pass) {
              const int ns = pass ? 1 : 2, sb = pass ? 2 : 0;
              f32x4 wt[2][3][2], bs[2][2];
#pragma unroll
              for (int s = 0; s < 2; ++s) if (s < ns) { const int col = (sb + s) * 1024 + c;
#pragma unroll
                  for (int k = 0; k < 3; ++k) { wt[s][k][0] = *(const f32x4*)(cw + k * 3072 + col); wt[s][k][1] = *(const f32x4*)(cw + k * 3072 + col + 4); }
                  bs[s][0] = *(const f32x4*)(cb + col); bs[s][1] = *(const f32x4*)(cb + col + 4); }
              v4u row[2][10];
#pragma unroll
              for (int s = 0; s < 2; ++s) if (s < ns) {
#pragma unroll
                  for (int r = 0; r < 10; ++r) { const int t = tw - 1 + r;
                      row[s][r] = (t >= 0 && t < SEQ) ? *(const v4u*)(phy + (size_t)t * 3072 + (sb + s) * 1024 + c) : (v4u){0u, 0u, 0u, 0u}; } }
#pragma unroll
              for (int tt = 0; tt < 8; ++tt) { float z[2][8];
#pragma unroll
                  for (int s = 0; s < 2; ++s) if (s < ns) {
#pragma unroll
                      for (int h = 0; h < 4; ++h) { const unsigned a = row[s][tt][h], m = row[s][tt + 1][h], n = row[s][tt + 2][h]; const int q = h >> 1, e = 2 * (h & 1);
                          z[s][2 * h]     = blo(a) * wt[s][0][q][e]     + blo(m) * wt[s][1][q][e]     + blo(n) * wt[s][2][q][e]     + bs[s][q][e];
                          z[s][2 * h + 1] = bhi(a) * wt[s][0][q][e + 1] + bhi(m) * wt[s][1][q][e + 1] + bhi(n) * wt[s][2][q][e + 1] + bs[s][q][e + 1]; } }
                  if (pass == 0) { const int tl = 8 * F.wave + tt;
                      LAS unsigned short* tp = (LAS unsigned short*)(tile + (size_t)(8 * ln) * 128 + ((((tl >> 3) ^ ln) & 7) << 4) + 2 * (tl & 7));
#pragma unroll
                      for (int e = 0; e < 8; ++e) tp[e * 64] = (unsigned short)f2bf(z[0][e] * z[1][e]);
                  } else { v4u o; o.x = pk2(z[0][0], z[0][1]); o.y = pk2(z[0][2], z[0][3]); o.z = pk2(z[0][4], z[0][5]); o.w = pk2(z[0][6], z[0][7]);
                      *(v4u*)(x0o + (size_t)(tw + tt) * 1024 + c) = o; } }
          }
          __syncthreads();
          { const int csub = ln >> 3, piece = ln & 7;
#pragma unroll
            for (int i = 0; i < 8; ++i) { const int cl = 64 * F.wave + 8 * i + csub;
                const v4u v = *(const LAS v4u*)(tile + (size_t)cl * 128 + (((piece ^ (cl >> 3)) & 7) << 4));
                *(v4u*)(uht + (size_t)(cbase + cl) * SEQ + t0 + 8 * piece) = v; } }
          __syncthreads();
      } }
}

__device__ __forceinline__ void p4_conv_channel(Frame& F, int c) {
    LAS float* T = (LAS float*)F.lds;
    LAS float* uh = T + 16384;
    const float* tapF = (const float*)(F.ws + WS_TAPF) + (size_t)c * 8192; const float* tapB = (const float*)(F.ws + WS_TAPB) + (size_t)c * 8192;
    const bf16* uht = (const bf16*)(F.ws + WS_UHT) + (size_t)c * 8192;
    for (int i = F.tid; i < 8192; i += NTHR) { T[8192 + i] = tapF[i]; T[8192 - i] = (i == 0) ? tapF[0] : tapB[i]; uh[i] = bf2f(uht[i]); }
    if (F.tid == 0) T[0] = 0.f;
    __syncthreads();
    float acc[16];
#pragma unroll
    for (int i = 0; i < 16; ++i) acc[i] = 0.f;
    const int tid = F.tid;
    for (int S = 0; S < 512; ++S) {
        const int base = 16 * (tid - S) + 8192 - 16;
        float W[32], u[16];
#pragma unroll
        for (int q = 0; q < 32; q += 4) { const f32x4 w4 = *(const LAS f32x4*)(T + base + q); W[q] = w4[0]; W[q + 1] = w4[1]; W[q + 2] = w4[2]; W[q + 3] = w4[3]; }
#pragma unroll
        for (int q = 0; q < 16; q += 4) { const f32x4 u4 = *(const LAS f32x4*)(uh + 16 * S + q); u[q] = u4[0]; u[q + 1] = u4[1]; u[q + 2] = u4[2]; u[q + 3] = u4[3]; }
#pragma unroll
        for (int j = 0; j < 16; ++j)
#pragma unroll
            for (int i = 0; i < 16; ++i) acc[i] += W[16 + i - j] * u[j];
    }
    bf16* yo = (bf16*)(F.ws + WS_YCT) + (size_t)c * 8192 + 16 * tid;
    v4u o0, o1; o0.x = pk2(acc[0], acc[1]); o0.y = pk2(acc[2], acc[3]); o0.z = pk2(acc[4], acc[5]); o0.w = pk2(acc[6], acc[7]);
    o1.x = pk2(acc[8], acc[9]); o1.y = pk2(acc[10], acc[11]); o1.z = pk2(acc[12], acc[13]); o1.w = pk2(acc[14], acc[15]);
    *(v4u*)yo = o0; *(v4u*)(yo + 8) = o1;
    __syncthreads();
}
namespace fftc {
constexpr int N = 16384, LH = 8192, KSTR = 8320;
typedef float c32 __attribute__((ext_vector_type(2)));
__device__ __forceinline__ int rev4(int k) {
    unsigned r = __brev((unsigned)k) >> 18; return (int)(((r & 0x2AAAu) >> 1) | ((r & 0x1555u) << 1));
}
__device__ __forceinline__ int sw(int e) { const int t = e >> 4; return e ^ ((t & 3) * 5) ^ ((t & 4) << 2); }
__device__ __forceinline__ int rev4b(int m) { const unsigned r = __brev((unsigned)m) >> 24; return (int)(((r & 0xAAu) >> 1) | ((r & 0x55u) << 1)); }
__device__ __forceinline__ c32 cmul(c32 a, c32 b) { return (c32){a.x * b.x - a.y * b.y, a.x * b.y + a.y * b.x}; }
__device__ __forceinline__ c32 cadd(c32 a, c32 b) { c32 r; asm("v_pk_add_f32 %0, %1, %2" : "=v"(r) : "v"(a), "v"(b)); return r; }
__device__ __forceinline__ c32 csub(c32 a, c32 b) { c32 r; asm("v_pk_add_f32 %0, %1, %2 neg_lo:[0,1] neg_hi:[0,1]" : "=v"(r) : "v"(a), "v"(b)); return r; }
__device__ __forceinline__ c32 csubi(c32 a, c32 b) { c32 r; asm("v_pk_add_f32 %0, %1, %2 op_sel:[0,1] op_sel_hi:[1,0] neg_hi:[0,1]" : "=v"(r) : "v"(a), "v"(b)); return r; }
__device__ __forceinline__ c32 caddi(c32 a, c32 b) { c32 r; asm("v_pk_add_f32 %0, %1, %2 op_sel:[0,1] op_sel_hi:[1,0] neg_lo:[0,1]" : "=v"(r) : "v"(a), "v"(b)); return r; }
__device__ __forceinline__ c32 cmulw(c32 a, c32 w, c32 wr) { c32 t, r;
    asm("v_pk_mul_f32 %0, %1, %2 op_sel_hi:[0,1]" : "=v"(t) : "v"(a), "v"(w));
    asm("v_pk_fma_f32 %0, %1, %2, %3 op_sel:[1,0,0] op_sel_hi:[1,1,1]" : "=v"(r) : "v"(a), "v"(wr), "v"(t)); return r; }
struct Tw { c32 w1, r1, w2, r2, w3, r3; };
template <bool INV> __device__ __forceinline__ Tw make_tw(float ang) {
    float c, s; Tw t;
    asm("s_nop 1\n\tv_cos_f32 %0, %2\n\tv_sin_f32 %1, %2\n\ts_nop 1" : "=&v"(c), "=&v"(s) : "v"(ang));
    t.w1 = INV ? (c32){c, s} : (c32){c, -s}; t.r1 = INV ? (c32){-s, c} : (c32){s, c};
    t.w2 = cmulw(t.w1, t.w1, t.r1); t.r2 = cmulw(t.r1, t.w1, t.r1); t.w3 = cmulw(t.w2, t.w1, t.r1); t.r3 = cmulw(t.r2, t.w1, t.r1); return t;
}
template <bool INV, bool TW> __device__ __forceinline__ void bfly(c32& a0, c32& a1, c32& a2, c32& a3, const Tw& t) {
    if (INV) {
        if (TW) { a1 = cmulw(a1, t.w1, t.r1); a2 = cmulw(a2, t.w2, t.r2); a3 = cmulw(a3, t.w3, t.r3); }
        const c32 s0 = cadd(a0, a2), s1 = csub(a0, a2), s2 = cadd(a1, a3), s3 = csub(a1, a3);
        a0 = cadd(s0, s2); a2 = csub(s0, s2); a1 = caddi(s1, s3); a3 = csubi(s1, s3);
    } else {
        const c32 t0 = cadd(a0, a2), t1 = csub(a0, a2), t2 = cadd(a1, a3), t3 = csub(a1, a3);
        a0 = cadd(t0, t2); a2 = csub(t0, t2); a1 = csubi(t1, t3); a3 = caddi(t1, t3);
        if (TW) { a1 = cmulw(a1, t.w1, t.r1); a2 = cmulw(a2, t.w2, t.r2); a3 = cmulw(a3, t.w3, t.r3); }
    }
}
template <int S, bool INV> __device__ __forceinline__ void stage(LAS c32* x, int tid) {
    constexpr int L = N >> (2 * S), q = L / 4;
    asm volatile("" : "+v"(tid));
    if constexpr (q >= 512) {
        LAS c32* xs = x + sw(tid); constexpr int R = q / 512;
#pragma unroll
        for (int i = 0; i < 8; ++i) { const int off = (i / R) * L + 512 * (i % R);
            c32 a0 = xs[off], a1 = xs[off + q], a2 = xs[off + 2 * q], a3 = xs[off + 3 * q];
            const Tw t = make_tw<INV>((float)(tid + 512 * (i % R)) * (1.f / (float)L));
            bfly<INV, true>(a0, a1, a2, a3, t);
            xs[off] = a0; xs[off + q] = a1; xs[off + 2 * q] = a2; xs[off + 3 * q] = a3; }
    } else {
        const int j = tid & (q - 1), base = (tid / q) * L + j;
        LAS c32* p0 = x + sw(base); LAS c32* p1 = x + sw(base + q); LAS c32* p2 = x + sw(base + 2 * q); LAS c32* p3 = x + sw(base + 3 * q);
        Tw t; if constexpr (q > 1) t = make_tw<INV>((float)j * (1.f / (float)L));
#pragma unroll
        for (int i = 0; i < 8; ++i) { c32 a0 = p0[2048 * i], a1 = p1[2048 * i], a2 = p2[2048 * i], a3 = p3[2048 * i];
            bfly<INV, (q > 1)>(a0, a1, a2, a3, t);
            p0[2048 * i] = a0; p1[2048 * i] = a1; p2[2048 * i] = a2; p3[2048 * i] = a3; }
    }
    __syncthreads();
}
template <int S> __device__ __forceinline__ void fwd_stage(LAS c32* x, int tid) { stage<S, false>(x, tid); }
template <int S> __device__ __forceinline__ void inv_stage(LAS c32* x, int tid) { stage<S, true>(x, tid); }
__device__ __forceinline__ void fwd_all(LAS c32* x, int tid) { fwd_stage<0>(x, tid); fwd_stage<1>(x, tid); fwd_stage<2>(x, tid); fwd_stage<3>(x, tid); fwd_stage<4>(x, tid); fwd_stage<5>(x, tid); fwd_stage<6>(x, tid); }
__device__ __forceinline__ void inv_all(LAS c32* x, int tid) { inv_stage<6>(x, tid); inv_stage<5>(x, tid); inv_stage<4>(x, tid); inv_stage<3>(x, tid); inv_stage<2>(x, tid); inv_stage<1>(x, tid); inv_stage<0>(x, tid); }
__device__ __forceinline__ void conv_pair(LAS unsigned char* lds, int tid, int pr, const float* tapF, const float* tapB, const unsigned short* uht, unsigned short* yct) {
    LAS c32* x = (LAS c32*)lds;
    const size_t o1 = (size_t)(2 * pr) * LH, o2 = o1 + LH;
#pragma unroll 1
    for (int h = 0; h < 2; ++h) { f32x4 f1[2], f2[2], b1[2], b2[2];
#pragma unroll
      for (int i = 0; i < 2; ++i) { const int n = 4 * (tid + 512 * (2 * h + i)); f1[i] = *(const f32x4*)(tapF + o1 + n); f2[i] = *(const f32x4*)(tapF + o2 + n); b1[i] = *(const f32x4*)(tapB + o1 + n); b2[i] = *(const f32x4*)(tapB + o2 + n); }
#pragma unroll
      for (int i = 0; i < 2; ++i) {
#pragma unroll
          for (int e = 0; e < 4; ++e) { const int n = 4 * (tid + 512 * (2 * h + i)) + e; const bool z = (n == 0);
              x[sw(n)] = (c32){f1[i][e], f2[i][e]}; x[sw(z ? LH : N - n)] = z ? (c32){0.f, 0.f} : (c32){b1[i][e], b2[i][e]}; } } }
    __syncthreads();
    fwd_all(x, tid);
    const int lane = tid & 63, wv = tid >> 6, khi = ((lane & 3) << 4) | (lane & 12) | (lane >> 4);
    f32x4 Kr[17];
#pragma unroll
    for (int it = 0; it < 17; ++it) { const int m = wv + 8 * it;
        const bool act = (it == 16) ? (wv == 0 && khi < 32) : ((it == 0 && wv == 0) ? (khi <= 32) : true);
        const int kp = (N - (256 * khi + m)) & (N - 1);
        const int pk = sw((rev4b(m) << 6) | lane), pkp = sw(rev4(kp));
        Kr[it] = (f32x4){0.f, 0.f, 0.f, 0.f};
        if (act) { const c32 A = x[pk], Bq = x[pkp]; const c32 B = (c32){Bq.x, -Bq.y};
            const c32 sm = A + B, df = A - B; constexpr float h = 0.5f / (float)N;
            Kr[it] = (f32x4){sm.x * h, sm.y * h, df.y * h, -df.x * h}; } }
    __syncthreads();
    { v2u u1[4], u2[4];
#pragma unroll
      for (int i = 0; i < 4; ++i) { const int n = 4 * (tid + 512 * i); u1[i] = *(const v2u*)(uht + o1 + n); u2[i] = *(const v2u*)(uht + o2 + n); }
#pragma unroll
      for (int i = 0; i < 4; ++i) { const int n = 4 * (tid + 512 * i);
          x[sw(n)] = (c32){blo(u1[i].x), blo(u2[i].x)}; x[sw(n + 1)] = (c32){bhi(u1[i].x), bhi(u2[i].x)}; x[sw(n + 2)] = (c32){blo(u1[i].y), blo(u2[i].y)}; x[sw(n + 3)] = (c32){bhi(u1[i].y), bhi(u2[i].y)};
#pragma unroll
          for (int e = 0; e < 4; ++e) x[sw(LH + n + e)] = (c32){0.f, 0.f}; } }
    __syncthreads();
    fwd_all(x, tid);
#pragma unroll
    for (int it = 0; it < 17; ++it) { const int m = wv + 8 * it;
        const bool act = (it == 16) ? (wv == 0 && khi < 32) : ((it == 0 && wv == 0) ? (khi <= 32) : true);
        const int kp = (N - (256 * khi + m)) & (N - 1);
        const int pk = sw((rev4b(m) << 6) | lane), pkp = sw(rev4(kp));
        if (act) { const c32 A = x[pk], Bq = x[pkp]; const c32 B = (c32){Bq.x, -Bq.y};
            const c32 sm = A + B, df = A - B; const c32 U1 = sm * 0.5f, U2 = (c32){df.y * 0.5f, -df.x * 0.5f};
            const f32x4 K = Kr[it];
            const c32 Y1 = cmul(U1, (c32){K[0], K[1]}), Y2 = cmul(U2, (c32){K[2], K[3]});
            x[pkp] = (c32){Y1.x + Y2.y, Y2.x - Y1.y};
            x[pk]  = (c32){Y1.x - Y2.y, Y1.y + Y2.x}; } }
    __syncthreads();
    inv_all(x, tid);
#pragma unroll
    for (int i = 0; i < 4; ++i) { const int n = 4 * (tid + 512 * i); const c32 v0 = x[sw(n)], v1 = x[sw(n + 1)], v2 = x[sw(n + 2)], v3 = x[sw(n + 3)];
        *(v2u*)(yct + o1 + n) = (v2u){pk2(v0.x, v1.x), pk2(v2.x, v3.x)}; *(v2u*)(yct + o2 + n) = (v2u){pk2(v0.y, v1.y), pk2(v2.y, v3.y)}; }
    __syncthreads();
}
}
__device__ __forceinline__ float da_lambda(const Args& A, const Frame& F) {
    const float* lp = A.in[22]; const int l = F.lane;
    const float sa = wave_sum(lp[l] * lp[64 + l]), sb = wave_sum(lp[128 + l] * lp[192 + l]);
    return __expf(sa) - __expf(sb) + 0.2f;
}
__device__ __forceinline__ void p5_finalize(const Args& A, Frame& F) {
    { const float lam = da_lambda(A, F); const float* O = (const float*)(F.ws + WS_O); bf16* yda = (bf16*)(F.ws + WS_YDA); const float* sub = A.in[23];
      const int head = F.lane >> 3, e0 = (F.lane & 7) * 16;
      float sl[16];
#pragma unroll
      for (int i = 0; i < 16; ++i) sl[i] = sub[e0 + i] * 0.8f;
      for (int t = F.gw; t < SEQ; t += F.NGW) {
          const float* o0 = O + (size_t)t * 2048 + (2 * head) * 128 + e0; const float* o1 = o0 + 128;
          float y[16]; float ss = 0.f;
#pragma unroll
          for (int q = 0; q < 4; ++q) { const f32x4 a = *(const f32x4*)(o0 + 4 * q), b = *(const f32x4*)(o1 + 4 * q);
#pragma unroll
              for (int e = 0; e < 4; ++e) { const float v = a[e] - lam * b[e]; y[4 * q + e] = v; ss += v * v; } }
          ss += __shfl_xor(ss, 1); ss += __shfl_xor(ss, 2); ss += __shfl_xor(ss, 4);
          const float rstd = rsqrtf(ss * (1.f / 128.f) + EPS);
          v4u w0, w1; w0.x = pk2(y[0] * rstd * sl[0], y[1] * rstd * sl[1]); w0.y = pk2(y[2] * rstd * sl[2], y[3] * rstd * sl[3]);
          w0.z = pk2(y[4] * rstd * sl[4], y[5] * rstd * sl[5]); w0.w = pk2(y[6] * rstd * sl[6], y[7] * rstd * sl[7]);
          w1.x = pk2(y[8] * rstd * sl[8], y[9] * rstd * sl[9]); w1.y = pk2(y[10] * rstd * sl[10], y[11] * rstd * sl[11]);
          w1.z = pk2(y[12] * rstd * sl[12], y[13] * rstd * sl[13]); w1.w = pk2(y[14] * rstd * sl[14], y[15] * rstd * sl[15]);
          bf16* dst = yda + (size_t)t * 1024 + head * 128 + e0; *(v4u*)dst = w0; *(v4u*)(dst + 8) = w1; } }
    { const bf16* yct = (const bf16*)(F.ws + WS_YCT); const bf16* uht = (const bf16*)(F.ws + WS_UHT); const bf16* x0 = (const bf16*)(F.ws + WS_X0);
      bf16* yhy = (bf16*)(F.ws + WS_YHY); const float* bias = A.in[21];
      LAS unsigned char* tile = F.lds;
#pragma unroll 1
      for (int it = F.vcu; it < 256; it += F.G) { int ln = F.lane; asm volatile("" : "+v"(ln));
          const int t0 = (it >> 1) * 64, cbase = (it & 1) * 512, csub = ln >> 3, piece = ln & 7;
          v4u yv[8], uv[8]; float bv[8];
#pragma unroll
          for (int i = 0; i < 8; ++i) { const int cl = 64 * F.wave + 8 * i + csub; const size_t o = (size_t)(cbase + cl) * SEQ + t0 + 8 * piece;
              yv[i] = *(const v4u*)(yct + o); uv[i] = *(const v4u*)(uht + o); bv[i] = bias[cbase + cl]; }
#pragma unroll
          for (int i = 0; i < 8; ++i) { const int cl = 64 * F.wave + 8 * i + csub;
              LAS unsigned short* tp = (LAS unsigned short*)(tile + (size_t)(8 * piece) * 1024 + ((((cl >> 3) ^ piece) & 63) << 4) + 2 * (cl & 7));
#pragma unroll
              for (int h = 0; h < 4; ++h) { tp[(2 * h) * 512] = (unsigned short)f2bf(blo(yv[i][h]) + blo(uv[i][h]) * bv[i]); tp[(2 * h + 1) * 512] = (unsigned short)f2bf(bhi(yv[i][h]) + bhi(uv[i][h]) * bv[i]); } }
          __syncthreads();
          v4u xv[8];
#pragma unroll
          for (int tt = 0; tt < 8; ++tt) xv[tt] = *(const v4u*)(x0 + (size_t)(t0 + 8 * F.wave + tt) * 1024 + cbase + 8 * ln);
#pragma unroll
          for (int tt = 0; tt < 8; ++tt) { const int tl = 8 * F.wave + tt;
              const v4u m = *(const LAS v4u*)(tile + (size_t)tl * 1024 + (((ln ^ (tl >> 3)) & 63) << 4)); v4u o;
#pragma unroll
              for (int h = 0; h < 4; ++h) o[h] = pk2(blo(xv[tt][h]) * blo(m[h]), bhi(xv[tt][h]) * bhi(m[h]));
              *(v4u*)(yhy + (size_t)(t0 + tl) * 1024 + cbase + 8 * ln) = o; }
          __syncthreads();
      } }
}

__device__ __forceinline__ void p8_rows(const Args& A, Frame& F) {
    const float* mix = (const float*)(F.ws + WS_MIX); bf16* hb = (bf16*)(F.ws + WS_HB);
    int r = F.gw; if (r >= SEQ) return;
    f32x4 ga[8], a2[8], b2[8];
#pragma unroll
    for (int j = 0; j < 8; ++j) { const int col = 4 * F.lane + 256 * j;
        ga[j] = mod4(A, F, 0, 2 * DM + col) * *(const f32x4*)(A.in[7] + col);
        a2[j] = *(const f32x4*)(A.in[8] + col) * (mod4(A, F, 0, 4 * DM + col) + 1.f); b2[j] = mod4(A, F, 0, 3 * DM + col); }
    for (; r < SEQ; r += F.NGW) {
        const f32x4* mr = (const f32x4*)(mix + (size_t)r * DM) + F.lane; const f32x4* xr = (const f32x4*)(A.in[0] + (size_t)r * DM) + F.lane;
        f32x4 v[8], xv[8]; float s = 0.f;
#pragma unroll
        for (int j = 0; j < 8; ++j) { v[j] = mr[64 * j]; xv[j] = xr[64 * j]; }
#pragma unroll
        for (int j = 0; j < 8; ++j) s += (v[j][0] * v[j][0] + v[j][1] * v[j][1]) + (v[j][2] * v[j][2] + v[j][3] * v[j][3]);
        const float rstd = rsqrtf(wave_sum(s) * (1.f / DM) + EPS); float s2 = 0.f;
        f32x4* orow = (f32x4*)(F.out + (size_t)r * DM) + F.lane;
#pragma unroll
        for (int j = 0; j < 8; ++j) { v[j] = xv[j] + v[j] * rstd * ga[j]; orow[64 * j] = v[j];
            s2 += (v[j][0] * v[j][0] + v[j][1] * v[j][1]) + (v[j][2] * v[j][2] + v[j][3] * v[j][3]); }
        const float rstd2 = rsqrtf(wave_sum(s2) * (1.f / DM) + EPS);
        unsigned long long* o8 = (unsigned long long*)(hb + (size_t)r * DM) + F.lane;
#pragma unroll
        for (int j = 0; j < 8; ++j) { const f32x4 y = v[j] * rstd2 * a2[j] + b2[j];
            o8[64 * j] = (unsigned long long)pk2(y[0], y[1]) | ((unsigned long long)pk2(y[2], y[3]) << 32); }
    }
}

typedef float f32x16 __attribute__((ext_vector_type(16)));
#define TK_CS(A, B) do { const float hi_ = __builtin_fmaxf(v[A], v[B]), lo_ = __builtin_fminf(v[A], v[B]); v[A] = hi_; v[B] = lo_; } while (0)
__device__ __forceinline__ float tk_tag(float x, unsigned mask, unsigned id) { return __uint_as_float((__float_as_uint(x) & ~mask) | id); }
__device__ __forceinline__ void tk_sort16(float (&v)[16]) {
#pragma unroll
    for (int k = 2; k <= 16; k <<= 1)
#pragma unroll
        for (int j = k >> 1; j >= 1; j >>= 1)
#pragma unroll
            for (int i = 0; i < 16; ++i) { const int l = i ^ j; if (l > i) { if ((i & k) == 0) TK_CS(i, l); else TK_CS(l, i); } }
}
__device__ __forceinline__ void tk_merge16(float (&v)[16], const float (&o)[16]) {
#pragma unroll
    for (int t = 0; t < 16; ++t) v[t] = __builtin_fmaxf(v[t], o[15 - t]);
#pragma unroll
    for (int st = 8; st >= 1; st >>= 1)
#pragma unroll
        for (int t = 0; t < 16; ++t) if ((t & st) == 0) TK_CS(t, t + st);
}
__device__ __forceinline__ void p11_item(const Args& A, Frame& F, int item) {
    const int tb = item & 31, h = item >> 5;
    typedef short s16x8 __attribute__((ext_vector_type(8)));
    LAS unsigned char* KH = F.lds;
    const float* keys = A.in[28];
    for (int i = F.tid; i < 2 * 128 * 16; i += NTHR) { const int ch = i & 15, k = (i >> 4) & 127, p = i >> 11;
        const float* src = keys + ((size_t)(p * 8 + h) * 128 + k) * 128 + ch * 8; const f32x4 a = *(const f32x4*)src, b = *(const f32x4*)(src + 4);
        const float x[8] = {a[0], a[1], a[2], a[3], b[0], b[1], b[2], b[3]}; unsigned hw[4], lw[4];
#pragma unroll
        for (int e = 0; e < 4; ++e) { const unsigned h0 = f2bf(x[2 * e]), h1 = f2bf(x[2 * e + 1]); hw[e] = h0 | (h1 << 16);
            lw[e] = pk2(x[2 * e] - __builtin_bit_cast(float, h0 << 16), x[2 * e + 1] - __builtin_bit_cast(float, h1 << 16)); }
        LAS unsigned char* d = KH + (size_t)p * 65536 + (size_t)k * 256 + ((ch ^ (k & 15)) << 4);
        *(LAS v4u*)d = (v4u){hw[0], hw[1], hw[2], hw[3]}; *(LAS v4u*)(d + 32768) = (v4u){lw[0], lw[1], lw[2], lw[3]}; }
    __syncthreads();
    const int lane = F.lane, r32 = lane & 31, hi = lane >> 5;
    const int n = tb * 256 + F.wave * 32 + r32;
    const float* qrow = (const float*)(F.ws + WS_QP) + (size_t)n * DM + h * 256;
    f32x16 acc[2][4];
#pragma unroll
    for (int p = 0; p < 2; ++p) {
#pragma unroll
        for (int kt = 0; kt < 4; ++kt) acc[p][kt] = f32x16{};
        const LAS unsigned char* kb = KH + (size_t)p * 65536 + (size_t)r32 * 256;
        const float* qp = qrow + p * 128 + 8 * hi;
        f32x4 qa = *(const f32x4*)qp, qb = *(const f32x4*)(qp + 4);
#pragma unroll 1
        for (int s = 0; s < 8; ++s) {
            const f32x4 ca = qa, cb = qb; { const int sn = (s + 1) & 7; qa = *(const f32x4*)(qp + 16 * sn); qb = *(const f32x4*)(qp + 16 * sn + 4); }
            const float x[8] = {ca[0], ca[1], ca[2], ca[3], cb[0], cb[1], cb[2], cb[3]}; unsigned hw[4], lw[4];
#pragma unroll
            for (int e = 0; e < 4; ++e) { const unsigned h0 = f2bf(x[2 * e]), h1 = f2bf(x[2 * e + 1]); hw[e] = h0 | (h1 << 16);
                lw[e] = pk2(x[2 * e] - __builtin_bit_cast(float, h0 << 16), x[2 * e + 1] - __builtin_bit_cast(float, h1 << 16)); }
            const v4u bhv = {hw[0], hw[1], hw[2], hw[3]}, blv = {lw[0], lw[1], lw[2], lw[3]};
            const s16x8 bh = __builtin_bit_cast(s16x8, bhv), bl = __builtin_bit_cast(s16x8, blv);
            const int co = (((2 * s + hi) ^ (r32 & 15)) << 4);
#pragma unroll
            for (int kt = 0; kt < 4; ++kt) { const s16x8 ah = *(const LAS s16x8*)(kb + kt * 8192 + co), al = *(const LAS s16x8*)(kb + kt * 8192 + co + 32768);
                acc[p][kt] = __builtin_amdgcn_mfma_f32_32x32x16_bf16(al, bh, acc[p][kt], 0, 0, 0);
                acc[p][kt] = __builtin_amdgcn_mfma_f32_32x32x16_bf16(ah, bl, acc[p][kt], 0, 0, 0);
                acc[p][kt] = __builtin_amdgcn_mfma_f32_32x32x16_bf16(ah, bh, acc[p][kt], 0, 0, 0); }
        }
    }
    __syncthreads();
    float lv[2][16];
#pragma unroll
    for (int p = 0; p < 2; ++p) {
        float v[16];
#pragma unroll
        for (int r = 0; r < 16; ++r) v[r] = tk_tag(acc[p][0][r], 127u, (unsigned)((r & 3) + 8 * (r >> 2) + 4 * hi));
        tk_sort16(v);
#pragma unroll
        for (int kt = 1; kt < 4; ++kt) { float w[16];
#pragma unroll
            for (int r = 0; r < 16; ++r) w[r] = tk_tag(acc[p][kt][r], 127u, (unsigned)(32 * kt + (r & 3) + 8 * (r >> 2) + 4 * hi));
            tk_sort16(w); tk_merge16(v, w); }
        { float ov[16];
#pragma unroll
          for (int t = 0; t < 16; ++t) ov[t] = __shfl_xor(v[t], 32);
          tk_merge16(v, ov); }
#pragma unroll
        for (int t = 0; t < 16; ++t) lv[p][t] = v[t];
    }
    LAS int* cidl = (LAS int*)F.lds + (F.wave * 32 + r32) * 65;
    float blk[4][16]; { int c = 0;
#pragma unroll
        for (int i = 0; i < 16; ++i)
#pragma unroll
            for (int j = 0; j < 16; ++j) if ((i + 1) * (j + 1) <= 16) {
                blk[c >> 4][c & 15] = tk_tag(lv[0][i] + lv[1][j], 63u, (unsigned)c);
                if (hi == 0) cidl[c] = (int)((__float_as_uint(lv[0][i]) & 127u) * 128u + (__float_as_uint(lv[1][j]) & 127u));
                ++c; }
#pragma unroll
        for (; c < 64; ++c) blk[c >> 4][c & 15] = tk_tag(-3.0e38f, 63u, (unsigned)c); }
    tk_sort16(blk[0]); tk_sort16(blk[1]); tk_sort16(blk[2]); tk_sort16(blk[3]);
    tk_merge16(blk[0], blk[1]); tk_merge16(blk[2], blk[3]); tk_merge16(blk[0], blk[2]);
    float e[16], sum = 0.f;
#pragma unroll
    for (int t = 0; t < 16; ++t) { e[t] = __expf(blk[0][t] - blk[0][0]); sum += e[t]; }
    const float rs = 1.f / sum;
    if (hi == 0) { int* io = (int*)(F.ws + WS_IDX) + (size_t)n * 128 + h * 16; float* go = (float*)(F.ws + WS_GW) + (size_t)n * 128 + h * 16;
        int id[16];
#pragma unroll
        for (int t = 0; t < 16; ++t) id[t] = cidl[__float_as_uint(blk[0][t]) & 63u];
#pragma unroll
        for (int t = 0; t < 16; t += 4) { *(v4u*)(io + t) = (v4u){(unsigned)id[t], (unsigned)id[t + 1], (unsigned)id[t + 2], (unsigned)id[t + 3]};
            *(f32x4*)(go + t) = (f32x4){e[t] * rs, e[t + 1] * rs, e[t + 2] * rs, e[t + 3] * rs}; } }
    __syncthreads();
}
#undef TK_CS

__device__ __forceinline__ float gelu_erf(float x) { return 0.5f * x * (1.f + erff(x * 0.7071067811865476f)); }
__device__ __forceinline__ void fmac1(float& acc, float a, float b) { asm("v_fmac_f32 %0, %1, %2" : "+v"(acc) : "v"(a), "v"(b)); }
typedef _Float16 h2 __attribute__((ext_vector_type(2)));
__device__ __forceinline__ void p12_coldots(const Args& A, Frame& F) {
    typedef float f32x2 __attribute__((ext_vector_type(2)));
    const bf16* hb = (const bf16*)(F.ws + WS_HB); const unsigned char* ub = F.ws + WS_UB; const int* idx = (const int*)(F.ws + WS_IDX);
    const int lane = F.lane, wpg = F.NGW >> 3, x = F.gw / wpg, wl = F.gw - x * wpg, rs = lane >> 4, cc = lane & 15;
    float* pdx = (float*)(F.ws + WS_PD) + (size_t)x * SEQ * 128;
    const size_t coff = 256 * x + 16 * cc;
    const unsigned char* usl = ub + (size_t)x * ((size_t)NEXP * 256) + 16 * cc;
#define P12_LOADH(HF, ID0, ID1, nn) do { const v4u a_ = *(const v4u*)(hb + (size_t)(nn) * DM + coff), b_ = *(const v4u*)(hb + (size_t)(nn) * DM + coff + 8); \
        HF[0] = (h2){(_Float16)blo(a_.x), (_Float16)bhi(a_.x)}; HF[1] = (h2){(_Float16)blo(a_.y), (_Float16)bhi(a_.y)}; HF[2] = (h2){(_Float16)blo(a_.z), (_Float16)bhi(a_.z)}; HF[3] = (h2){(_Float16)blo(a_.w), (_Float16)bhi(a_.w)}; \
        HF[4] = (h2){(_Float16)blo(b_.x), (_Float16)bhi(b_.x)}; HF[5] = (h2){(_Float16)blo(b_.y), (_Float16)bhi(b_.y)}; HF[6] = (h2){(_Float16)blo(b_.z), (_Float16)bhi(b_.z)}; HF[7] = (h2){(_Float16)blo(b_.w), (_Float16)bhi(b_.w)}; \
        ID0 = idx[(size_t)(nn) * 128 + lane]; ID1 = idx[(size_t)(nn) * 128 + 64 + lane]; } while (0)
#define P12_LOADW(W, ID) do { _Pragma("unroll") for (int i = 0; i < 16; ++i) { const int e_ = __shfl((ID), 4 * i + rs); W[i] = *(const v4u*)(usl + (size_t)e_ * 256); } } while (0)
#define P12_DOTS(W, HF, B) do { _Pragma("unroll") for (int i = 0; i < 16; ++i) { float a0 = 0.f, a1 = 0.f; \
        _Pragma("unroll") for (int e = 0; e < 4; ++e) { const h2 lo = __builtin_amdgcn_cvt_scalef32_pk_f16_fp8((int)W[i][e], 1.0f, false), hi2 = __builtin_amdgcn_cvt_scalef32_pk_f16_fp8((int)W[i][e], 1.0f, true); \
            a0 = __builtin_amdgcn_fdot2(lo, HF[2 * e], a0, false); a1 = __builtin_amdgcn_fdot2(hi2, HF[2 * e + 1], a1, false); } \
        acc[16 * (B) + i] = a0 + a1; } } while (0)
    h2 hf[8], hfn[8]; int id0, id1, idn0 = 0, idn1 = 0; v4u wA[16], wB[16];
    if (wl < SEQ) { P12_LOADH(hf, id0, id1, wl); P12_LOADW(wA, id0); }
#pragma unroll 1
    for (int n = wl; n < SEQ; n += wpg) {
        const int nn = n + wpg; const bool more = nn < SEQ;
        float acc[32];
        if (more) P12_LOADH(hfn, idn0, idn1, nn);
        P12_LOADW(wB, id1);
        __builtin_amdgcn_sched_barrier(0);
        P12_DOTS(wA, hf, 0);
        __builtin_amdgcn_sched_barrier(0);
        if (more) P12_LOADW(wA, idn0);
        __builtin_amdgcn_sched_barrier(0);
        P12_DOTS(wB, hf, 1);
        __builtin_amdgcn_sched_barrier(0);
        float r16[16], r8[8], r4[4], r2[2];
        { const bool t = cc & 8;
#pragma unroll
          for (int k = 0; k < 16; ++k) r16[k] = (t ? acc[k + 16] : acc[k]) + __shfl_xor(t ? acc[k] : acc[k + 16], 8); }
        { const bool t = cc & 4;
#pragma unroll
          for (int k = 0; k < 8; ++k) r8[k] = (t ? r16[k + 8] : r16[k]) + __shfl_xor(t ? r16[k] : r16[k + 8], 4); }
        { const bool t = cc & 2;
#pragma unroll
          for (int k = 0; k < 4; ++k) r4[k] = (t ? r8[k + 4] : r8[k]) + __shfl_xor(t ? r8[k] : r8[k + 4], 2); }
        { const bool t = cc & 1;
#pragma unroll
          for (int k = 0; k < 2; ++k) r2[k] = (t ? r4[k + 2] : r4[k]) + __shfl_xor(t ? r4[k] : r4[k + 2], 1); }
        const int I0 = 2 * (cc & 1) + 4 * ((cc >> 1) & 1) + 8 * ((cc >> 2) & 1) + 16 * (cc >> 3);
        pdx[(size_t)n * 128 + 4 * I0 + rs] = r2[0]; pdx[(size_t)n * 128 + 4 * (I0 + 1) + rs] = r2[1];
#pragma unroll
        for (int i = 0; i < 8; ++i) hf[i] = hfn[i];
        id0 = idn0; id1 = idn1;
    }
#undef P12_LOADH
#undef P12_LOADW
#undef P12_DOTS
}
__device__ __forceinline__ void p12b_weights(const Args& A, Frame& F) {
    const int* idx = (const int*)(F.ws + WS_IDX); const float* gwp = (const float*)(F.ws + WS_GW); const float* pd = (const float*)(F.ws + WS_PD);
    const float* usc = (const float*)(F.ws + WS_USC); const float* vsc = (const float*)(F.ws + WS_VSC); float* wgt = (float*)(F.ws + WS_WGT);
    const int lane = F.lane;
    for (int n = F.gw; n < SEQ; n += F.NGW) {
        const int id0 = idx[(size_t)n * 128 + lane], id1 = idx[(size_t)n * 128 + 64 + lane];
        float d0 = 0.f, d1 = 0.f;
#pragma unroll
        for (int g = 0; g < 8; ++g) { d0 += pd[((size_t)g * SEQ + n) * 128 + lane]; d1 += pd[((size_t)g * SEQ + n) * 128 + 64 + lane]; }
        wgt[(size_t)n * 128 + lane] = gwp[(size_t)n * 128 + lane] * gelu_erf(d0 * usc[id0]) * vsc[id0];
        wgt[(size_t)n * 128 + 64 + lane] = gwp[(size_t)n * 128 + 64 + lane] * gelu_erf(d1 * usc[id1]) * vsc[id1];
    }
}
__device__ __forceinline__ void p13_colsum(const Args& A, Frame& F) {
    typedef float f32x2 __attribute__((ext_vector_type(2)));
    const unsigned char* vb = F.ws + WS_VB; const int* idx = (const int*)(F.ws + WS_IDX); const float* gwp = (const float*)(F.ws + WS_GW);
    const float* wgt = (const float*)(F.ws + WS_WGT);
    float* opre = (float*)(F.ws + WS_OPRE); float* ssp = (float*)(F.ws + WS_SSP);
    const int lane = F.lane, wpg = F.NGW >> 3, x = F.gw / wpg, wl = F.gw - x * wpg, rs = lane >> 4, cc = lane & 15;
    const size_t coff = 256 * x + 16 * cc;
    const unsigned char* vsl = vb + (size_t)x * ((size_t)NEXP * 256) + 16 * cc;
#pragma unroll 1
    for (int n = wl; n < SEQ; n += wpg) {
        const int id0 = idx[(size_t)n * 128 + lane], id1 = idx[(size_t)n * 128 + 64 + lane];
        const float wg0 = wgt[(size_t)n * 128 + lane], wg1 = wgt[(size_t)n * 128 + 64 + lane];
        h2 o2[8];
#pragma unroll
        for (int i = 0; i < 8; ++i) o2[i] = (h2){(_Float16)0.f, (_Float16)0.f};
#pragma unroll
        for (int b = 0; b < 2; ++b) {
            v4u w[16]; h2 wv[16];
#pragma unroll
            for (int i = 0; i < 16; ++i) { const int e = __shfl(b ? id1 : id0, 4 * i + rs); const _Float16 t = (_Float16)(__shfl(b ? wg1 : wg0, 4 * i + rs) * 4096.f); wv[i] = (h2){t, t};
                w[i] = *(const v4u*)(vsl + (size_t)e * 256); }
#pragma unroll
            for (int i = 0; i < 16; ++i) {
#pragma unroll
                for (int e = 0; e < 4; ++e) { const h2 lo = __builtin_amdgcn_cvt_scalef32_pk_f16_fp8((int)w[i][e], 1.0f, false), hi2 = __builtin_amdgcn_cvt_scalef32_pk_f16_fp8((int)w[i][e], 1.0f, true);
                    o2[2 * e] = lo * wv[i] + o2[2 * e]; o2[2 * e + 1] = hi2 * wv[i] + o2[2 * e + 1]; } }
            __builtin_amdgcn_sched_barrier(0);
        }
        float o[16];
#pragma unroll
        for (int i = 0; i < 8; ++i) { o[2 * i] = (float)o2[i][0] * (1.f / 4096.f); o[2 * i + 1] = (float)o2[i][1] * (1.f / 4096.f); }
        float t8[8]; f32x4 t4;
        { const bool t = lane & 32;
#pragma unroll
          for (int k = 0; k < 8; ++k) t8[k] = (t ? o[k + 8] : o[k]) + __shfl_xor(t ? o[k] : o[k + 8], 32); }
        { const bool t = lane & 16;
#pragma unroll
          for (int k = 0; k < 4; ++k) t4[k] = (t ? t8[k + 4] : t8[k]) + __shfl_xor(t ? t8[k] : t8[k + 4], 16); }
        *(f32x4*)(opre + (size_t)n * DM + coff + 8 * (lane >> 5) + 4 * ((lane >> 4) & 1)) = t4;
        const float ss = wave_sum((t4[0] * t4[0] + t4[1] * t4[1]) + (t4[2] * t4[2] + t4[3] * t4[3]));
        if (lane == 0) ssp[(size_t)x * SEQ + n] = ss;
    }
}
__device__ __forceinline__ void p14_final(const Args& A, Frame& F) {
    const float* opre = (const float*)(F.ws + WS_OPRE); const float* ssp = (const float*)(F.ws + WS_SSP);
    int n = F.gw; if (n >= SEQ) return;
    f32x4 gnp[8];
#pragma unroll
    for (int j = 0; j < 8; ++j) { const int col = 4 * F.lane + 256 * j; gnp[j] = mod4(A, F, 0, 5 * DM + col) * *(const f32x4*)(A.in[9] + col); }
    for (; n < SEQ; n += F.NGW) {
        const float ss = wave_sum(F.lane < 8 ? ssp[(size_t)F.lane * SEQ + n] : 0.f);
        const float rstd = rsqrtf(ss * (1.f / DM) + EPS);
        const f32x4* pr = (const f32x4*)(opre + (size_t)n * DM) + F.lane; f32x4* orow = (f32x4*)(F.out + (size_t)n * DM) + F.lane;
        f32x4 p[8], xo[8];
#pragma unroll
        for (int j = 0; j < 8; ++j) { p[j] = pr[64 * j]; xo[j] = orow[64 * j]; }
#pragma unroll
        for (int j = 0; j < 8; ++j) orow[64 * j] = xo[j] + gnp[j] * p[j] * rstd;
    }
}
constexpr int NPH = 16;
constexpr int CW_BAR = 4096;
constexpr int MAX_LAUNCHES = 3;
static_assert((CW_BAR + MAX_LAUNCHES * XCD_BAR_WORDS) * 4 <= (int)CTL_ZERO_BYTES, "barrier words inside the memset region");
__device__ __forceinline__ bool refresh_ids(Frame& F) { int t = threadIdx.x; asm volatile("" : "+v"(t)); F.tid = t; F.lane = t & 63; return true; }
__global__ void __launch_bounds__(NTHR, 2) hybrid_fwd(Args args) {
    extern __shared__ __attribute__((aligned(16))) unsigned char lds[];
    Frame F;
    F.lds = (LAS unsigned char*)lds; F.ldsg = (char*)lds;
    F.tid = threadIdx.x; F.lane = F.tid & 63; F.wave = __builtin_amdgcn_readfirstlane(F.tid >> 6);
    F.G = gridDim.x; { const int bx = blockIdx.x; F.vcu = (F.G % 8 == 0) ? (bx % 8) * (F.G / 8) + bx / 8 : bx; }
    F.gw = F.vcu * NWAVES + F.wave; F.NGW = F.G * NWAVES;
    F.out = args.out; F.ws = args.ws;
    volatile LAS unsigned* MISC = (volatile LAS unsigned*)(F.lds + MISC_OFF);
    for (int u = F.tid; u < 64; u += NTHR) MISC[u] = 0u;
    __syncthreads();
    unsigned* ctl = (unsigned*)(F.ws + WS_CTL);
    XcdBarrier bar = xcd_barrier_post(ctl + CW_BAR + args.li * XCD_BAR_WORDS, MISC + 8);
    const int lo = args.ph_lo, hi = args.ph_hi;
#define IN(k) (lo <= (k) && (k) < hi && refresh_ids(F))
#define SEAM(k) do { if (IN(k) && IN((k) + 1)) xcd_barrier(bar); } while (0)

    if (IN(0)) { p0_prologue(args, F); } SEAM(0);
    if (IN(1)) { p1_rows(args, F); } SEAM(1);
    if (IN(2)) {
        p2_ctx_unit(F);
        pg8::Gemm g{(const bf16*)(F.ws + WS_U), (const bf16*)(F.ws + WS_WIN), SEQ, INCOLS, DM}; pg8::StaticOrder S; S.init(SEQ, INCOLS, F.G, (int)blockIdx.x);
        pg8::EpiSplit1 E{(bf16*)(F.ws + WS_PHY), (long)(WS_QRAW - WS_PHY) / 2, (long)(WS_KRAW - WS_PHY) / 2, (long)(WS_V2 - WS_PHY) / 2, (long)(WS_GATES - WS_PHY) / 2};
        pg8::gemm_phase<pg8::EpiSplit1, pg8::StaticOrder, true, true>(F.lds, g, S, E);
    } SEAM(2);
    if (IN(3)) { p3_post(args, F, F.gw, F.NGW); } SEAM(3);
    if (IN(4)) {
        const int x = F.vcu >> 5, qb = F.vcu & 31;
        if (F.G == 256) {
#pragma unroll 1
            for (int i = 0; i < 2; ++i) { const int hm = 2 * x + i;
                att::attn_unit((const bf16*)(F.ws + WS_Q2) + (size_t)(qb * 256) * 1024 + hm * 64, (const bf16*)(F.ws + WS_K2) + hm * 64,
                               (const bf16*)(F.ws + WS_V2) + (hm >> 1) * 128, (float*)(F.ws + WS_O) + (size_t)(qb * 256) * 2048 + hm * 128, NKEYS, F.ldsg); }
#ifdef ATT_VAR
            { const int hm = 2 * x;
                att::attn_unit<ATT_VAR>((const bf16*)(F.ws + WS_Q2) + (size_t)(qb * 256) * 1024 + hm * 64, (const bf16*)(F.ws + WS_K2) + hm * 64,
                               (const bf16*)(F.ws + WS_V2) + (hm >> 1) * 128, (float*)(F.ws + WS_KSPEC), NKEYS, F.ldsg); }
#endif
        }
    }
    if (IN(5)) {
#pragma unroll 1
        for (int pr = F.vcu; pr < HYW / 2; pr += F.G)
            fftc::conv_pair(F.lds, F.tid, pr, (const float*)(F.ws + WS_TAPF), (const float*)(F.ws + WS_TAPB), (const bf16*)(F.ws + WS_UHT), (bf16*)(F.ws + WS_YCT));
    } SEAM(5);
    if (IN(6)) { p5_finalize(args, F); } SEAM(6);
    if (IN(7)) {
        pg8::StaticOrder S; S.init(SEQ, DM, F.G, (int)blockIdx.x);
        { pg8::Gemm g{(const bf16*)(F.ws + WS_YHY), (const bf16*)(F.ws + WS_WHY), SEQ, DM, HYW};
          pg8::EpiGate<0> E{(bf16*)(F.ws + WS_MB), DM, (const bf16*)(F.ws + WS_GATES), 4096};
          pg8::gemm_phase<pg8::EpiGate<0>, pg8::StaticOrder, true, true>(F.lds, g, S, E); }
        { pg8::Gemm g{(const bf16*)(F.ws + WS_YDA), (const bf16*)(F.ws + WS_WDA), SEQ, DM, HYW};
          pg8::EpiGate<1> E{(bf16*)(F.ws + WS_MB), DM, (const bf16*)(F.ws + WS_GATES) + 2048, 4096};
          pg8::gemm_phase<pg8::EpiGate<1>, pg8::StaticOrder, true, true>(F.lds, g, S, E); }
    } SEAM(7);
    if (IN(8)) {
        pg8::Gemm g{(const bf16*)(F.ws + WS_MB), (const bf16*)(F.ws + WS_WO), SEQ, DM, DM}; pg8::StaticOrder S; S.init(SEQ, DM, F.G, (int)blockIdx.x);
        pg8::EpiF32 E{(float*)(F.ws + WS_MIX), DM};
        pg8::gemm_phase<pg8::EpiF32, pg8::StaticOrder, true, true>(F.lds, g, S, E);
    } SEAM(8);
    if (IN(9)) { p8_rows(args, F); } SEAM(9);
    if (IN(10)) {
        pg8::Gemm g{(const bf16*)(F.ws + WS_HB), (const bf16*)(F.ws + WS_WQ), SEQ, DM, DM}; pg8::StaticOrder S; S.init(SEQ, DM, F.G, (int)blockIdx.x);
        pg8::EpiF32 E{(float*)(F.ws + WS_QP), DM};
        pg8::gemm_phase<pg8::EpiF32, pg8::StaticOrder, true, true>(F.lds, g, S, E);
    } SEAM(10);
    if (IN(11)) {
#pragma unroll 1
        for (int it = F.vcu; it < 256; it += F.G) p11_item(args, F, it);
    } SEAM(11);
    if (IN(12)) { p12_coldots(args, F); } SEAM(12);
    if (IN(13)) { p12b_weights(args, F); } SEAM(13);
    if (IN(14)) { p13_colsum(args, F); } SEAM(14);
    if (IN(15)) { p14_final(args, F); }
#undef IN
#undef SEAM
}

#ifndef PROBE_PH
#define PROBE_PH -1
#endif
extern "C" void kernel_launch(void* const* d_in, const int* in_sizes, int n_in, void* d_out, int out_size, void* d_ws, size_t ws_size, hipStream_t stream) {
    static int grid = 0;
    if (grid == 0) {
        if (n_in != 31 || in_sizes[0] != SEQ * DM || out_size != SEQ * DM || ws_size < WS_END) {
            fprintf(stderr, "kernel_launch: built for 31 inputs, x/out of %d floats, >= %zu bytes of workspace; got n_in %d, in0 %d, out %d, ws %zu; nothing launched\n",
                    SEQ * DM, (size_t)WS_END, n_in, n_in > 0 ? in_sizes[0] : -1, out_size, ws_size); grid = -1; return; }
        int dev = 0, cus = 0, per_cu = 0;
        if (hipGetDevice(&dev) != hipSuccess || hipDeviceGetAttribute(&cus, hipDeviceAttributeMultiprocessorCount, dev) != hipSuccess) { fprintf(stderr, "kernel_launch: device query failed\n"); grid = -1; return; }
        if (hipFuncSetAttribute((const void*)hybrid_fwd, hipFuncAttributeMaxDynamicSharedMemorySize, LDS_BYTES) != hipSuccess) { fprintf(stderr, "kernel_launch: hipFuncSetAttribute failed\n"); grid = -1; return; }
        if (hipOccupancyMaxActiveBlocksPerMultiprocessor(&per_cu, (const void*)hybrid_fwd, NTHR, LDS_BYTES) != hipSuccess || per_cu < 1) {
            fprintf(stderr, "kernel_launch: occupancy query reports %d workgroups per CU; nothing launched\n", per_cu); (void)hipGetLastError(); grid = -1; return; }
        grid = cus;
        if (grid != 256) fprintf(stderr, "kernel_launch: note: %d CUs (tuned for 256)\n", grid);
    }
    if (grid < 0) return;
    if (hipMemsetAsync((char*)d_ws + WS_CTL, 0, CTL_ZERO_BYTES, stream) != hipSuccess) { fprintf(stderr, "kernel_launch: hipMemsetAsync failed\n"); return; }
    Args a{};
    for (int i = 0; i < 31; ++i) a.in[i] = (const float*)d_in[i];
    a.out = (float*)d_out; a.ws = (unsigned char*)d_ws;
    constexpr int NL = (PROBE_PH >= 0) ? 3 : 1;
    const int cut[4] = {0, (PROBE_PH >= 0) ? PROBE_PH + 1 : NPH, (PROBE_PH >= 0) ? PROBE_PH + 1 : NPH, NPH};
    for (int li = 0; li < NL; ++li) {
        a.ph_lo = (li == 1) ? PROBE_PH : cut[li]; a.ph_hi = cut[li + 1]; a.li = li;
        if (a.ph_lo >= a.ph_hi) continue;
        hipLaunchKernelGGL(hybrid_fwd, dim3(grid), dim3(NTHR), LDS_BYTES, stream, a);
        const hipError_t le = hipPeekAtLastError();
        if (le != hipSuccess) { fprintf(stderr, "kernel_launch: launch %d failed: %s\n", li, hipGetErrorName(le)); break; }
    }
}
```

```cpp
#include <hip/hip_runtime.h>
#include <hip/hip_bf16.h>
#include <cstdio>
#include <cstdint>
namespace pg8 {
#define PG8_LAS __attribute__((address_space(3)))
typedef unsigned short bf16_t;
typedef short bf16x8 __attribute__((ext_vector_type(8)));
typedef float f32x4 __attribute__((ext_vector_type(4)));
typedef unsigned u32x4 __attribute__((ext_vector_type(4)));
constexpr int BM = 256, BK = 64, HALF = 128, HTB = HALF * BK * 2  , STAGE_BYTES = 8 * HTB, NXCD = 8, WGM = 8;

__host__ __device__ __forceinline__ int lds_byte(int r, int c) { const int st = (r >> 4) * 2 + (c >> 5), rr = r & 15, cc = c & 31, ob = rr * 64 + cc * 2; return st * 1024 + (ob ^ (((ob >> 9) & 1) << 5)); }
__host__ __device__ __forceinline__ void stage_rc(int b, int& R, int& C) { const int st = b / 1024, sb = b % 1024, swz = sb ^ (((sb >> 9) & 1) << 5); R = (st >> 1) * 16 + swz / 64; C = (st & 1) * 32 + (swz % 64) / 2; }
__host__ __device__ __forceinline__ int perm32(int rho) { const int n = rho >> 4, i = rho & 15; return 8 * (i >> 2) + 4 * n + (i & 3); }

struct Unit { int pm, pn; };
struct Gemm { const bf16_t* A; const bf16_t* Bt; int M, N, K; };

struct StaticOrder {
    int nM, nN, nwg, G, c;
    __host__ __device__ void init(int M, int N, int G_, int c_) { nM = M / BM; nN = N / BM; nwg = nM * nN; G = G_; c = c_; }
    __host__ __device__ bool next(int i, Unit& u) const {
        const long L = (long)i * G + c; if (L >= nwg) return false;
        int wgid = (int)L; { const int q = nwg / NXCD, r = nwg % NXCD, xcd = wgid % NXCD, off = wgid / NXCD; wgid = (xcd < r ? xcd * (q + 1) : r * (q + 1) + (xcd - r) * q) + off; }
        const int nig = WGM * nN, gid = wgid / nig, fm = gid * WGM, gsz = (nM - fm) < WGM ? (nM - fm) : WGM;
        u.pm = fm + ((wgid % nig) % gsz); u.pn = (wgid % nig) / gsz; return true;
    }
    __device__ __forceinline__ void a_ready(const Unit&) const {}
    __device__ __forceinline__ void done(const Unit&) const {}
};

__device__ __forceinline__ unsigned cvt_pk_bf16(float lo, float hi) { unsigned r; asm volatile("v_cvt_pk_bf16_f32 %0, %1, %2" : "=v"(r) : "v"(lo), "v"(hi)); return r; }
typedef float f32x2 __attribute__((ext_vector_type(2)));
__device__ __forceinline__ float bflo(unsigned w) { return __builtin_bit_cast(float, w << 16); }
__device__ __forceinline__ float bfhi(unsigned w) { return __builtin_bit_cast(float, w & 0xffff0000u); }
__device__ __forceinline__ float sigm(float x) { return 1.f / (1.f + __expf(-x)); }
struct EpiSplit1 {
    static constexpr bool PERM = true, AFTER_DRAIN = false;
    bf16_t* phy; long dq, dk, dv, dg;
    __device__ __forceinline__ void operator()(const f32x4 (&acc)[2][2][4][2], const Unit& u, int wr, int wc, int fr, int fq) const {
        const int pn = u.pn; const bool ctx = (u.pm == 32);
        const int s1 = pn >= 12, s2 = pn >= 16, s3 = pn >= 20, s4 = pn >= 24;
        bf16_t* base = phy + (long)s1 * dq + (long)s2 * (dk - dq) + (long)s3 * (dv - dk) + (long)s4 * (dg - dv);
        const int ldc = 3072 - s1 * 2048 + s4 * 3072;
        const int colt = (pn - 12 * s1 - 4 * s2 - 4 * s3 - 4 * s4) * 256;
        const bool lat_only = !(s2 && !s4);
        const int rowoff = (s3 && !s4) ? (ctx ? -8192 : 256) : 0;
        if (ctx && lat_only) return;
        const int row0 = u.pm * BM + wr * 64 + fr + rowoff, col0 = colt + wc * 32 + 8 * fq;
#pragma unroll
        for (int ai = 0; ai < 2; ++ai)
#pragma unroll
            for (int m = 0; m < 4; ++m) { bf16_t* rowp = base + (size_t)(row0 + ai * HALF + m * 16) * ldc + col0;
#pragma unroll
                for (int bj = 0; bj < 2; ++bj) { const f32x4 v0 = acc[ai][bj][m][0], v1 = acc[ai][bj][m][1];
                    u32x4 w; w.x = cvt_pk_bf16(v0[0], v0[1]); w.y = cvt_pk_bf16(v0[2], v0[3]); w.z = cvt_pk_bf16(v1[0], v1[1]); w.w = cvt_pk_bf16(v1[2], v1[3]);
                    *(u32x4*)(rowp + bj * HALF) = w; } }
    }
};
template <int MODE> struct EpiGate {
    static constexpr bool PERM = true, AFTER_DRAIN = false;
    bf16_t* O; int ldc; const bf16_t* G; int ldg;
    __device__ __forceinline__ void operator()(const f32x4 (&acc)[2][2][4][2], const Unit& u, int wr, int wc, int fr, int fq) const {
        const int row0 = u.pm * BM + wr * 64 + fr, col0 = u.pn * BM + wc * 32 + 8 * fq;
#pragma unroll
        for (int ai = 0; ai < 2; ++ai)
#pragma unroll
            for (int m = 0; m < 4; ++m) { const size_t r = (size_t)(row0 + ai * HALF + m * 16);
#pragma unroll
                for (int bj = 0; bj < 2; ++bj) { const f32x4 v0 = acc[ai][bj][m][0], v1 = acc[ai][bj][m][1];
                    const u32x4 g = *(const u32x4*)(G + r * ldg + col0 + bj * HALF);
                    float o[8] = { sigm(bflo(g.x)) * v0[0], sigm(bfhi(g.x)) * v0[1], sigm(bflo(g.y)) * v0[2], sigm(bfhi(g.y)) * v0[3],
                                   sigm(bflo(g.z)) * v1[0], sigm(bfhi(g.z)) * v1[1], sigm(bflo(g.w)) * v1[2], sigm(bfhi(g.w)) * v1[3] };
                    u32x4* op = (u32x4*)(O + r * ldc + col0 + bj * HALF);
                    if (MODE == 1) { const u32x4 p = *op; o[0] += bflo(p.x); o[1] += bfhi(p.x); o[2] += bflo(p.y); o[3] += bfhi(p.y); o[4] += bflo(p.z); o[5] += bfhi(p.z); o[6] += bflo(p.w); o[7] += bfhi(p.w); }
                    u32x4 w; w.x = cvt_pk_bf16(o[0], o[1]); w.y = cvt_pk_bf16(o[2], o[3]); w.z = cvt_pk_bf16(o[4], o[5]); w.w = cvt_pk_bf16(o[6], o[7]);
                    *op = w; } }
    }
};
struct EpiF32 {
    static constexpr bool PERM = true, AFTER_DRAIN = false;
    float* O; int ldc;
    __device__ __forceinline__ void operator()(const f32x4 (&acc)[2][2][4][2], const Unit& u, int wr, int wc, int fr, int fq) const {
        const int row0 = u.pm * BM + wr * 64 + fr, col0 = u.pn * BM + wc * 32 + 8 * fq;
#pragma unroll
        for (int ai = 0; ai < 2; ++ai)
#pragma unroll
            for (int m = 0; m < 4; ++m) { float* rowp = O + (size_t)(row0 + ai * HALF + m * 16) * ldc + col0;
#pragma unroll
                for (int bj = 0; bj < 2; ++bj) { *(f32x4*)(rowp + bj * HALF) = acc[ai][bj][m][0]; *(f32x4*)(rowp + bj * HALF + 4) = acc[ai][bj][m][1]; } }
    }
};
struct EpiBf16 {
    static constexpr bool PERM = true, AFTER_DRAIN = false;
    bf16_t* O; int ldc;
    __device__ __forceinline__ void operator()(const f32x4 (&acc)[2][2][4][2], const Unit& u, int wr, int wc, int fr, int fq) const {
        const int row0 = u.pm * BM + wr * 64 + fr, col0 = u.pn * BM + wc * 32 + 8 * fq;
#pragma unroll
        for (int ai = 0; ai < 2; ++ai)
#pragma unroll
            for (int m = 0; m < 4; ++m) { bf16_t* rowp = O + (size_t)(row0 + ai * HALF + m * 16) * ldc + col0;
#pragma unroll
                for (int bj = 0; bj < 2; ++bj) { const f32x4 v0 = acc[ai][bj][m][0], v1 = acc[ai][bj][m][1];
                    u32x4 w; w.x = cvt_pk_bf16(v0[0], v0[1]); w.y = cvt_pk_bf16(v0[2], v0[3]); w.z = cvt_pk_bf16(v1[0], v1[1]); w.w = cvt_pk_bf16(v1[2], v1[3]);
                    *(u32x4*)(rowp + bj * HALF) = w; } }
    }
};
struct EpiCtxKV {
    static constexpr bool PERM = true, AFTER_DRAIN = false;
    bf16_t* k2; long dv;
    __device__ __forceinline__ void operator()(const f32x4 (&acc)[2][2][4][2], const Unit& u, int wr, int wc, int fr, int fq) const {
        const int isv = u.pn >= 20; bf16_t* base = k2 + (long)isv * dv;
        const int row0 = wr * 64 + fr, col0 = (u.pn - 16 - 4 * isv) * 256 + wc * 32 + 8 * fq;
#pragma unroll
        for (int ai = 0; ai < 2; ++ai)
#pragma unroll
            for (int m = 0; m < 4; ++m) { bf16_t* rowp = base + (size_t)(row0 + ai * HALF + m * 16) * 1024 + col0;
#pragma unroll
                for (int bj = 0; bj < 2; ++bj) { const f32x4 v0 = acc[ai][bj][m][0], v1 = acc[ai][bj][m][1];
                    u32x4 w; w.x = cvt_pk_bf16(v0[0], v0[1]); w.y = cvt_pk_bf16(v0[2], v0[3]); w.z = cvt_pk_bf16(v1[0], v1[1]); w.w = cvt_pk_bf16(v1[2], v1[3]);
                    *(u32x4*)(rowp + bj * HALF) = w; } }
    }
};
struct OneUnit {
    int pm, pn;
    __device__ __forceinline__ bool next(int i, Unit& u) const { if (i) return false; u.pm = pm; u.pn = pn; return true; }
    __device__ __forceinline__ void a_ready(const Unit&) const {}
    __device__ __forceinline__ void done(const Unit&) const {}
};
template <class Epi, class Sched, bool ALIGN_EPI = false, bool SP2 = false>
__device__ __forceinline__ void gemm_phase(PG8_LAS unsigned char* lds, const Gemm g, const Sched& S, const Epi& E) {
    const int tid = threadIdx.x, wid = __builtin_amdgcn_readfirstlane(tid >> 6), lane = tid & 63, wr = wid >> 2, wc = wid & 3, fr = lane & 15, fq = lane >> 4;
    const int K = g.K, nt = K / BK;
    unsigned voffA[2], voffB[2];
#pragma unroll
    for (int i = 0; i < 2; ++i) { int R, C; stage_rc(tid * 16 + i * 8192, R, C); const int Rb = Epi::PERM ? ((R & ~31) + perm32(R & 31)) : R;
        voffA[i] = (unsigned)(R * K + C) * 2u; voffB[i] = (unsigned)(Rb * K + C) * 2u; }
    const size_t kstep = (size_t)(BK * 2);
    const size_t hstep = (size_t)HALF * K * 2;
    const size_t tstep = 2 * hstep;
    const unsigned ldsw = (unsigned)wid * 1024u;
    const int aoff = lds_byte(wr * 64 + fr, fq * 8), boff = lds_byte(wc * 32 + fr, fq * 8);
#define PG8_SA(b, h) (((b) * 2 + (h)) * HTB)
#define PG8_SB(b, h) ((4 + (b) * 2 + (h)) * HTB)
#define PG8_STAGE(bufoff, gbase, voff) do { _Pragma("unroll") for (int _i = 0; _i < 2; ++_i) \
        __builtin_amdgcn_global_load_lds((const unsigned*)((const char*)(gbase) + (voff)[_i]), (PG8_LAS unsigned*)(lds + (bufoff) + ldsw + _i * 8192), 16, 0, 0); } while (0)
#define PG8_LDA(dst, b, h) do { _Pragma("unroll") for (int m = 0; m < 4; ++m) _Pragma("unroll") for (int k = 0; k < 2; ++k) dst[m][k] = *(const PG8_LAS bf16x8*)(lds + PG8_SA(b, h) + aoff + m * 2048 + k * 1024); } while (0)
#define PG8_LDB(dst, b, h) do { _Pragma("unroll") for (int n = 0; n < 2; ++n) _Pragma("unroll") for (int k = 0; k < 2; ++k) dst[n][k] = *(const PG8_LAS bf16x8*)(lds + PG8_SB(b, h) + boff + n * 2048 + k * 1024); } while (0)
#define PG8_MMA(ai, bj, At, Bt) do { __builtin_amdgcn_s_setprio(1); _Pragma("unroll") for (int m = 0; m < 4; ++m) _Pragma("unroll") for (int n = 0; n < 2; ++n) _Pragma("unroll") for (int k = 0; k < 2; ++k) \
        acc[ai][bj][m][n] = __builtin_amdgcn_mfma_f32_16x16x32_bf16(Bt[n][k], At[m][k], acc[ai][bj][m][n], 0, 0, 0); __builtin_amdgcn_s_setprio(0); } while (0)
#define PG8_WAIT_V(n) asm volatile("s_waitcnt vmcnt(" #n ")" ::: "memory")
#define PG8_WAIT_L(n) asm volatile("s_waitcnt lgkmcnt(" #n ")" ::: "memory")
#define PG8_BAR __builtin_amdgcn_s_barrier()
#define PG8_SCHED __builtin_amdgcn_sched_barrier(0)
    Unit cur, nxt; int ui = 0;
    if (!S.next(0, cur)) return;
    f32x4 acc[2][2][4][2];
#pragma unroll
    for (int a = 0; a < 2; ++a)
#pragma unroll
        for (int b = 0; b < 2; ++b)
#pragma unroll
            for (int m = 0; m < 4; ++m)
#pragma unroll
                for (int n = 0; n < 2; ++n) acc[a][b][m][n] = (f32x4){0.f, 0.f, 0.f, 0.f};
    bf16x8 At[4][2], B0[2][2], B1[2][2];
    const char* cA = (const char*)g.A + (size_t)cur.pm * tstep; const char* cB = (const char*)g.Bt + (size_t)cur.pn * tstep;
    S.a_ready(cur);
    if constexpr (SP2) {
        PG8_STAGE(PG8_SB(0, 0), cB, voffB); PG8_STAGE(PG8_SB(0, 1), cB + hstep, voffB); PG8_STAGE(PG8_SA(0, 0), cA, voffA); PG8_STAGE(PG8_SA(0, 1), cA + hstep, voffA);
        if (wr == 1) PG8_BAR;
        PG8_WAIT_V(2); PG8_BAR;
        PG8_STAGE(PG8_SB(1, 0), cB + kstep, voffB); PG8_STAGE(PG8_SA(1, 0), cA + kstep, voffA); PG8_STAGE(PG8_SB(1, 1), cB + hstep + kstep, voffB);
        PG8_WAIT_V(6); PG8_BAR;
    } else {
        PG8_STAGE(PG8_SB(0, 0), cB, voffB); PG8_STAGE(PG8_SA(0, 0), cA, voffA); PG8_STAGE(PG8_SB(0, 1), cB + hstep, voffB); PG8_STAGE(PG8_SA(0, 1), cA + hstep, voffA);
        if (wr == 1) PG8_BAR;
        PG8_WAIT_V(4); PG8_BAR;
        PG8_STAGE(PG8_SB(1, 0), cB + kstep, voffB); PG8_STAGE(PG8_SA(1, 0), cA + kstep, voffA); PG8_STAGE(PG8_SB(1, 1), cB + hstep + kstep, voffB);
        PG8_WAIT_V(6); PG8_BAR;
    }
    for (;;) {
        const bool has_next = S.next(ui + 1, nxt);
        const char* nA = has_next ? (const char*)g.A + (size_t)nxt.pm * tstep : cA; const char* nB = has_next ? (const char*)g.Bt + (size_t)nxt.pn * tstep : cB;
        for (int t = 0; t < nt; t += 2) {
            const bool last = (t == nt - 2);
            const char* a1 = cA + (size_t)(t + 1) * kstep;
            const char* a2 = last ? nA : cA + (size_t)(t + 2) * kstep; const char* b2 = last ? nB : cB + (size_t)(t + 2) * kstep;
            const char* a3 = a2 + kstep; const char* b3 = b2 + kstep;
            if (last && has_next) S.a_ready(nxt);
            if constexpr (SP2) {
            PG8_LDB(B0, 0, 0); PG8_LDB(B1, 0, 1); PG8_SCHED; PG8_LDA(At, 0, 0); PG8_STAGE(PG8_SA(1, 1), a1 + hstep, voffA);
            PG8_WAIT_V(8); PG8_WAIT_L(0); PG8_BAR; PG8_MMA(0, 0, At, B0); PG8_MMA(0, 1, At, B1); PG8_BAR; PG8_SCHED;
            PG8_LDA(At, 0, 1); PG8_STAGE(PG8_SB(0, 0), b2, voffB); PG8_STAGE(PG8_SB(0, 1), b2 + hstep, voffB); PG8_STAGE(PG8_SA(0, 0), a2, voffA);
            PG8_WAIT_V(8); PG8_WAIT_L(0); PG8_BAR; PG8_MMA(1, 0, At, B0); PG8_MMA(1, 1, At, B1); PG8_BAR; PG8_SCHED;
            PG8_LDB(B0, 1, 0); PG8_LDB(B1, 1, 1); PG8_SCHED; PG8_LDA(At, 1, 0); PG8_STAGE(PG8_SA(0, 1), a2 + hstep, voffA);
            PG8_WAIT_V(8); PG8_WAIT_L(0); PG8_BAR; PG8_MMA(0, 0, At, B0); PG8_MMA(0, 1, At, B1); PG8_BAR; PG8_SCHED;
            PG8_LDA(At, 1, 1); PG8_STAGE(PG8_SB(1, 0), b3, voffB); PG8_STAGE(PG8_SB(1, 1), b3 + hstep, voffB); PG8_STAGE(PG8_SA(1, 0), a3, voffA);
            PG8_WAIT_V(8); PG8_WAIT_L(0); PG8_BAR; PG8_MMA(1, 0, At, B0); PG8_MMA(1, 1, At, B1); PG8_BAR; PG8_SCHED;
            } else {
            PG8_LDB(B0, 0, 0); PG8_SCHED; PG8_LDA(At, 0, 0); PG8_STAGE(PG8_SA(1, 1), a1 + hstep, voffA);
            PG8_WAIT_L(8); PG8_BAR; PG8_WAIT_L(0); PG8_MMA(0, 0, At, B0); PG8_BAR; PG8_SCHED;
            PG8_LDB(B1, 0, 1); PG8_STAGE(PG8_SB(0, 0), b2, voffB);
            PG8_BAR; PG8_WAIT_L(0); PG8_MMA(0, 1, At, B1); PG8_BAR;
            PG8_LDA(At, 0, 1); PG8_STAGE(PG8_SA(0, 0), a2, voffA);
            PG8_BAR; PG8_WAIT_L(0); PG8_MMA(1, 0, At, B0); PG8_BAR; PG8_SCHED;
            PG8_STAGE(PG8_SB(0, 1), b2 + hstep, voffB);
            PG8_WAIT_V(6); PG8_BAR; PG8_MMA(1, 1, At, B1); PG8_BAR;
            PG8_LDB(B0, 1, 0); PG8_SCHED; PG8_LDA(At, 1, 0); PG8_STAGE(PG8_SA(0, 1), a2 + hstep, voffA);
            PG8_WAIT_L(8); PG8_BAR; PG8_WAIT_L(0); PG8_MMA(0, 0, At, B0); PG8_BAR; PG8_SCHED;
            PG8_LDB(B1, 1, 1); PG8_STAGE(PG8_SB(1, 0), b3, voffB);
            PG8_BAR; PG8_WAIT_L(0); PG8_MMA(0, 1, At, B1); PG8_BAR;
            PG8_LDA(At, 1, 1); PG8_STAGE(PG8_SA(1, 0), a3, voffA);
            PG8_BAR; PG8_WAIT_L(0); PG8_MMA(1, 0, At, B0); PG8_BAR; PG8_SCHED;
            PG8_STAGE(PG8_SB(1, 1), b3 + hstep, voffB);
            PG8_WAIT_V(6); PG8_BAR; PG8_MMA(1, 1, At, B1); PG8_BAR;
            }
        }
        if constexpr (ALIGN_EPI) { if (wr == 0) PG8_BAR; }
        if constexpr (!Epi::AFTER_DRAIN) { E(acc, cur, wr, wc, fr, fq); S.done(cur); }
        if (!has_next) break;
#pragma unroll
        for (int a = 0; a < 2; ++a)
#pragma unroll
            for (int b = 0; b < 2; ++b)
#pragma unroll
                for (int m = 0; m < 4; ++m)
#pragma unroll
                    for (int n = 0; n < 2; ++n) acc[a][b][m][n] = (f32x4){0.f, 0.f, 0.f, 0.f};
        cur = nxt; cA = nA; cB = nB; ++ui;
        if constexpr (ALIGN_EPI) { if (wr == 1) PG8_BAR; }
    }
    PG8_WAIT_V(0);
    if constexpr (!ALIGN_EPI) { if (wr == 0) PG8_BAR; }
    PG8_BAR;
    if constexpr (Epi::AFTER_DRAIN) { E.fused(acc, cur, wr, wc, fr, fq, lds, wid, lane); S.done(cur); }
#undef PG8_SA
#undef PG8_SB
#undef PG8_STAGE
#undef PG8_LDA
#undef PG8_LDB
#undef PG8_MMA
#undef PG8_WAIT_V
#undef PG8_WAIT_L
#undef PG8_BAR
#undef PG8_SCHED
}
}
namespace att {
using bf16x8 = __attribute__((ext_vector_type(8))) short;
using s16x4  = __attribute__((ext_vector_type(4))) short;
using f32x16 = __attribute__((ext_vector_type(16))) float;
using u32x4  = __attribute__((ext_vector_type(4))) unsigned;
constexpr int DQK = 64, DV = 128, NW = 8, QBLK = 32, KVBLK = 64;
constexpr float SCALE = 0.125f;
constexpr float C2 = 0.125f * 1.4426950408889634f;
constexpr float THR2 = 11.5f;
constexpr int LDQ = 1024, LDK = 1024, LDO = 2048;
constexpr size_t SHM_V = KVBLK * DV * 2, SHM_K = KVBLK * DQK * 2, SHM_ATTN = 3 * SHM_V + 3 * SHM_K + NW * 64 * 4;
#define KSWZ64(row, ch) ((row) * 128 + ((((ch) ^ ((row) >> 1)) & 7) << 4))
#define SBAR() __builtin_amdgcn_sched_barrier(0)
__device__ __forceinline__ int crow(int r, int hi) { return (r & 3) + 8 * (r >> 2) + 4 * hi; }
__device__ __forceinline__ unsigned cvtpk(float lo, float hi) { unsigned r; asm volatile("v_cvt_pk_bf16_f32 %0, %1, %2" : "=v"(r) : "v"(lo), "v"(hi)); return r; }

#define MX3(a, b, c) __builtin_fmaxf(__builtin_fmaxf((a), (b)), (c))
__device__ __forceinline__ float rowmax32(const f32x16& p0, const f32x16& p1) {
  float a = MX3(p0[0], p0[1], p1[0]), b = MX3(p0[2], p0[3], p1[1]); a = MX3(a, p1[2], p1[3]);
#pragma unroll
  for (int r = 4; r < 16; r += 4) { a = MX3(a, p0[r], p0[r + 1]); b = MX3(b, p0[r + 2], p0[r + 3]); a = MX3(a, p1[r], p1[r + 1]); b = MX3(b, p1[r + 2], p1[r + 3]); }
  float m = __builtin_fmaxf(a, b);
  { auto rr = __builtin_amdgcn_permlane32_swap(__float_as_uint(m), __float_as_uint(m), false, false);
    m = __builtin_fmaxf(__uint_as_float(rr[0]), __uint_as_float(rr[1])); }
  return m;
}
template <bool FIRST, int VAR = 0> __device__ __forceinline__ void partialSM(f32x16& p0, f32x16& p1, float& m_ref, f32x16& negm, float& alpha) {
  const float pmax = rowmax32(p0, p1);
  alpha = 1.f;
  if (FIRST || __builtin_expect(__any(pmax > THR2), 0)) {
    const float d = FIRST ? pmax : __builtin_fmaxf(pmax, 0.f);
    m_ref += d;
#pragma unroll
    for (int r = 0; r < 16; ++r) { p0[r] -= d; p1[r] -= d; }
#pragma unroll
    for (int r = 0; r < 16; ++r) negm[r] = -m_ref;
    if (!FIRST) alpha = __builtin_amdgcn_exp2f(-d);
  }
#pragma unroll
  for (int r = 0; r < 16; ++r) p0[r] = (VAR == 1) ? p0[r] * 0.001f : __builtin_amdgcn_exp2f(p0[r]);
}
template <int VAR = 0> __device__ __forceinline__ void finishSM(f32x16& p0, f32x16& p1, bf16x8& pa0, bf16x8& pa1, bf16x8& pa2, bf16x8& pa3) {
#pragma unroll
  for (int r = 0; r < 16; ++r) p1[r] = (VAR == 1) ? p1[r] * 0.001f : __builtin_amdgcn_exp2f(p1[r]);
#define PK4(P, BASE, OUT) do { unsigned a0 = cvtpk(P[BASE + 0], P[BASE + 1]), a1 = cvtpk(P[BASE + 2], P[BASE + 3]);   \
    unsigned b0 = cvtpk(P[BASE + 4], P[BASE + 5]), b1 = cvtpk(P[BASE + 6], P[BASE + 7]);                              \
    auto r0 = __builtin_amdgcn_permlane32_swap(a0, b0, false, false); auto r1 = __builtin_amdgcn_permlane32_swap(a1, b1, false, false); \
    u32x4 w = {r0[0], r1[0], r0[1], r1[1]}; OUT = *reinterpret_cast<bf16x8*>(&w); } while (0)
  PK4(p0, 0, pa0); PK4(p0, 8, pa1); PK4(p1, 0, pa2); PK4(p1, 8, pa3);
#undef PK4
}
__device__ __forceinline__ void qkt(f32x16& p0, f32x16& p1, const char* Ks, const bf16x8* qr, const f32x16& negm, int r32, int hi) {
#pragma unroll
  for (int d0 = 0; d0 < 4; ++d0) { const int ch = d0 * 2 + hi;
    bf16x8 b0 = *reinterpret_cast<const bf16x8*>(Ks + KSWZ64(r32, ch));
    bf16x8 b1 = *reinterpret_cast<const bf16x8*>(Ks + KSWZ64(32 + r32, ch));
    if (d0 == 0) { p0 = __builtin_amdgcn_mfma_f32_32x32x16_bf16(b0, qr[0], negm, 0, 0, 0); p1 = __builtin_amdgcn_mfma_f32_32x32x16_bf16(b1, qr[0], negm, 0, 0, 0); }
    else { p0 = __builtin_amdgcn_mfma_f32_32x32x16_bf16(b0, qr[d0], p0, 0, 0, 0); p1 = __builtin_amdgcn_mfma_f32_32x32x16_bf16(b1, qr[d0], p1, 0, 0, 0); } }
}
__device__ __forceinline__ int v_st(int k, int c) { const int kk = (k & ~0xC) | ((k & 4) << 1) | ((k & 8) >> 1); return ((kk >> 3) * 4 + (c >> 5)) * 512 + ((kk & 7) * 32 + (c & 31)) * 2; }
__device__ __forceinline__ int v_rd_base(int lane) { return ((lane & 3) << 3) | (((lane >> 2) & 3) << 6) | (((lane >> 4) & 1) << 5) | (((lane >> 5) & 1) << 8); }
constexpr int v_rd_off(int d0, int ks, int half) { return d0 * 512 + ks * 4096 + half * 2048; }
template <int OFF> __device__ __forceinline__ s16x4 tr_read(int vb) {
  s16x4 r; asm volatile("ds_read_b64_tr_b16 %0, %1 offset:%2" : "=&v"(r) : "v"(vb), "i"(OFF) : "memory"); return r;
}
template <int D0> __device__ __forceinline__ void pv_one(f32x16& od, int vb, bf16x8 pa0, bf16x8 pa1, bf16x8 pa2, bf16x8 pa3) {
  const s16x4 l0 = tr_read<v_rd_off(D0, 0, 0)>(vb), h0 = tr_read<v_rd_off(D0, 0, 1)>(vb), l1 = tr_read<v_rd_off(D0, 1, 0)>(vb), h1 = tr_read<v_rd_off(D0, 1, 1)>(vb);
  const s16x4 l2 = tr_read<v_rd_off(D0, 2, 0)>(vb), h2 = tr_read<v_rd_off(D0, 2, 1)>(vb), l3 = tr_read<v_rd_off(D0, 3, 0)>(vb), h3 = tr_read<v_rd_off(D0, 3, 1)>(vb);
  asm volatile("s_waitcnt lgkmcnt(0)" ::: "memory"); SBAR();
#define PK(L, H) (bf16x8){L[0], L[1], L[2], L[3], H[0], H[1], H[2], H[3]}
  od = __builtin_amdgcn_mfma_f32_32x32x16_bf16(pa0, PK(l0, h0), od, 0, 0, 0);
  od = __builtin_amdgcn_mfma_f32_32x32x16_bf16(pa1, PK(l1, h1), od, 0, 0, 0);
  od = __builtin_amdgcn_mfma_f32_32x32x16_bf16(pa2, PK(l2, h2), od, 0, 0, 0);
  od = __builtin_amdgcn_mfma_f32_32x32x16_bf16(pa3, PK(l3, h3), od, 0, 0, 0);
#undef PK
}
__device__ __forceinline__ void pv_d0(f32x16* o, f32x16& lsum, int vb, bf16x8 pa0, bf16x8 pa1, bf16x8 pa2, bf16x8 pa3) {
  const bf16x8 ones = {0x3F80, 0x3F80, 0x3F80, 0x3F80, 0x3F80, 0x3F80, 0x3F80, 0x3F80};
  pv_one<0>(o[0], vb, pa0, pa1, pa2, pa3); pv_one<1>(o[1], vb, pa0, pa1, pa2, pa3);
  lsum = __builtin_amdgcn_mfma_f32_32x32x16_bf16(pa0, ones, lsum, 0, 0, 0); lsum = __builtin_amdgcn_mfma_f32_32x32x16_bf16(pa1, ones, lsum, 0, 0, 0);
  pv_one<2>(o[2], vb, pa0, pa1, pa2, pa3); pv_one<3>(o[3], vb, pa0, pa1, pa2, pa3);
  lsum = __builtin_amdgcn_mfma_f32_32x32x16_bf16(pa2, ones, lsum, 0, 0, 0); lsum = __builtin_amdgcn_mfma_f32_32x32x16_bf16(pa3, ones, lsum, 0, 0, 0);
}
template <int VAR = 0> __device__ __forceinline__ void attn_unit(const unsigned short* __restrict__ Qb, const unsigned short* __restrict__ Kh, const unsigned short* __restrict__ Vh,
                                          float* __restrict__ Ob, int seq, char* lds) {
  int tid_ = threadIdx.x; asm volatile("" : "+v"(tid_));
  const int tid = tid_, wid = tid >> 6, lane = tid & 63, r32 = lane & 31, hi = lane >> 5;
  char* V_lds = lds; char* K_lds = lds + 3 * SHM_V;
  float* ws = (float*)(lds + 3 * SHM_V + 3 * SHM_K) + wid * 64; float* al_l = ws + 32;
  float m_ref = 0.f; f32x16 o[4] = {}; f32x16 lsum = {}; f32x16 negm = {}; bf16x8 qr[4];
  const unsigned short* Qw = Qb + (long)(wid * QBLK + r32) * LDQ + hi * 8;
#pragma unroll
  for (int d0 = 0; d0 < 4; ++d0) qr[d0] = *reinterpret_cast<const bf16x8*>(Qw + d0 * 16);
  const int vb0 = (int)(uintptr_t)V_lds + v_rd_base(lane);
  int koff, voff0, voff1;
  { const int row = 8 * wid + (lane >> 3), ch = (lane & 7) ^ ((row >> 1) & 7); koff = row * LDK + ch * 8; }
  { const int blk = 4 * wid + (lane >> 5), kk = (blk >> 2) * 8 + ((lane >> 2) & 7), k = (kk & ~0xC) | ((kk & 4) << 1) | ((kk & 8) >> 1); voff0 = k * LDK + (blk & 3) * 32 + (lane & 3) * 8; }
  { const int blk = 4 * wid + 2 + (lane >> 5), kk = (blk >> 2) * 8 + ((lane >> 2) & 7), k = (kk & ~0xC) | ((kk & 4) << 1) | ((kk & 8) >> 1); voff1 = k * LDK + (blk & 3) * 32 + (lane & 3) * 8; }
  typedef __attribute__((address_space(3))) unsigned ldsu32;
  const unsigned widu = (unsigned)__builtin_amdgcn_readfirstlane(wid);
  const unsigned ldsK = (unsigned)(uintptr_t)K_lds + widu * 1024u, ldsV = (unsigned)(uintptr_t)V_lds + widu * 2048u;
#define SDMA(b, k0) do { if (VAR != 4) { \
    __builtin_amdgcn_global_load_lds((const unsigned*)(Kh + (long)(k0) * LDK + koff), (ldsu32*)(uintptr_t)(ldsK + (b) * (unsigned)SHM_K), 16, 0, 0); \
    __builtin_amdgcn_global_load_lds((const unsigned*)(Vh + (long)(k0) * LDK + voff0), (ldsu32*)(uintptr_t)(ldsV + (b) * (unsigned)SHM_V), 16, 0, 0); \
    __builtin_amdgcn_global_load_lds((const unsigned*)(Vh + (long)(k0) * LDK + voff1), (ldsu32*)(uintptr_t)(ldsV + (b) * (unsigned)SHM_V + 1024u), 16, 0, 0); } } while (0)
#define SWAIT() asm volatile("s_waitcnt vmcnt(0)" ::: "memory")
#define RESC(a) do { if (__any((a) < 1.f)) { if (hi == 0) al_l[r32] = (a); asm volatile("s_waitcnt lgkmcnt(0)" ::: "memory"); \
    _Pragma("unroll") for (int r = 0; r < 16; ++r) { const float f_ = al_l[crow(r, hi)]; o[0][r] *= f_; o[1][r] *= f_; o[2][r] *= f_; o[3][r] *= f_; lsum[r] *= f_; } } } while (0)
  f32x16 pA0, pA1, pB0, pB1; float alA, alB; bf16x8 pa0, pa1, pa2, pa3; const int NT = seq / KVBLK;
  SDMA(0, 0); SWAIT(); __syncthreads();
  if (VAR != 3) qkt(pA0, pA1, K_lds, qr, negm, r32, hi); partialSM<true, VAR>(pA0, pA1, m_ref, negm, alA);
  SDMA(1, KVBLK);
  SWAIT(); __syncthreads();
  int bp = 0, bc = 1, bn = 2;
#define ROT3() do { const int t_ = bp; bp = bc; bc = bn; bn = t_; } while (0)
  for (int j = 1; j + 1 < NT; j += 2) {
    SDMA(bn, (j + 1) * KVBLK);
    SBAR(); if (VAR != 3) qkt(pB0, pB1, K_lds + bc * SHM_K, qr, negm, r32, hi);
    finishSM<VAR>(pA0, pA1, pa0, pa1, pa2, pa3); SBAR();
    if (VAR != 2) pv_d0(o, lsum, vb0 + bp * (int)SHM_V, pa0, pa1, pa2, pa3); partialSM<false, VAR>(pB0, pB1, m_ref, negm, alB);
    RESC(alB); SWAIT(); __syncthreads(); ROT3();
    SDMA(bn, (j + 2) * KVBLK);
    SBAR(); if (VAR != 3) qkt(pA0, pA1, K_lds + bc * SHM_K, qr, negm, r32, hi);
    finishSM<VAR>(pB0, pB1, pa0, pa1, pa2, pa3); SBAR();
    if (VAR != 2) pv_d0(o, lsum, vb0 + bp * (int)SHM_V, pa0, pa1, pa2, pa3); partialSM<false, VAR>(pA0, pA1, m_ref, negm, alA);
    RESC(alA); SWAIT(); __syncthreads(); ROT3();
  }
  SBAR(); if (VAR != 3) qkt(pB0, pB1, K_lds + bc * SHM_K, qr, negm, r32, hi);
  finishSM<VAR>(pA0, pA1, pa0, pa1, pa2, pa3); SBAR();
  if (VAR != 2) pv_d0(o, lsum, vb0 + bp * (int)SHM_V, pa0, pa1, pa2, pa3); partialSM<false, VAR>(pB0, pB1, m_ref, negm, alB);
  RESC(alB);
  finishSM<VAR>(pB0, pB1, pa0, pa1, pa2, pa3); SBAR();
  if (VAR != 2) pv_d0(o, lsum, vb0 + bc * (int)SHM_V, pa0, pa1, pa2, pa3);
#undef ROT3
  float rli[16];
#pragma unroll
  for (int r = 0; r < 16; ++r) rli[r] = __builtin_amdgcn_rcpf(lsum[r]);
  float* Ow = Ob + (long)(wid * QBLK) * LDO;
#pragma unroll
  for (int r = 0; r < 16; ++r) { const int orow = crow(r, hi);
#pragma unroll
    for (int d0 = 0; d0 < 4; ++d0) Ow[(long)orow * LDO + d0 * 32 + r32] = o[d0][r] * rli[r]; }
  __syncthreads();
#undef SDMA
#undef SWAIT
#undef RESC
}
#undef SBAR
#undef MX3
}
constexpr int NWAVES = 8, NTHR = 512;
constexpr int DM = 2048, SEQ = 8192, CTXL = 256, MROWS = SEQ + CTXL  , NKEYS = SEQ + CTXL;
constexpr int HYW = 1024, INCOLS = 10240, NMOD = 6 * DM;
constexpr float EPS = 1e-6f;
constexpr int NEXP = 16384;
constexpr size_t MiB = 1u << 20;
constexpr size_t WS_CTL = 0, CTL_ZERO_BYTES = 64 * 1024;
constexpr size_t WS_MODP = 1 * MiB;
constexpr size_t WS_WIN = 2 * MiB;
constexpr size_t WS_WHY = 42 * MiB, WS_WDA = 46 * MiB;
constexpr size_t WS_WO = 50 * MiB, WS_WQ = 58 * MiB;
constexpr size_t WS_UB = 66 * MiB, WS_VB = 130 * MiB;
constexpr size_t WS_USC = 98 * MiB, WS_VSC = 162 * MiB;
constexpr size_t WS_TAPF = 194 * MiB, WS_TAPB = 226 * MiB;
constexpr size_t WS_MB = 194 * MiB;
constexpr size_t WS_HB = 226 * MiB;
constexpr size_t WS_U = 258 * MiB;
constexpr size_t WS_Q2 = 258 * MiB, WS_K2 = 274 * MiB;
constexpr size_t WS_YHY = 258 * MiB, WS_YDA = 274 * MiB;
constexpr size_t WS_PHY = 291 * MiB;
constexpr size_t WS_QRAW = 339 * MiB;
constexpr size_t WS_KRAW = 355 * MiB + 512 * 1024;
constexpr size_t WS_O = 291 * MiB;
constexpr size_t WS_MIX = 291 * MiB;
constexpr size_t WS_YCT = 355 * MiB + 512 * 1024;
constexpr size_t WS_V2 = 372 * MiB;
constexpr size_t WS_GATES = 388 * MiB + 512 * 1024;
constexpr size_t WS_X0 = 452 * MiB + 512 * 1024;
constexpr size_t WS_UHT = 468 * MiB + 512 * 1024;
constexpr size_t WS_QP = 356 * MiB;
constexpr size_t WS_IDX = 420 * MiB, WS_GW = 424 * MiB;
constexpr size_t WS_PD = 258 * MiB;
constexpr size_t WS_OPRE = 452 * MiB;
constexpr size_t WS_WGT = 432 * MiB;
constexpr size_t WS_SSP = 354 * MiB;
constexpr size_t WS_KSPEC = 485 * MiB;
constexpr size_t WS_UCTX = 520 * MiB;
constexpr size_t WS_END = 522 * MiB;
static_assert(WS_UHT + (size_t)1024 * 8192 * 2 <= WS_KSPEC && WS_KSPEC + (size_t)256 * 8320 * 16 <= WS_END && WS_GW + (size_t)8192 * 128 * 4 <= WS_GATES + 64 * MiB, "ws map");

constexpr int LDS_BYTES = 147456;
constexpr int MISC_OFF = 147456 - 256;

#define GAS __attribute__((address_space(1)))
#define LAS __attribute__((address_space(3)))
typedef unsigned short bf16;
typedef unsigned v4u __attribute__((ext_vector_type(4)));
typedef unsigned v2u __attribute__((ext_vector_type(2)));
typedef float f32x4 __attribute__((ext_vector_type(4)));
typedef GAS unsigned gu32;
#define RLX_AGENT __ATOMIC_RELAXED, __HIP_MEMORY_SCOPE_AGENT
#define LDS_WAIT() asm volatile("s_waitcnt lgkmcnt(0)" ::: "memory")
#define VM_WAIT() asm volatile("s_waitcnt vmcnt(0)" ::: "memory")
__device__ __forceinline__ unsigned f2bf(float f) { unsigned u = __builtin_bit_cast(unsigned, f); return (u + 0x7fffu + ((u >> 16) & 1u)) >> 16; }
__device__ __forceinline__ unsigned pk2(float lo, float hi) { return f2bf(lo) | (f2bf(hi) << 16); }
__device__ __forceinline__ float bf2f(unsigned short b) { return __builtin_bit_cast(float, (unsigned)b << 16); }
__device__ __forceinline__ float blo(unsigned w) { return __builtin_bit_cast(float, w << 16); }
__device__ __forceinline__ float bhi(unsigned w) { return __builtin_bit_cast(float, w & 0xffff0000u); }
__device__ __forceinline__ float fsin(float x) { return __builtin_amdgcn_sinf(x * 0.15915494309189535f); }
__device__ __forceinline__ float fcos(float x) { return __builtin_amdgcn_cosf(x * 0.15915494309189535f); }
__device__ __forceinline__ float wave_sum(float v) {
#pragma unroll
    for (int o = 1; o < 64; o <<= 1) v += __shfl_xor(v, o);
    return v;
}
__device__ __forceinline__ float wave_max(float v) {
#pragma unroll
    for (int o = 1; o < 64; o <<= 1) v = fmaxf(v, __shfl_xor(v, o));
    return v;
}
#define XB_TMO      128
#define XB_XCNT(j)  (256  + 64 * (j))
#define XB_XSUB(j)  (1280 + 64 * (j))
#define XB_XGEN(j)  (2304 + 64 * (j))
#define XB_TOP      3328
#define XB_TOPGEN   3392
#define XCD_BAR_WORDS 3456
#define XB_SPIN_CAP (1u << 24)

__device__ __forceinline__ unsigned xb_ld(unsigned* p)              { return __hip_atomic_load(p, __ATOMIC_RELAXED, __HIP_MEMORY_SCOPE_AGENT); }
__device__ __forceinline__ unsigned xb_add(unsigned* p, unsigned v) { return __hip_atomic_fetch_add(p, v, __ATOMIC_RELAXED, __HIP_MEMORY_SCOPE_AGENT); }
__device__ __forceinline__ unsigned xb_xcc_id() { return (unsigned)__builtin_amdgcn_s_getreg((3 << 11) | 20) & 0xFu; }
#define XB_SPIN(cond, bar) do { unsigned _sp = 0; while (cond) { __builtin_amdgcn_s_sleep(1); \
    if ((++_sp & 255u) == 0u) { if (xb_ld(&(bar)[XB_TMO])) break; if (_sp > XB_SPIN_CAP) { atomicAdd(&(bar)[XB_TMO], 1u); break; } } } } while (0)

struct XcdBarrier {
    unsigned* bar; unsigned x;
    volatile LAS unsigned* st;
};

__device__ __forceinline__ XcdBarrier xcd_barrier_post(unsigned* bar, volatile LAS unsigned* st) {
    XcdBarrier b; b.bar = bar; b.x = xb_xcc_id(); b.st = st;
    if (threadIdx.x == 0) (void)xb_add(&bar[XB_XCNT(b.x)], 1u);
    return b;
}
__device__ __forceinline__ void xcd_barrier_complete(unsigned* bar, unsigned x, unsigned& nloc, unsigned& nx) {
    const unsigned G = gridDim.x * gridDim.y * gridDim.z;
    unsigned sum, cnt, mine, sp = 0u;
    for (;;) {
        sum = 0u; cnt = 0u; mine = 0u;
#pragma unroll
        for (unsigned j = 0; j < 16; ++j) { const unsigned c = xb_ld(&bar[XB_XCNT(j)]); sum += c; cnt += (c > 0u) ? 1u : 0u; mine = (j == x) ? c : mine; }
        if (sum == G) break;
        __builtin_amdgcn_s_sleep(1);
        if ((++sp & 255u) == 0u) { if (xb_ld(&bar[XB_TMO])) break; if (sp > XB_SPIN_CAP) { atomicAdd(&bar[XB_TMO], 1u); break; } }
    }
    nloc = mine > 0u ? mine : 1u; nx = cnt > 0u ? cnt : 1u;
}

__device__ __forceinline__ void xcd_barrier(const XcdBarrier& b) {
    asm volatile("s_waitcnt vmcnt(0)" ::: "memory");
    __syncthreads();
    if (threadIdx.x == 0) {
        unsigned* bar = b.bar;
        __builtin_amdgcn_s_waitcnt(0);
        unsigned nloc = b.st[0], nx = b.st[1];
        if (nloc == 0u) { xcd_barrier_complete(bar, b.x, nloc, nx); b.st[0] = nloc; b.st[1] = nx; }
        const unsigned old = xb_add(&bar[XB_XSUB(b.x)], 1u);
        const unsigned gen = old / nloc;
        if (old + 1u == (gen + 1u) * nloc) {
            __builtin_amdgcn_fence(__ATOMIC_RELEASE, "agent");
            asm volatile("s_waitcnt vmcnt(0)" ::: "memory");
            const unsigned og = xb_add(&bar[XB_TOP], 1u);
            const unsigned tg = og / nx;
            if (og + 1u == (tg + 1u) * nx) xb_add(&bar[XB_TOPGEN], 1u);
            else XB_SPIN(xb_ld(&bar[XB_TOPGEN]) == tg, bar);
            __builtin_amdgcn_fence(__ATOMIC_ACQUIRE, "agent");
            xb_add(&bar[XB_XGEN(b.x)], 1u);
            asm volatile("s_waitcnt vmcnt(0)" ::: "memory");
        } else {
            XB_SPIN(xb_ld(&bar[XB_XGEN(b.x)]) == gen, bar);
            __builtin_amdgcn_fence(__ATOMIC_ACQUIRE, "agent");
            asm volatile("s_waitcnt vmcnt(0)" ::: "memory");
        }
    }
    __syncthreads();
}

struct XcdTok { unsigned role, val; };
__device__ __forceinline__ XcdTok xcd_arrive(const XcdBarrier& b) {
    asm volatile("s_waitcnt vmcnt(0)" ::: "memory");
    __syncthreads();
    XcdTok t; t.role = 0u; t.val = 0u;
    if (threadIdx.x == 0) {
        unsigned* bar = b.bar;
        __builtin_amdgcn_s_waitcnt(0);
        unsigned nloc = b.st[0], nx = b.st[1];
        if (nloc == 0u) { xcd_barrier_complete(bar, b.x, nloc, nx); b.st[0] = nloc; b.st[1] = nx; }
        const unsigned old = xb_add(&bar[XB_XSUB(b.x)], 1u);
        const unsigned gen = old / nloc;
        if (old + 1u == (gen + 1u) * nloc) {
            __builtin_amdgcn_fence(__ATOMIC_RELEASE, "agent");
            asm volatile("s_waitcnt vmcnt(0)" ::: "memory");
            const unsigned og = xb_add(&bar[XB_TOP], 1u);
            const unsigned tg = og / nx;
            if (og + 1u == (tg + 1u) * nx) { xb_add(&bar[XB_TOPGEN], 1u); t.role = 2u; }
            else { t.role = 1u; t.val = tg; }
        } else { t.role = 0u; t.val = gen; }
    }
    return t;
}
__device__ __forceinline__ void xcd_wait(const XcdBarrier& b, const XcdTok& t) {
    if (threadIdx.x == 0) {
        unsigned* bar = b.bar;
        if (t.role != 0u) {
            if (t.role == 1u) XB_SPIN(xb_ld(&bar[XB_TOPGEN]) == t.val, bar);
            __builtin_amdgcn_fence(__ATOMIC_ACQUIRE, "agent");
            xb_add(&bar[XB_XGEN(b.x)], 1u);
            asm volatile("s_waitcnt vmcnt(0)" ::: "memory");
        } else {
            XB_SPIN(xb_ld(&bar[XB_XGEN(b.x)]) == t.val, bar);
            __builtin_amdgcn_fence(__ATOMIC_ACQUIRE, "agent");
            asm volatile("s_waitcnt vmcnt(0)" ::: "memory");
        }
    }
    __syncthreads();
}
struct Args { const float* in[31]; float* out; unsigned char* ws; int ph_lo, ph_hi, li, pad; };
struct Frame {
    LAS unsigned char* lds; char* ldsg;
    int tid, lane, wave, vcu, G, gw, NGW;
    float* out; unsigned char* ws;
};
__device__ __forceinline__ const float* modp(const Frame& F) { return (const float*)(F.ws + WS_MODP); }
__device__ __forceinline__ f32x4 mod4(const Args& A, const Frame& F, int which, int i) {
    const float* p = modp(F) + which * NMOD + i; f32x4 v = *(const f32x4*)(A.in[5] + i);
#pragma unroll
    for (int kc = 0; kc < 4; ++kc) v += *(const f32x4*)(p + kc * 2 * NMOD);
    return v;
}
__device__ __forceinline__ float silu(float x) { return x / (1.f + __expf(-x)); }

__device__ __forceinline__ void p0_transpose_pair(const float* Wa, bf16* WTa, int ita, const float* Wb, bf16* WTb, int itb, int K, int N, bool two, LAS float* scr, int lane) {
    const int kka = lane >> 3, nl = (lane & 7) * 4, nb = N / 32;
    const int k0a = 64 * (ita / nb), n0a = 32 * (ita % nb), k0b = 64 * (itb / nb), n0b = 32 * (itb % nb);
    f32x4 va[8], vb_[8];
#pragma unroll
    for (int i = 0; i < 8; ++i) va[i] = *(const f32x4*)(Wa + (size_t)(k0a + 8 * i + kka) * N + n0a + nl);
    if (two) {
#pragma unroll
        for (int i = 0; i < 8; ++i) vb_[i] = *(const f32x4*)(Wb + (size_t)(k0b + 8 * i + kka) * N + n0b + nl); }
#pragma unroll
    for (int i = 0; i < 8; ++i) { LAS float* s = scr + (8 * i + kka) * 33 + nl; s[0] = va[i][0]; s[1] = va[i][1]; s[2] = va[i][2]; s[3] = va[i][3]; }
    if (two) {
#pragma unroll
        for (int i = 0; i < 8; ++i) { LAS float* s = scr + 2176 + (8 * i + kka) * 33 + nl; s[0] = vb_[i][0]; s[1] = vb_[i][1]; s[2] = vb_[i][2]; s[3] = vb_[i][3]; } }
    LDS_WAIT(); asm volatile("" ::: "memory");
    const int c = lane & 7;
#pragma unroll
    for (int j = 0; j < 4; ++j) { const int n = (lane >> 3) + 8 * j; const LAS float* s = scr + (8 * c) * 33 + n;
        v4u o; o.x = pk2(s[0 * 33], s[1 * 33]); o.y = pk2(s[2 * 33], s[3 * 33]); o.z = pk2(s[4 * 33], s[5 * 33]); o.w = pk2(s[6 * 33], s[7 * 33]);
        *(GAS v4u*)(WTa + (size_t)(n0a + n) * K + k0a + 8 * c) = o; }
    if (two) {
#pragma unroll
        for (int j = 0; j < 4; ++j) { const int n = (lane >> 3) + 8 * j; const LAS float* s = scr + 2176 + (8 * c) * 33 + n;
            v4u o; o.x = pk2(s[0 * 33], s[1 * 33]); o.y = pk2(s[2 * 33], s[3 * 33]); o.z = pk2(s[4 * 33], s[5 * 33]); o.w = pk2(s[6 * 33], s[7 * 33]);
            *(GAS v4u*)(WTb + (size_t)(n0b + n) * K + k0b + 8 * c) = o; } }
    LDS_WAIT(); asm volatile("" ::: "memory");
}
__device__ __forceinline__ void p0_filter_item(const Args& A, Frame& F, int pb) {
    LAS float* zb = (LAS float*)F.lds;
    LAS float* hA = zb + 64 * 36;
    LAS float* hB = hA + 64 * 68;
    LAS float* tl = hB + 64 * 68 + F.wave * (64 * 33);
    const int l0 = pb * 64, tid = F.tid;
    const float* w1 = A.in[13]; const float* b1 = A.in[14]; const float* w2 = A.in[15]; const float* b2 = A.in[16];
    const float* w3 = A.in[17]; const float* b3 = A.in[18]; const float* wout = A.in[19]; const float* freq = A.in[20];
    for (int idx = tid; idx < 64 * 33; idx += NTHR) { const int pos = idx / 33, f = idx % 33; const int l = l0 + pos;
        const float w = 6.283185307179586f * (float)l / 8192.f; float v;
        if (f == 0) v = (float)l / 8191.f;
        else { const int j = (f - 1) & 15; const float band = 1e-4f + (float)j * ((15.f - 1e-4f) / 15.f); const float a = band * w; v = (f <= 16) ? fcos(a) : -fsin(a); }
        zb[pos * 36 + f] = v; }
    __syncthreads();
    const int j = tid & 63, pg = tid >> 6;
    { float acc[8]; const float bj = b1[j], fj = freq[j];
#pragma unroll
      for (int i = 0; i < 8; ++i) acc[i] = bj;
      for (int k = 0; k < 33; ++k) { const float w = w1[k * 64 + j];
#pragma unroll
        for (int i = 0; i < 8; ++i) acc[i] += zb[(pg * 8 + i) * 36 + k] * w; }
#pragma unroll
      for (int i = 0; i < 8; ++i) hA[(pg * 8 + i) * 68 + j] = fsin(fj * acc[i]); }
    __syncthreads();
    { float acc[8]; const float bj = b2[j], fj = freq[j];
#pragma unroll
      for (int i = 0; i < 8; ++i) acc[i] = bj;
      for (int k = 0; k < 64; ++k) { const float w = w2[k * 64 + j];
#pragma unroll
        for (int i = 0; i < 8; ++i) acc[i] += hA[(pg * 8 + i) * 68 + k] * w; }
#pragma unroll
      for (int i = 0; i < 8; ++i) hB[(pg * 8 + i) * 68 + j] = fsin(fj * acc[i]); }
    __syncthreads();
    { float acc[8]; const float bj = b3[j], fj = freq[j];
#pragma unroll
      for (int i = 0; i < 8; ++i) acc[i] = bj;
      for (int k = 0; k < 64; ++k) { const float w = w3[k * 64 + j];
#pragma unroll
        for (int i = 0; i < 8; ++i) acc[i] += hB[(pg * 8 + i) * 68 + k] * w; }
      __syncthreads();
#pragma unroll
      for (int i = 0; i < 8; ++i) { const float v = fsin(fj * acc[i]); const unsigned hb_ = f2bf(v);
          LAS unsigned short* hp = (LAS unsigned short*)((LAS unsigned char*)hA + (pg * 8 + i) * 144) + j;
          hp[0] = (unsigned short)hb_; hp[4608] = (unsigned short)f2bf(v - __builtin_bit_cast(float, hb_ << 16)); } }
    __syncthreads();
    typedef short s16x8 __attribute__((ext_vector_type(8))); typedef float f32x16 __attribute__((ext_vector_type(16)));
    const int lane = F.lane, r32 = lane & 31, hi = lane >> 5;
    bf16* tapF = (bf16*)(F.ws + WS_TAPF); bf16* tapB = (bf16*)(F.ws + WS_TAPB);
    const LAS unsigned char* Hh = (const LAS unsigned char*)hA;
#pragma unroll 1
    for (int nb = 0; nb < 8; ++nb) {
        const int c0 = F.wave * 256 + nb * 32, col = c0 + r32, chan = col & 1023;
        s16x8 bh[4], bl[4];
#pragma unroll
        for (int s = 0; s < 4; ++s) { float x[8];
#pragma unroll
            for (int e = 0; e < 8; ++e) x[e] = wout[(size_t)(16 * s + 8 * hi + e) * 2048 + col];
            unsigned hw[4], lw[4];
#pragma unroll
            for (int e = 0; e < 4; ++e) { const unsigned h0 = f2bf(x[2 * e]), h1 = f2bf(x[2 * e + 1]); hw[e] = h0 | (h1 << 16);
                lw[e] = pk2(x[2 * e] - __builtin_bit_cast(float, h0 << 16), x[2 * e + 1] - __builtin_bit_cast(float, h1 << 16)); }
            const v4u hv = {hw[0], hw[1], hw[2], hw[3]}, lv = {lw[0], lw[1], lw[2], lw[3]};
            bh[s] = __builtin_bit_cast(s16x8, hv); bl[s] = __builtin_bit_cast(s16x8, lv); }
        const float delta = fabsf(-3.0701134573253945f + (-15.350567286626973f + 3.0701134573253945f) * ((float)chan / 1023.f));
#pragma unroll
        for (int mb = 0; mb < 2; ++mb) { f32x16 acc = {};
#pragma unroll
            for (int s = 0; s < 4; ++s) { const LAS unsigned char* ap = Hh + (32 * mb + r32) * 144 + (2 * s + hi) * 16;
                const s16x8 ah = *(const LAS s16x8*)ap, al = *(const LAS s16x8*)(ap + 9216);
                acc = __builtin_amdgcn_mfma_f32_32x32x16_bf16(al, bh[s], acc, 0, 0, 0);
                acc = __builtin_amdgcn_mfma_f32_32x32x16_bf16(ah, bl[s], acc, 0, 0, 0);
                acc = __builtin_amdgcn_mfma_f32_32x32x16_bf16(ah, bh[s], acc, 0, 0, 0); }
#pragma unroll
            for (int r = 0; r < 16; ++r) { const int pos = 32 * mb + (r & 3) + 8 * (r >> 2) + 4 * hi; const float t = (float)(l0 + pos) / 8191.f;
                tl[r32 * 65 + pos] = acc[r] * (__expf(-t * delta) + 0.05f); } }
        LDS_WAIT(); asm volatile("" ::: "memory");
        bf16* dst = (c0 < 1024) ? tapF : tapB;
#pragma unroll 4
        for (int c = 0; c < 16; ++c) { const int cl = 2 * c + hi;
            *(unsigned*)(dst + (size_t)((c0 + cl) & 1023) * 8192 + l0 + 2 * r32) = pk2(tl[cl * 65 + 2 * r32], tl[cl * 65 + 2 * r32 + 1]); }
        LDS_WAIT(); asm volatile("" ::: "memory");
    }
    __syncthreads();
}
#ifdef P0_MASK
#define P0REP(s) _Pragma("unroll 1") for (int rep_ = 0; rep_ <= ((P0_MASK >> (s)) & 1); ++rep_)
#define P3REP(s) _Pragma("unroll 1") for (int rep3_ = 0; rep3_ <= ((P0_MASK >> (s)) & 1); ++rep3_)
#else
#define P0REP(s)
#define P3REP(s)
#endif
__device__ __forceinline__ unsigned tab_pack4(const f32x4 t, bool as_i8) {
    if (as_i8) { const int a = (int)__builtin_rintf(t[0]), b = (int)__builtin_rintf(t[1]), c = (int)__builtin_rintf(t[2]), d = (int)__builtin_rintf(t[3]);
        return (unsigned)(a & 255) | ((unsigned)(b & 255) << 8) | ((unsigned)(c & 255) << 16) | ((unsigned)d << 24); }
    int w = 0; w = __builtin_amdgcn_cvt_pk_fp8_f32(t[0], t[1], w, false); w = __builtin_amdgcn_cvt_pk_fp8_f32(t[2], t[3], w, true); return (unsigned)w;
}
__device__ __forceinline__ void p0_prologue(const Args& A, Frame& F) {
    P0REP(0) if ((int)blockIdx.x < 128) p0_filter_item(A, F, (int)blockIdx.x);
    P0REP(1) { const float* wm = A.in[4]; const float* c = A.in[1]; const float* cc = A.in[3]; float* mp = (float*)(F.ws + WS_MODP);
      LAS float* sl = (LAS float*)F.lds;
      for (int k = F.tid; k < DM; k += NTHR) { sl[k] = silu(c[k]); sl[DM + k] = silu(cc[k]); }
      __syncthreads();
      const int cl = F.lane & 7, rl = F.lane >> 3;
      for (int it = F.gw; it < 384 * 4; it += F.NGW) { const int cg = it % 384, kc = it / 384;
          f32x4 al = {0.f, 0.f, 0.f, 0.f}, ac = {0.f, 0.f, 0.f, 0.f};
#pragma unroll
          for (int h = 0; h < 2; ++h) { f32x4 w[32];
#pragma unroll
              for (int i = 0; i < 32; ++i) w[i] = *(const f32x4*)(wm + (size_t)(kc * 512 + rl + 8 * (32 * h + i)) * NMOD + cg * 32 + cl * 4);
#pragma unroll
              for (int i = 0; i < 32; ++i) { const int k = kc * 512 + rl + 8 * (32 * h + i); al += w[i] * sl[k]; ac += w[i] * sl[DM + k]; } }
#pragma unroll
          for (int o = 8; o < 64; o <<= 1) {
#pragma unroll
              for (int e = 0; e < 4; ++e) { al[e] += __shfl_xor(al[e], o); ac[e] += __shfl_xor(ac[e], o); } }
          if (rl == 0) { *(f32x4*)(mp + (kc * 2 + 0) * NMOD + cg * 32 + cl * 4) = al; *(f32x4*)(mp + (kc * 2 + 1) * NMOD + cg * 32 + cl * 4) = ac; } }
      __syncthreads(); }
}
__device__ __forceinline__ void p0_prologue_b(const Args& A, Frame& F) {
    P0REP(2) { LAS float* scr = (LAS float*)(F.lds + F.wave * 17408);
      constexpr int I_IN = (DM / 64) * (INCOLS / 32), I_HY = (HYW / 64) * (DM / 32), I_O = (DM / 64) * (DM / 32);
      for (int it = F.gw; it < I_IN; it += 2 * F.NGW) { const bool two = it + F.NGW < I_IN;
          p0_transpose_pair(A.in[10], (bf16*)(F.ws + WS_WIN), it, A.in[10], (bf16*)(F.ws + WS_WIN), two ? it + F.NGW : it, DM, INCOLS, two, scr, F.lane); }
      for (int it = F.gw; it < I_O; it += F.NGW)
          p0_transpose_pair(A.in[26], (bf16*)(F.ws + WS_WO), it, A.in[27], (bf16*)(F.ws + WS_WQ), it, DM, DM, true, scr, F.lane);
      for (int it = F.gw; it < 2 * I_HY; it += F.NGW) { const bool da = it >= I_HY; const int r = da ? it - I_HY : it;
          const float* W = da ? A.in[25] : A.in[24]; bf16* WT = (bf16*)(F.ws + (da ? WS_WDA : WS_WHY));
          p0_transpose_pair(W, WT, r, W, WT, r, HYW, DM, false, scr, F.lane); } }
    P0REP(3) {
      const int bx = (int)blockIdx.x; const bool bal = (F.G == 256);
      const int rbase = bal ? (bx < 128 ? bx * 120 : 15360 + (bx - 128) * 136) : 0, rcnt = bal ? (bx < 128 ? 120 : 136) : 2 * NEXP;
      const int rstart = bal ? F.wave : F.gw, rstep = bal ? NWAVES : F.NGW;
      for (int ri = rstart; ri < rcnt; ri += 2 * rstep) {
          const int rowa = rbase + ri, rowb = (ri + rstep < rcnt) ? rowa + rstep : rowa; const bool two = rowb != rowa;
          const bool ua = rowa < NEXP, ub_ = rowb < NEXP; const int ra = ua ? rowa : rowa - NEXP, rb = ub_ ? rowb : rowb - NEXP;
          const float* sa = (ua ? A.in[29] : A.in[30]) + (size_t)ra * DM + 16 * F.lane; const float* sb = (ub_ ? A.in[29] : A.in[30]) + (size_t)rb * DM + 16 * F.lane;
          f32x4 xa[8], xb[8];
#pragma unroll
          for (int i = 0; i < 8; ++i) xa[i] = *(const f32x4*)(sa + 1024 * (i >> 2) + 4 * (i & 3));
#pragma unroll
          for (int i = 0; i < 8; ++i) xb[i] = *(const f32x4*)(sb + 1024 * (i >> 2) + 4 * (i & 3));
          float ma = 0.f, mb = 0.f;
#pragma unroll
          for (int i = 0; i < 8; ++i) { ma = fmaxf(ma, fmaxf(fmaxf(fabsf(xa[i][0]), fabsf(xa[i][1])), fmaxf(fabsf(xa[i][2]), fabsf(xa[i][3]))));
              mb = fmaxf(mb, fmaxf(fmaxf(fabsf(xb[i][0]), fabsf(xb[i][1])), fmaxf(fabsf(xb[i][2]), fabsf(xb[i][3])))); }
#pragma unroll
          for (int o = 1; o < 64; o <<= 1) { ma = fmaxf(ma, __shfl_xor(ma, o)); mb = fmaxf(mb, __shfl_xor(mb, o)); }
          const float sca = (ma > 0.f) ? 127.f / ma : 1.f, scb = (mb > 0.f) ? 127.f / mb : 1.f;
          unsigned char* da = F.ws + (ua ? WS_UB : WS_VB) + (size_t)(F.lane >> 4) * ((size_t)NEXP * 256) + (size_t)ra * 256 + 16 * (F.lane & 15);
          unsigned char* db = F.ws + (ub_ ? WS_UB : WS_VB) + (size_t)(F.lane >> 4) * ((size_t)NEXP * 256) + (size_t)rb * 256 + 16 * (F.lane & 15);
#pragma unroll
          for (int q = 0; q < 2; ++q) { v4u o;
#pragma unroll
              for (int e = 0; e < 4; ++e) o[e] = tab_pack4(xa[4 * q + e] * sca, true);
              *(v4u*)(da + (size_t)(4 * q) * ((size_t)NEXP * 256)) = o; }
          if (F.lane == 0) ((float*)(F.ws + (ua ? WS_USC : WS_VSC)))[ra] = 1.f / sca;
          if (two) {
#pragma unroll
              for (int q = 0; q < 2; ++q) { v4u o;
#pragma unroll
                  for (int e = 0; e < 4; ++e) o[e] = tab_pack4(xb[4 * q + e] * scb, true);
                  *(v4u*)(db + (size_t)(4 * q) * ((size_t)NEXP * 256)) = o; }
              if (F.lane == 0) ((float*)(F.ws + (ub_ ? WS_USC : WS_VSC)))[rb] = 1.f / scb; } } }

}

__device__ __forceinline__ void p1_cv(const Args& A, Frame& F) {
    const float* gn = A.in[6]; LAS f32x4* cv = (LAS f32x4*)F.lds;
    const int col = 4 * F.tid; const f32x4 g = *(const f32x4*)(gn + col);
#pragma unroll
    for (int w = 0; w < 2; ++w) { cv[(2 * w) * 512 + F.tid] = g * (mod4(A, F, w, 1 * DM + col) + 1.f); cv[(2 * w + 1) * 512 + F.tid] = mod4(A, F, w, 0 * DM + col); }
}
__device__ __forceinline__ void p1_rows(const Args& A, Frame& F) {
    bf16* U = (bf16*)(F.ws + WS_U);
    LAS f32x4* cv = (LAS f32x4*)F.lds;
#pragma unroll 1
    for (int which = 0; which < 2; ++which) {
        const int r0 = which ? SEQ : 0, r1 = which ? MROWS : SEQ; const float* src = which ? A.in[2] : A.in[0];
        int r = r0 + F.gw; if (r >= r1) continue;
        f32x4 a[8], b[8];
#pragma unroll
        for (int j = 0; j < 8; ++j) { a[j] = cv[(2 * which) * 512 + F.lane + 64 * j]; b[j] = cv[(2 * which + 1) * 512 + F.lane + 64 * j]; }
        for (; r < r1; r += F.NGW) {
            const f32x4* xr = (const f32x4*)(src + (size_t)(r - r0) * DM) + F.lane; f32x4 v[8]; float s = 0.f;
#pragma unroll
            for (int j = 0; j < 8; ++j) { v[j] = xr[64 * j]; s += (v[j][0] * v[j][0] + v[j][1] * v[j][1]) + (v[j][2] * v[j][2] + v[j][3] * v[j][3]); }
            const float rstd = rsqrtf(wave_sum(s) * (1.f / DM) + EPS);
            unsigned long long* o8 = (unsigned long long*)(U + (size_t)r * DM) + F.lane;
#pragma unroll
            for (int j = 0; j < 8; ++j) { const f32x4 y = v[j] * rstd * a[j] + b[j];
                o8[64 * j] = (unsigned long long)pk2(y[0], y[1]) | ((unsigned long long)pk2(y[2], y[3]) << 32); }
        }
    }
}

__device__ __forceinline__ void p2_ctx_unit(Frame& F) {
    typedef short s16x8 __attribute__((ext_vector_type(8))); typedef float f32x16 __attribute__((ext_vector_type(16)));
    const bf16* U = (const bf16*)(F.ws + WS_U) + (size_t)SEQ * DM; const bf16* W = (const bf16*)(F.ws + WS_WIN);
    LAS float* part = (LAS float*)F.lds;
#pragma unroll 1
    for (int unit = F.vcu; unit < 256; unit += F.G) {
        const int rb = unit >> 5, cb = unit & 31, l31 = F.lane & 31, hi = F.lane >> 5, k0 = 256 * F.wave + 8 * hi;
        const bf16* ap = U + (size_t)(32 * rb + l31) * DM + k0;
        const bf16* bp0 = W + (size_t)(4096 + 64 * cb + l31) * DM + k0; const bf16* bp1 = bp0 + (size_t)32 * DM;
        f32x16 c0, c1;
#pragma unroll
        for (int r = 0; r < 16; ++r) { c0[r] = 0.f; c1[r] = 0.f; }
#pragma unroll
        for (int h = 0; h < 2; ++h) { s16x8 a[8], b0[8], b1[8];
#pragma unroll
            for (int s = 0; s < 8; ++s) { const int ko = 16 * (8 * h + s); a[s] = *(const s16x8*)(ap + ko); b0[s] = *(const s16x8*)(bp0 + ko); b1[s] = *(const s16x8*)(bp1 + ko); }
#pragma unroll
            for (int s = 0; s < 8; ++s) { c0 = __builtin_amdgcn_mfma_f32_32x32x16_bf16(a[s], b0[s], c0, 0, 0, 0); c1 = __builtin_amdgcn_mfma_f32_32x32x16_bf16(a[s], b1[s], c1, 0, 0, 0); } }
#pragma unroll
        for (int r = 0; r < 16; ++r) { const int row = (r & 3) + 8 * (r >> 2) + 4 * hi; part[F.wave * 2048 + row * 64 + l31] = c0[r]; part[F.wave * 2048 + row * 64 + 32 + l31] = c1[r]; }
        __syncthreads();
        { const int row = F.tid >> 4, c4 = 4 * (F.tid & 15); f32x4 s = {0.f, 0.f, 0.f, 0.f};
#pragma unroll
          for (int w = 0; w < 8; ++w) s += *(const LAS f32x4*)(part + w * 2048 + row * 64 + c4);
          bf16* dst = (bf16*)(F.ws + (cb < 16 ? WS_KRAW + (size_t)SEQ * 1024 * 2 : WS_V2)) + (size_t)(32 * rb + row) * 1024 + 64 * (cb & 15) + c4;
          *(unsigned long long*)dst = (unsigned long long)pk2(s[0], s[1]) | ((unsigned long long)pk2(s[2], s[3]) << 32); }
        __syncthreads();
    }
}

__device__ __forceinline__ void p3_post(const Args& A, Frame& F, const int gw, const int NGW) {
    const bf16* qraw = (const bf16*)(F.ws + WS_QRAW); const bf16* kraw = (const bf16*)(F.ws + WS_KRAW);
    bf16* q2 = (bf16*)(F.ws + WS_Q2); bf16* k2 = (bf16*)(F.ws + WS_K2);
    P3REP(4) { const int hm = F.lane >> 2, ax = (F.lane >> 1) & 1, jh = F.lane & 1; const int e0 = hm * 64 + 32 * ax + 8 * jh;
      float inv[8];
#pragma unroll
      for (int j = 0; j < 8; ++j) inv[j] = __builtin_amdgcn_exp2f(-(float)(8 * jh + j) * (13.287712379549449f / 16.f));
      for (int t = gw; t < SEQ; t += NGW) {
          const float pos = (float)(ax ? (t & 63) : (t >> 6));
          float cs[8], sn[8];
#pragma unroll
          for (int j = 0; j < 8; ++j) { const float a = pos * inv[j]; cs[j] = fcos(a); sn[j] = fsin(a); }
#pragma unroll
          for (int w = 0; w < 2; ++w) {
              const bf16* src = (w ? kraw : qraw) + (size_t)t * 1024 + e0; bf16* dst = (w ? k2 + (size_t)(CTXL + t) * 1024 : q2 + (size_t)t * 1024) + e0;
              const v4u x1 = *(const v4u*)src, x2 = *(const v4u*)(src + 16);
              float a1[8] = { blo(x1.x), bhi(x1.x), blo(x1.y), bhi(x1.y), blo(x1.z), bhi(x1.z), blo(x1.w), bhi(x1.w) };
              float a2[8] = { blo(x2.x), bhi(x2.x), blo(x2.y), bhi(x2.y), blo(x2.z), bhi(x2.z), blo(x2.w), bhi(x2.w) };
              float o1[8], o2[8];
              const float qs = w ? 1.f : att::C2;
#pragma unroll
              for (int j = 0; j < 8; ++j) { o1[j] = (a1[j] * cs[j] - a2[j] * sn[j]) * qs; o2[j] = (a2[j] * cs[j] + a1[j] * sn[j]) * qs; }
              v4u w1, w2; w1.x = pk2(o1[0], o1[1]); w1.y = pk2(o1[2], o1[3]); w1.z = pk2(o1[4], o1[5]); w1.w = pk2(o1[6], o1[7]);
              w2.x = pk2(o2[0], o2[1]); w2.y = pk2(o2[2], o2[3]); w2.z = pk2(o2[4], o2[5]); w2.w = pk2(o2[6], o2[7]);
              *(v4u*)dst = w1; *(v4u*)(dst + 16) = w2; }
      }
      for (int i = gw * 64 + F.lane; i < CTXL * 1024 / 8; i += NGW * 64) *((v4u*)k2 + i) = *((const v4u*)(kraw + (size_t)SEQ * 1024) + i);
    }
    P3REP(5) { const bf16* phy = (const bf16*)(F.ws + WS_PHY); const float* cw = A.in[11]; const float* cb = A.in[12];
      bf16* x0o = (bf16*)(F.ws + WS_X0); bf16* uht = (bf16*)(F.ws + WS_UHT);
      LAS unsigned char* tile = F.lds;
#pragma unroll 1
      for (int it = F.vcu; it < 256; it += F.G) { int ln = F.lane; asm volatile("" : "+v"(ln));
          const int t0 = (it >> 1) * 64, cbase = (it & 1) * 512, c = cbase + 8 * ln, tw = t0 + 8 * F.wave;
#pragma unroll 1
          for (int pass = 0; pass < 2; ++pass) {
              const int ns = pass ? 1 : 2, sb = pass ? 2 : 0;
              f32x4 wt[2][3][2], bs[2][2];
#pragma unroll
              for (int s = 0; s < 2; ++s) if (s < ns) { const int col = (sb + s) * 1024 + c;
#pragma unroll
                  for (int k = 0; k < 3; ++k) { wt[s][k][0] = *(const f32x4*)(cw + k * 3072 + col); wt[s][k][1] = *(const f32x4*)(cw + k * 3072 + col + 4); }
                  bs[s][0] = *(const f32x4*)(cb + col); bs[s][1] = *(const f32x4*)(cb + col + 4); }
              v4u row[2][10];
#pragma unroll
              for (int s = 0; s < 2; ++s) if (s < ns) {
#pragma unroll
                  for (int r = 0; r < 10; ++r) { const int t = tw - 1 + r;
                      row[s][r] = (t >= 0 && t < SEQ) ? *(const v4u*)(phy + (size_t)t * 3072 + (sb + s) * 1024 + c) : (v4u){0u, 0u, 0u, 0u}; } }
#pragma unroll
              for (int tt = 0; tt < 8; ++tt) { float z[2][8];
#pragma unroll
                  for (int s = 0; s < 2; ++s) if (s < ns) {
#pragma unroll
                      for (int h = 0; h < 4; ++h) { const unsigned a = row[s][tt][h], m = row[s][tt + 1][h], n = row[s][tt + 2][h]; const int q = h >> 1, e = 2 * (h & 1);
                          z[s][2 * h]     = blo(a) * wt[s][0][q][e]     + blo(m) * wt[s][1][q][e]     + blo(n) * wt[s][2][q][e]     + bs[s][q][e];
                          z[s][2 * h + 1] = bhi(a) * wt[s][0][q][e + 1] + bhi(m) * wt[s][1][q][e + 1] + bhi(n) * wt[s][2][q][e + 1] + bs[s][q][e + 1]; } }
                  if (pass == 0) { const int tl = 8 * F.wave + tt;
                      LAS unsigned short* tp = (LAS unsigned short*)(tile + (size_t)(8 * ln) * 128 + ((((tl >> 3) ^ ln) & 7) << 4) + 2 * (tl & 7));
#pragma unroll
                      for (int e = 0; e < 8; ++e) tp[e * 64] = (unsigned short)f2bf(z[0][e] * z[1][e]);
                  } else { v4u o; o.x = pk2(z[0][0], z[0][1]); o.y = pk2(z[0][2], z[0][3]); o.z = pk2(z[0][4], z[0][5]); o.w = pk2(z[0][6], z[0][7]);
                      *(v4u*)(x0o + (size_t)(tw + tt) * 1024 + c) = o; } }
          }
          __syncthreads();
          { const int csub = ln >> 3, piece = ln & 7;
#pragma unroll
            for (int i = 0; i < 8; ++i) { const int cl = 64 * F.wave + 8 * i + csub;
                const v4u v = *(const LAS v4u*)(tile + (size_t)cl * 128 + (((piece ^ (cl >> 3)) & 7) << 4));
                *(v4u*)(uht + (size_t)(cbase + cl) * SEQ + t0 + 8 * piece) = v; } }
          __syncthreads();
      } }
}

__device__ __forceinline__ void p4_conv_channel(Frame& F, int c) {
    LAS float* T = (LAS float*)F.lds;
    LAS float* uh = T + 16384;
    const float* tapF = (const float*)(F.ws + WS_TAPF) + (size_t)c * 8192; const float* tapB = (const float*)(F.ws + WS_TAPB) + (size_t)c * 8192;
    const bf16* uht = (const bf16*)(F.ws + WS_UHT) + (size_t)c * 8192;
    for (int i = F.tid; i < 8192; i += NTHR) { T[8192 + i] = tapF[i]; T[8192 - i] = (i == 0) ? tapF[0] : tapB[i]; uh[i] = bf2f(uht[i]); }
    if (F.tid == 0) T[0] = 0.f;
    __syncthreads();
    float acc[16];
#pragma unroll
    for (int i = 0; i < 16; ++i) acc[i] = 0.f;
    const int tid = F.tid;
    for (int S = 0; S < 512; ++S) {
        const int base = 16 * (tid - S) + 8192 - 16;
        float W[32], u[16];
#pragma unroll
        for (int q = 0; q < 32; q += 4) { const f32x4 w4 = *(const LAS f32x4*)(T + base + q); W[q] = w4[0]; W[q + 1] = w4[1]; W[q + 2] = w4[2]; W[q + 3] = w4[3]; }
#pragma unroll
        for (int q = 0; q < 16; q += 4) { const f32x4 u4 = *(const LAS f32x4*)(uh + 16 * S + q); u[q] = u4[0]; u[q + 1] = u4[1]; u[q + 2] = u4[2]; u[q + 3] = u4[3]; }
#pragma unroll
        for (int j = 0; j < 16; ++j)
#pragma unroll
            for (int i = 0; i < 16; ++i) acc[i] += W[16 + i - j] * u[j];
    }
    bf16* yo = (bf16*)(F.ws + WS_YCT) + (size_t)c * 8192 + 16 * tid;
    v4u o0, o1; o0.x = pk2(acc[0], acc[1]); o0.y = pk2(acc[2], acc[3]); o0.z = pk2(acc[4], acc[5]); o0.w = pk2(acc[6], acc[7]);
    o1.x = pk2(acc[8], acc[9]); o1.y = pk2(acc[10], acc[11]); o1.z = pk2(acc[12], acc[13]); o1.w = pk2(acc[14], acc[15]);
    *(v4u*)yo = o0; *(v4u*)(yo + 8) = o1;
    __syncthreads();
}
namespace fftc {
constexpr int N = 16384, LH = 8192, KSTR = 8320;
typedef float c32 __attribute__((ext_vector_type(2)));
__device__ __forceinline__ int rev4(int k) {
    unsigned r = __brev((unsigned)k) >> 18; return (int)(((r & 0x2AAAu) >> 1) | ((r & 0x1555u) << 1));
}
__device__ __forceinline__ int sw(int e) { const int t = e >> 4; return e ^ ((t & 3) * 5) ^ ((t & 4) << 2); }
__device__ __forceinline__ int rev4b(int m) { const unsigned r = __brev((unsigned)m) >> 24; return (int)(((r & 0xAAu) >> 1) | ((r & 0x55u) << 1)); }
__device__ __forceinline__ c32 cmul(c32 a, c32 b) { return (c32){a.x * b.x - a.y * b.y, a.x * b.y + a.y * b.x}; }
__device__ __forceinline__ c32 cadd(c32 a, c32 b) { c32 r; asm("v_pk_add_f32 %0, %1, %2" : "=v"(r) : "v"(a), "v"(b)); return r; }
__device__ __forceinline__ c32 csub(c32 a, c32 b) { c32 r; asm("v_pk_add_f32 %0, %1, %2 neg_lo:[0,1] neg_hi:[0,1]" : "=v"(r) : "v"(a), "v"(b)); return r; }
__device__ __forceinline__ c32 csubi(c32 a, c32 b) { c32 r; asm("v_pk_add_f32 %0, %1, %2 op_sel:[0,1] op_sel_hi:[1,0] neg_hi:[0,1]" : "=v"(r) : "v"(a), "v"(b)); return r; }
__device__ __forceinline__ c32 caddi(c32 a, c32 b) { c32 r; asm("v_pk_add_f32 %0, %1, %2 op_sel:[0,1] op_sel_hi:[1,0] neg_lo:[0,1]" : "=v"(r) : "v"(a), "v"(b)); return r; }
__device__ __forceinline__ c32 cmulw(c32 a, c32 w, c32 wr) { c32 t, r;
    asm("v_pk_mul_f32 %0, %1, %2 op_sel_hi:[0,1]" : "=v"(t) : "v"(a), "v"(w));
    asm("v_pk_fma_f32 %0, %1, %2, %3 op_sel:[1,0,0] op_sel_hi:[1,1,1]" : "=v"(r) : "v"(a), "v"(wr), "v"(t)); return r; }
struct Tw { c32 w1, r1, w2, r2, w3, r3; };
template <bool INV> __device__ __forceinline__ Tw make_tw(float ang) {
    float c, s; Tw t;
    asm("s_nop 1\n\tv_cos_f32 %0, %2\n\tv_sin_f32 %1, %2\n\ts_nop 1" : "=&v"(c), "=&v"(s) : "v"(ang));
    t.w1 = INV ? (c32){c, s} : (c32){c, -s}; t.r1 = INV ? (c32){-s, c} : (c32){s, c};
    t.w2 = cmulw(t.w1, t.w1, t.r1); t.r2 = cmulw(t.r1, t.w1, t.r1); t.w3 = cmulw(t.w2, t.w1, t.r1); t.r3 = cmulw(t.r2, t.w1, t.r1); return t;
}
template <bool INV, bool TW> __device__ __forceinline__ void bfly(c32& a0, c32& a1, c32& a2, c32& a3, const Tw& t) {
    if (INV) {
        if (TW) { a1 = cmulw(a1, t.w1, t.r1); a2 = cmulw(a2, t.w2, t.r2); a3 = cmulw(a3, t.w3, t.r3); }
        const c32 s0 = cadd(a0, a2), s1 = csub(a0, a2), s2 = cadd(a1, a3), s3 = csub(a1, a3);
        a0 = cadd(s0, s2); a2 = csub(s0, s2); a1 = caddi(s1, s3); a3 = csubi(s1, s3);
    } else {
        const c32 t0 = cadd(a0, a2), t1 = csub(a0, a2), t2 = cadd(a1, a3), t3 = csub(a1, a3);
        a0 = cadd(t0, t2); a2 = csub(t0, t2); a1 = csubi(t1, t3); a3 = caddi(t1, t3);
        if (TW) { a1 = cmulw(a1, t.w1, t.r1); a2 = cmulw(a2, t.w2, t.r2); a3 = cmulw(a3, t.w3, t.r3); }
    }
}
template <int S, bool INV> __device__ __forceinline__ void stage(LAS c32* x, int tid) {
    constexpr int L = N >> (2 * S), q = L / 4;
    asm volatile("" : "+v"(tid));
    if constexpr (q >= 512) {
        LAS c32* xs = x + sw(tid); constexpr int R = q / 512;
#pragma unroll
        for (int i = 0; i < 8; ++i) { const int off = (i / R) * L + 512 * (i % R);
            c32 a0 = xs[off], a1 = xs[off + q], a2 = xs[off + 2 * q], a3 = xs[off + 3 * q];
            const Tw t = make_tw<INV>((float)(tid + 512 * (i % R)) * (1.f / (float)L));
            bfly<INV, true>(a0, a1, a2, a3, t);
            xs[off] = a0; xs[off + q] = a1; xs[off + 2 * q] = a2; xs[off + 3 * q] = a3; }
    } else {
        const int j = tid & (q - 1), base = (tid / q) * L + j;
        LAS c32* p0 = x + sw(base); LAS c32* p1 = x + sw(base + q); LAS c32* p2 = x + sw(base + 2 * q); LAS c32* p3 = x + sw(base + 3 * q);
        Tw t; if constexpr (q > 1) t = make_tw<INV>((float)j * (1.f / (float)L));
#pragma unroll
        for (int i = 0; i < 8; ++i) { c32 a0 = p0[2048 * i], a1 = p1[2048 * i], a2 = p2[2048 * i], a3 = p3[2048 * i];
            bfly<INV, (q > 1)>(a0, a1, a2, a3, t);
            p0[2048 * i] = a0; p1[2048 * i] = a1; p2[2048 * i] = a2; p3[2048 * i] = a3; }
    }
    __syncthreads();
}
template <int S> __device__ __forceinline__ void fwd_stage(LAS c32* x, int tid) { stage<S, false>(x, tid); }
template <int S> __device__ __forceinline__ void inv_stage(LAS c32* x, int tid) { stage<S, true>(x, tid); }
__device__ __forceinline__ void fwd_all(LAS c32* x, int tid) { fwd_stage<0>(x, tid); fwd_stage<1>(x, tid); fwd_stage<2>(x, tid); fwd_stage<3>(x, tid); fwd_stage<4>(x, tid); fwd_stage<5>(x, tid); fwd_stage<6>(x, tid); }
__device__ __forceinline__ void inv_all(LAS c32* x, int tid) { inv_stage<6>(x, tid); inv_stage<5>(x, tid); inv_stage<4>(x, tid); inv_stage<3>(x, tid); inv_stage<2>(x, tid); inv_stage<1>(x, tid); inv_stage<0>(x, tid); }
__device__ __forceinline__ void conv_pair(LAS unsigned char* lds, int tid, int pr, const unsigned short* tapF, const unsigned short* tapB, const unsigned short* uht, unsigned short* yct) {
    LAS c32* x = (LAS c32*)lds;
    const size_t o1 = (size_t)(2 * pr) * LH, o2 = o1 + LH;
#pragma unroll 1
    for (int h = 0; h < 2; ++h) { typedef unsigned u32x2 __attribute__((ext_vector_type(2))); u32x2 f1[2], f2[2], b1[2], b2[2];
#pragma unroll
      for (int i = 0; i < 2; ++i) { const int n = 4 * (tid + 512 * (2 * h + i)); f1[i] = *(const u32x2*)(tapF + o1 + n); f2[i] = *(const u32x2*)(tapF + o2 + n); b1[i] = *(const u32x2*)(tapB + o1 + n); b2[i] = *(const u32x2*)(tapB + o2 + n); }
#pragma unroll
      for (int i = 0; i < 2; ++i) {
#pragma unroll
          for (int e = 0; e < 4; ++e) { const int n = 4 * (tid + 512 * (2 * h + i)) + e; const bool z = (n == 0);
              const float tf1 = (e & 1) ? bhi(f1[i][e >> 1]) : blo(f1[i][e >> 1]), tf2 = (e & 1) ? bhi(f2[i][e >> 1]) : blo(f2[i][e >> 1]);
              const float tb1 = (e & 1) ? bhi(b1[i][e >> 1]) : blo(b1[i][e >> 1]), tb2 = (e & 1) ? bhi(b2[i][e >> 1]) : blo(b2[i][e >> 1]);
              x[sw(n)] = (c32){tf1, tf2}; x[sw(z ? LH : N - n)] = z ? (c32){0.f, 0.f} : (c32){tb1, tb2}; } } }
    __syncthreads();
    fwd_all(x, tid);
    const int lane = tid & 63, wv = tid >> 6, khi = ((lane & 3) << 4) | (lane & 12) | (lane >> 4);
    f32x4 Kr[17];
#pragma unroll
    for (int it = 0; it < 17; ++it) { const int m = wv + 8 * it;
        const bool act = (it == 16) ? (wv == 0 && khi < 32) : ((it == 0 && wv == 0) ? (khi <= 32) : true);
        const int kp = (N - (256 * khi + m)) & (N - 1);
        const int pk = sw((rev4b(m) << 6) | lane), pkp = sw(rev4(kp));
        Kr[it] = (f32x4){0.f, 0.f, 0.f, 0.f};
        if (act) { const c32 A = x[pk], Bq = x[pkp]; const c32 B = (c32){Bq.x, -Bq.y};
            const c32 sm = A + B, df = A - B; constexpr float h = 0.5f / (float)N;
            Kr[it] = (f32x4){sm.x * h, sm.y * h, df.y * h, -df.x * h}; } }
    __syncthreads();
    { v2u u1[4], u2[4];
#pragma unroll
      for (int i = 0; i < 4; ++i) { const int n = 4 * (tid + 512 * i); u1[i] = *(const v2u*)(uht + o1 + n); u2[i] = *(const v2u*)(uht + o2 + n); }
#pragma unroll
      for (int i = 0; i < 4; ++i) { const int n = 4 * (tid + 512 * i);
          x[sw(n)] = (c32){blo(u1[i].x), blo(u2[i].x)}; x[sw(n + 1)] = (c32){bhi(u1[i].x), bhi(u2[i].x)}; x[sw(n + 2)] = (c32){blo(u1[i].y), blo(u2[i].y)}; x[sw(n + 3)] = (c32){bhi(u1[i].y), bhi(u2[i].y)};
#pragma unroll
          for (int e = 0; e < 4; ++e) x[sw(LH + n + e)] = (c32){0.f, 0.f}; } }
    __syncthreads();
    fwd_all(x, tid);
#pragma unroll
    for (int it = 0; it < 17; ++it) { const int m = wv + 8 * it;
        const bool act = (it == 16) ? (wv == 0 && khi < 32) : ((it == 0 && wv == 0) ? (khi <= 32) : true);
        const int kp = (N - (256 * khi + m)) & (N - 1);
        const int pk = sw((rev4b(m) << 6) | lane), pkp = sw(rev4(kp));
        if (act) { const c32 A = x[pk], Bq = x[pkp]; const c32 B = (c32){Bq.x, -Bq.y};
            const c32 sm = A + B, df = A - B; const c32 U1 = sm * 0.5f, U2 = (c32){df.y * 0.5f, -df.x * 0.5f};
            const f32x4 K = Kr[it];
            const c32 Y1 = cmul(U1, (c32){K[0], K[1]}), Y2 = cmul(U2, (c32){K[2], K[3]});
            x[pkp] = (c32){Y1.x + Y2.y, Y2.x - Y1.y};
            x[pk]  = (c32){Y1.x - Y2.y, Y1.y + Y2.x}; } }
    __syncthreads();
    inv_all(x, tid);
#pragma unroll
    for (int i = 0; i < 4; ++i) { const int n = 4 * (tid + 512 * i); const c32 v0 = x[sw(n)], v1 = x[sw(n + 1)], v2 = x[sw(n + 2)], v3 = x[sw(n + 3)];
        *(v2u*)(yct + o1 + n) = (v2u){pk2(v0.x, v1.x), pk2(v2.x, v3.x)}; *(v2u*)(yct + o2 + n) = (v2u){pk2(v0.y, v1.y), pk2(v2.y, v3.y)}; }
    __syncthreads();
}
}
__device__ __forceinline__ float da_lambda(const Args& A, const Frame& F) {
    const float* lp = A.in[22]; const int l = F.lane;
    const float sa = wave_sum(lp[l] * lp[64 + l]), sb = wave_sum(lp[128 + l] * lp[192 + l]);
    return __expf(sa) - __expf(sb) + 0.2f;
}
__device__ __forceinline__ void p5_finalize(const Args& A, Frame& F) {
    { const float lam = da_lambda(A, F); const float* O = (const float*)(F.ws + WS_O); bf16* yda = (bf16*)(F.ws + WS_YDA); const float* sub = A.in[23];
      const int head = F.lane >> 3, e0 = (F.lane & 7) * 16;
      float sl[16];
#pragma unroll
      for (int i = 0; i < 16; ++i) sl[i] = sub[e0 + i] * 0.8f;
      for (int t = F.gw; t < SEQ; t += F.NGW) {
          const float* o0 = O + (size_t)t * 2048 + (2 * head) * 128 + e0; const float* o1 = o0 + 128;
          float y[16]; float ss = 0.f;
#pragma unroll
          for (int q = 0; q < 4; ++q) { const f32x4 a = *(const f32x4*)(o0 + 4 * q), b = *(const f32x4*)(o1 + 4 * q);
#pragma unroll
              for (int e = 0; e < 4; ++e) { const float v = a[e] - lam * b[e]; y[4 * q + e] = v; ss += v * v; } }
          ss += __shfl_xor(ss, 1); ss += __shfl_xor(ss, 2); ss += __shfl_xor(ss, 4);
          const float rstd = rsqrtf(ss * (1.f / 128.f) + EPS);
          v4u w0, w1; w0.x = pk2(y[0] * rstd * sl[0], y[1] * rstd * sl[1]); w0.y = pk2(y[2] * rstd * sl[2], y[3] * rstd * sl[3]);
          w0.z = pk2(y[4] * rstd * sl[4], y[5] * rstd * sl[5]); w0.w = pk2(y[6] * rstd * sl[6], y[7] * rstd * sl[7]);
          w1.x = pk2(y[8] * rstd * sl[8], y[9] * rstd * sl[9]); w1.y = pk2(y[10] * rstd * sl[10], y[11] * rstd * sl[11]);
          w1.z = pk2(y[12] * rstd * sl[12], y[13] * rstd * sl[13]); w1.w = pk2(y[14] * rstd * sl[14], y[15] * rstd * sl[15]);
          bf16* dst = yda + (size_t)t * 1024 + head * 128 + e0; *(v4u*)dst = w0; *(v4u*)(dst + 8) = w1; } }
    { const bf16* yct = (const bf16*)(F.ws + WS_YCT); const bf16* uht = (const bf16*)(F.ws + WS_UHT); const bf16* x0 = (const bf16*)(F.ws + WS_X0);
      bf16* yhy = (bf16*)(F.ws + WS_YHY); const float* bias = A.in[21];
      LAS unsigned char* tile = F.lds;
#pragma unroll 1
      for (int it = F.vcu; it < 256; it += F.G) { int ln = F.lane; asm volatile("" : "+v"(ln));
          const int t0 = (it >> 1) * 64, cbase = (it & 1) * 512, csub = ln >> 3, piece = ln & 7;
          v4u yv[8], uv[8]; float bv[8];
#pragma unroll
          for (int i = 0; i < 8; ++i) { const int cl = 64 * F.wave + 8 * i + csub; const size_t o = (size_t)(cbase + cl) * SEQ + t0 + 8 * piece;
              yv[i] = *(const v4u*)(yct + o); uv[i] = *(const v4u*)(uht + o); bv[i] = bias[cbase + cl]; }
#pragma unroll
          for (int i = 0; i < 8; ++i) { const int cl = 64 * F.wave + 8 * i + csub;
              LAS unsigned short* tp = (LAS unsigned short*)(tile + (size_t)(8 * piece) * 1024 + ((((cl >> 3) ^ piece) & 63) << 4) + 2 * (cl & 7));
#pragma unroll
              for (int h = 0; h < 4; ++h) { tp[(2 * h) * 512] = (unsigned short)f2bf(blo(yv[i][h]) + blo(uv[i][h]) * bv[i]); tp[(2 * h + 1) * 512] = (unsigned short)f2bf(bhi(yv[i][h]) + bhi(uv[i][h]) * bv[i]); } }
          __syncthreads();
          v4u xv[8];
#pragma unroll
          for (int tt = 0; tt < 8; ++tt) xv[tt] = *(const v4u*)(x0 + (size_t)(t0 + 8 * F.wave + tt) * 1024 + cbase + 8 * ln);
#pragma unroll
          for (int tt = 0; tt < 8; ++tt) { const int tl = 8 * F.wave + tt;
              const v4u m = *(const LAS v4u*)(tile + (size_t)tl * 1024 + (((ln ^ (tl >> 3)) & 63) << 4)); v4u o;
#pragma unroll
              for (int h = 0; h < 4; ++h) o[h] = pk2(blo(xv[tt][h]) * blo(m[h]), bhi(xv[tt][h]) * bhi(m[h]));
              *(v4u*)(yhy + (size_t)(t0 + tl) * 1024 + cbase + 8 * ln) = o; }
          __syncthreads();
      } }
}

__device__ __forceinline__ void p8_cv(const Args& A, Frame& F) {
    LAS f32x4* cv = (LAS f32x4*)F.lds; const int col = 4 * F.tid;
    cv[F.tid] = mod4(A, F, 0, 2 * DM + col) * *(const f32x4*)(A.in[7] + col);
    cv[512 + F.tid] = *(const f32x4*)(A.in[8] + col) * (mod4(A, F, 0, 4 * DM + col) + 1.f); cv[1024 + F.tid] = mod4(A, F, 0, 3 * DM + col);
}
__device__ __forceinline__ void p8_rows(const Args& A, Frame& F) {
    const bf16* mix = (const bf16*)(F.ws + WS_MIX); bf16* hb = (bf16*)(F.ws + WS_HB);
    LAS f32x4* cv = (LAS f32x4*)F.lds;
    int r = F.gw;
    f32x4 ga[8], a2[8], b2[8];
#pragma unroll
    for (int j = 0; j < 8; ++j) { ga[j] = cv[F.lane + 64 * j]; a2[j] = cv[512 + F.lane + 64 * j]; b2[j] = cv[1024 + F.lane + 64 * j]; }
    for (; r < SEQ; r += F.NGW) {
        const unsigned long long* mr = (const unsigned long long*)(mix + (size_t)r * DM) + F.lane; const f32x4* xr = (const f32x4*)(A.in[0] + (size_t)r * DM) + F.lane;
        f32x4 v[8], xv[8]; float s = 0.f;
#pragma unroll
        for (int j = 0; j < 8; ++j) { const unsigned long long m8 = mr[64 * j]; const unsigned m0 = (unsigned)m8, m1 = (unsigned)(m8 >> 32);
            v[j][0] = blo(m0); v[j][1] = bhi(m0); v[j][2] = blo(m1); v[j][3] = bhi(m1); xv[j] = xr[64 * j]; }
#pragma unroll
        for (int j = 0; j < 8; ++j) s += (v[j][0] * v[j][0] + v[j][1] * v[j][1]) + (v[j][2] * v[j][2] + v[j][3] * v[j][3]);
        const float rstd = rsqrtf(wave_sum(s) * (1.f / DM) + EPS); float s2 = 0.f;
#pragma unroll
        for (int j = 0; j < 8; ++j) { v[j] = xv[j] + v[j] * rstd * ga[j];
            s2 += (v[j][0] * v[j][0] + v[j][1] * v[j][1]) + (v[j][2] * v[j][2] + v[j][3] * v[j][3]); }
        const float rstd2 = rsqrtf(wave_sum(s2) * (1.f / DM) + EPS);
        unsigned long long* o8 = (unsigned long long*)(hb + (size_t)r * DM) + F.lane;
#pragma unroll
        for (int j = 0; j < 8; ++j) { const f32x4 y = v[j] * rstd2 * a2[j] + b2[j];
            o8[64 * j] = (unsigned long long)pk2(y[0], y[1]) | ((unsigned long long)pk2(y[2], y[3]) << 32); }
    }
}

typedef float f32x16 __attribute__((ext_vector_type(16)));
#define TK_CS(A, B) do { const float hi_ = __builtin_fmaxf(v[A], v[B]), lo_ = __builtin_fminf(v[A], v[B]); v[A] = hi_; v[B] = lo_; } while (0)
__device__ __forceinline__ float tk_tag(float x, unsigned mask, unsigned id) { return __uint_as_float((__float_as_uint(x) & ~mask) | id); }
__device__ __forceinline__ void tk_sort16(float (&v)[16]) {
#pragma unroll
    for (int k = 2; k <= 16; k <<= 1)
#pragma unroll
        for (int j = k >> 1; j >= 1; j >>= 1)
#pragma unroll
            for (int i = 0; i < 16; ++i) { const int l = i ^ j; if (l > i) { if ((i & k) == 0) TK_CS(i, l); else TK_CS(l, i); } }
}
__device__ __forceinline__ void tk_merge16(float (&v)[16], const float (&o)[16]) {
#pragma unroll
    for (int t = 0; t < 16; ++t) v[t] = __builtin_fmaxf(v[t], o[15 - t]);
#pragma unroll
    for (int st = 8; st >= 1; st >>= 1)
#pragma unroll
        for (int t = 0; t < 16; ++t) if ((t & st) == 0) TK_CS(t, t + st);
}
__device__ __forceinline__ void p11_keys(const Args& A, Frame& F, int h) {
    typedef short s16x8 __attribute__((ext_vector_type(8)));
    LAS unsigned char* KH = F.lds;
    const float* keys = A.in[28];
    for (int i = F.tid; i < 2 * 128 * 16; i += NTHR) { const int ch = i & 15, k = (i >> 4) & 127, p = i >> 11;
        const float* src = keys + ((size_t)(p * 8 + h) * 128 + k) * 128 + ch * 8; const f32x4 a = *(const f32x4*)src, b = *(const f32x4*)(src + 4);
        const float x[8] = {a[0], a[1], a[2], a[3], b[0], b[1], b[2], b[3]}; unsigned hw[4], lw[4];
#pragma unroll
        for (int e = 0; e < 4; ++e) { const unsigned h0 = f2bf(x[2 * e]), h1 = f2bf(x[2 * e + 1]); hw[e] = h0 | (h1 << 16);
            lw[e] = pk2(x[2 * e] - __builtin_bit_cast(float, h0 << 16), x[2 * e + 1] - __builtin_bit_cast(float, h1 << 16)); }
        LAS unsigned char* d = KH + (size_t)p * 65536 + (size_t)k * 256 + ((ch ^ (k & 15)) << 4);
        *(LAS v4u*)d = (v4u){hw[0], hw[1], hw[2], hw[3]}; *(LAS v4u*)(d + 32768) = (v4u){lw[0], lw[1], lw[2], lw[3]}; }
}
__device__ __forceinline__ void p11_item(const Args& A, Frame& F, int item, bool keys_built) {
    const int tb = item & 31, h = item >> 5;
    typedef short s16x8 __attribute__((ext_vector_type(8)));
    LAS unsigned char* KH = F.lds;
    if (!keys_built) { p11_keys(A, F, h); __syncthreads(); }
    const int lane = F.lane, r32 = lane & 31, hi = lane >> 5;
    const int n = tb * 256 + F.wave * 32 + r32;
    const float* qrow = (const float*)(F.ws + WS_QP) + (size_t)n * DM + h * 256;
    f32x16 acc[2][4];
#pragma unroll
    for (int p = 0; p < 2; ++p) {
#pragma unroll
        for (int kt = 0; kt < 4; ++kt) acc[p][kt] = f32x16{};
        const LAS unsigned char* kb = KH + (size_t)p * 65536 + (size_t)r32 * 256;
        const float* qp = qrow + p * 128 + 8 * hi;
        f32x4 qa = *(const f32x4*)qp, qb = *(const f32x4*)(qp + 4);
#pragma unroll 1
        for (int s = 0; s < 8; ++s) {
            const f32x4 ca = qa, cb = qb; { const int sn = (s + 1) & 7; qa = *(const f32x4*)(qp + 16 * sn); qb = *(const f32x4*)(qp + 16 * sn + 4); }
            const float x[8] = {ca[0], ca[1], ca[2], ca[3], cb[0], cb[1], cb[2], cb[3]}; unsigned hw[4], lw[4];
#pragma unroll
            for (int e = 0; e < 4; ++e) { const unsigned h0 = f2bf(x[2 * e]), h1 = f2bf(x[2 * e + 1]); hw[e] = h0 | (h1 << 16);
                lw[e] = pk2(x[2 * e] - __builtin_bit_cast(float, h0 << 16), x[2 * e + 1] - __builtin_bit_cast(float, h1 << 16)); }
            const v4u bhv = {hw[0], hw[1], hw[2], hw[3]}, blv = {lw[0], lw[1], lw[2], lw[3]};
            const s16x8 bh = __builtin_bit_cast(s16x8, bhv), bl = __builtin_bit_cast(s16x8, blv);
            const int co = (((2 * s + hi) ^ (r32 & 15)) << 4);
#pragma unroll
            for (int kt = 0; kt < 4; ++kt) { const s16x8 ah = *(const LAS s16x8*)(kb + kt * 8192 + co), al = *(const LAS s16x8*)(kb + kt * 8192 + co + 32768);
                acc[p][kt] = __builtin_amdgcn_mfma_f32_32x32x16_bf16(al, bh, acc[p][kt], 0, 0, 0);
                acc[p][kt] = __builtin_amdgcn_mfma_f32_32x32x16_bf16(ah, bl, acc[p][kt], 0, 0, 0);
                acc[p][kt] = __builtin_amdgcn_mfma_f32_32x32x16_bf16(ah, bh, acc[p][kt], 0, 0, 0); }
        }
    }
    __syncthreads();
    float lv[2][16];
#pragma unroll
    for (int p = 0; p < 2; ++p) {
        float v[16];
#pragma unroll
        for (int r = 0; r < 16; ++r) v[r] = tk_tag(acc[p][0][r], 127u, (unsigned)((r & 3) + 8 * (r >> 2) + 4 * hi));
        tk_sort16(v);
#pragma unroll
        for (int kt = 1; kt < 4; ++kt) { float w[16];
#pragma unroll
            for (int r = 0; r < 16; ++r) w[r] = tk_tag(acc[p][kt][r], 127u, (unsigned)(32 * kt + (r & 3) + 8 * (r >> 2) + 4 * hi));
            tk_sort16(w); tk_merge16(v, w); }
        { float ov[16];
#pragma unroll
          for (int t = 0; t < 16; ++t) ov[t] = __shfl_xor(v[t], 32);
          tk_merge16(v, ov); }
#pragma unroll
        for (int t = 0; t < 16; ++t) lv[p][t] = v[t];
    }
    LAS int* cidl = (LAS int*)F.lds + (F.wave * 32 + r32) * 65;
    float blk[4][16]; { int c = 0;
#pragma unroll
        for (int i = 0; i < 16; ++i)
#pragma unroll
            for (int j = 0; j < 16; ++j) if ((i + 1) * (j + 1) <= 16) {
                blk[c >> 4][c & 15] = tk_tag(lv[0][i] + lv[1][j], 63u, (unsigned)c);
                if (hi == 0) cidl[c] = (int)((__float_as_uint(lv[0][i]) & 127u) * 128u + (__float_as_uint(lv[1][j]) & 127u));
                ++c; }
#pragma unroll
        for (; c < 64; ++c) blk[c >> 4][c & 15] = tk_tag(-3.0e38f, 63u, (unsigned)c); }
    tk_sort16(blk[0]); tk_sort16(blk[1]); tk_sort16(blk[2]); tk_sort16(blk[3]);
    tk_merge16(blk[0], blk[1]); tk_merge16(blk[2], blk[3]); tk_merge16(blk[0], blk[2]);
    float e[16], sum = 0.f;
#pragma unroll
    for (int t = 0; t < 16; ++t) { e[t] = __expf(blk[0][t] - blk[0][0]); sum += e[t]; }
    const float rs = 1.f / sum;
    if (hi == 0) { int* io = (int*)(F.ws + WS_IDX) + (size_t)n * 128 + h * 16; float* go = (float*)(F.ws + WS_GW) + (size_t)n * 128 + h * 16;
        int id[16];
#pragma unroll
        for (int t = 0; t < 16; ++t) id[t] = cidl[__float_as_uint(blk[0][t]) & 63u];
#pragma unroll
        for (int t = 0; t < 16; t += 4) { *(v4u*)(io + t) = (v4u){(unsigned)id[t], (unsigned)id[t + 1], (unsigned)id[t + 2], (unsigned)id[t + 3]};
            *(f32x4*)(go + t) = (f32x4){e[t] * rs, e[t + 1] * rs, e[t + 2] * rs, e[t + 3] * rs}; } }
    __syncthreads();
}
#undef TK_CS

__device__ __forceinline__ float gelu_erf(float x) { return 0.5f * x * (1.f + erff(x * 0.7071067811865476f)); }
__device__ __forceinline__ void fmac1(float& acc, float a, float b) { asm("v_fmac_f32 %0, %1, %2" : "+v"(acc) : "v"(a), "v"(b)); }
typedef _Float16 h2 __attribute__((ext_vector_type(2)));
__device__ __forceinline__ void p12_coldots(const Args& A, Frame& F) {
    typedef float f32x2 __attribute__((ext_vector_type(2)));
    const bf16* hb = (const bf16*)(F.ws + WS_HB); const unsigned char* ub = F.ws + WS_UB; const int* idx = (const int*)(F.ws + WS_IDX);
    const int lane = F.lane, wpg = F.NGW >> 3, x = F.gw / wpg, wl = F.gw - x * wpg, rs = lane >> 4, cc = lane & 15;
    unsigned* pdx = (unsigned*)(F.ws + WS_PD) + (size_t)x * SEQ * 64;
    const size_t coff = 256 * x + 16 * cc;
    const unsigned char* usl = ub + (size_t)x * ((size_t)NEXP * 256) + 16 * cc;
#pragma unroll 1
    for (int n = wl; n < SEQ; n += wpg) {
        int hq[4]; float hinv;
        { const v4u a = *(const v4u*)(hb + (size_t)n * DM + coff), b = *(const v4u*)(hb + (size_t)n * DM + coff + 8);
          float hv[16] = { blo(a.x), bhi(a.x), blo(a.y), bhi(a.y), blo(a.z), bhi(a.z), blo(a.w), bhi(a.w), blo(b.x), bhi(b.x), blo(b.y), bhi(b.y), blo(b.z), bhi(b.z), blo(b.w), bhi(b.w) };
          float m = 0.f;
#pragma unroll
          for (int i = 0; i < 16; ++i) m = fmaxf(m, fabsf(hv[i]));
          m = fmaxf(m, __shfl_xor(m, 1)); m = fmaxf(m, __shfl_xor(m, 2)); m = fmaxf(m, __shfl_xor(m, 4)); m = fmaxf(m, __shfl_xor(m, 8));
          const float sc = (m > 0.f) ? 127.f / m : 1.f; hinv = 1.f / sc;
#pragma unroll
          for (int i = 0; i < 4; ++i) { const int q0 = (int)__builtin_rintf(hv[4 * i] * sc), q1 = (int)__builtin_rintf(hv[4 * i + 1] * sc), q2 = (int)__builtin_rintf(hv[4 * i + 2] * sc), q3 = (int)__builtin_rintf(hv[4 * i + 3] * sc);
              hq[i] = (int)((unsigned)(q0 & 255) | ((unsigned)(q1 & 255) << 8) | ((unsigned)(q2 & 255) << 16) | ((unsigned)q3 << 24)); } }
        const int id0 = idx[(size_t)n * 128 + lane], id1 = idx[(size_t)n * 128 + 64 + lane];
        float acc[32];
#pragma unroll
        for (int b = 0; b < 2; ++b) {
            v4u w[16];
#pragma unroll
            for (int i = 0; i < 16; ++i) { const int e = __shfl(b ? id1 : id0, 4 * i + rs); w[i] = *(const v4u*)(usl + (size_t)e * 256); }
#pragma unroll
            for (int i = 0; i < 16; ++i) { int d = __builtin_amdgcn_sdot4((int)w[i][0], hq[0], 0, false); d = __builtin_amdgcn_sdot4((int)w[i][1], hq[1], d, false);
                d = __builtin_amdgcn_sdot4((int)w[i][2], hq[2], d, false); d = __builtin_amdgcn_sdot4((int)w[i][3], hq[3], d, false);
                acc[16 * b + i] = (float)d; }
            __builtin_amdgcn_sched_barrier(0);
        }
        float r16[16], r8[8], r4[4], r2[2];
        { const bool t = cc & 8;
#pragma unroll
          for (int k = 0; k < 16; ++k) r16[k] = (t ? acc[k + 16] : acc[k]) + __shfl_xor(t ? acc[k] : acc[k + 16], 8); }
        { const bool t = cc & 4;
#pragma unroll
          for (int k = 0; k < 8; ++k) r8[k] = (t ? r16[k + 8] : r16[k]) + __shfl_xor(t ? r16[k] : r16[k + 8], 4); }
        { const bool t = cc & 2;
#pragma unroll
          for (int k = 0; k < 4; ++k) r4[k] = (t ? r8[k + 4] : r8[k]) + __shfl_xor(t ? r8[k] : r8[k + 4], 2); }
        { const bool t = cc & 1;
#pragma unroll
          for (int k = 0; k < 2; ++k) r2[k] = (t ? r4[k + 2] : r4[k]) + __shfl_xor(t ? r4[k] : r4[k + 2], 1); }
        const int I0 = 2 * (cc & 1) + 4 * ((cc >> 1) & 1) + 8 * ((cc >> 2) & 1) + 16 * (cc >> 3);
        (void)I0;
        pdx[(size_t)n * 64 + lane] = pk2(r2[0] * hinv, r2[1] * hinv);
    }
}
struct P13Pre { float g0[4], g1[4], u0[4], u1[4], v0[4], v1[4]; };
__device__ __forceinline__ void p12b_pre(const Args& A, Frame& F, int nb, P13Pre& P) {
    const int* idx = (const int*)(F.ws + WS_IDX); const float* gwp = (const float*)(F.ws + WS_GW);
    const float* usc = (const float*)(F.ws + WS_USC); const float* vsc = (const float*)(F.ws + WS_VSC);
    const int lane = F.lane, s0 = 8 * (lane & 15) + (lane >> 4), s1 = s0 + 4;
    int id0[4], id1[4];
#pragma unroll
    for (int k = 0; k < 4; ++k) { const int n = min(nb + k * F.NGW, SEQ - 1);
        id0[k] = idx[(size_t)n * 128 + s0]; id1[k] = idx[(size_t)n * 128 + s1]; P.g0[k] = gwp[(size_t)n * 128 + s0]; P.g1[k] = gwp[(size_t)n * 128 + s1]; }
#pragma unroll
    for (int k = 0; k < 4; ++k) { P.u0[k] = usc[id0[k]]; P.u1[k] = usc[id1[k]]; P.v0[k] = vsc[id0[k]]; P.v1[k] = vsc[id1[k]]; }
}
__device__ __forceinline__ void p12b_weights(const Args& A, Frame& F, P13Pre& P) {
    const unsigned* pd = (const unsigned*)(F.ws + WS_PD); float* wgt = (float*)(F.ws + WS_WGT);
    const int lane = F.lane;
    unsigned char* wq = (unsigned char*)wgt; float* wsc = (float*)(F.ws + WS_WGT + 2 * MiB);
#pragma unroll 1
    for (int nb = F.gw; nb < SEQ; nb += 4 * F.NGW) {
        if (nb != F.gw) p12b_pre(A, F, nb, P);
        unsigned pw[4][8];
#pragma unroll
        for (int k = 0; k < 4; ++k) { const int n = min(nb + k * F.NGW, SEQ - 1);
#pragma unroll
            for (int g = 0; g < 8; ++g) pw[k][g] = pd[((size_t)g * SEQ + n) * 64 + lane]; }
#pragma unroll
        for (int k = 0; k < 4; ++k) { const int n = nb + k * F.NGW;
            float d0 = 0.f, d1 = 0.f;
#pragma unroll
            for (int g = 0; g < 8; ++g) { d0 += blo(pw[k][g]); d1 += bhi(pw[k][g]); }
            const float w0 = P.g0[k] * gelu_erf(d0 * P.u0[k]) * P.v0[k], w1 = P.g1[k] * gelu_erf(d1 * P.u1[k]) * P.v1[k];
            const float m = wave_max(fmaxf(fabsf(w0), fabsf(w1))); const float sc = (m > 0.f) ? 127.f / m : 0.f;
            if (n < SEQ) {
                ((unsigned short*)wq)[(size_t)n * 64 + lane] = (unsigned short)(((int)__builtin_rintf(w0 * sc) & 255) | (((int)__builtin_rintf(w1 * sc) & 255) << 8));
                if (lane == 0) wsc[n] = m * (1.f / 127.f); } }
    }
}
__device__ __forceinline__ void p13_colsum(const Args& A, Frame& F) {
    typedef float f32x2 __attribute__((ext_vector_type(2)));
    const unsigned char* vb = F.ws + WS_VB; const int* idx = (const int*)(F.ws + WS_IDX); const float* gwp = (const float*)(F.ws + WS_GW);
    const float* wgt = (const float*)(F.ws + WS_WGT);
    bf16* opre = (bf16*)(F.ws + WS_OPRE); float* ssp = (float*)(F.ws + WS_SSP);
    const int lane = F.lane, wpg = F.NGW >> 3, x = F.gw / wpg, wl = F.gw - x * wpg, rs = lane >> 4, cc = lane & 15;
    const size_t coff = 256 * x + 16 * cc;
    const unsigned char* vsl = vb + (size_t)x * ((size_t)NEXP * 256) + 16 * cc;
    const unsigned char* wq = (const unsigned char*)wgt; const float* wsc = (const float*)(F.ws + WS_WGT + 2 * MiB);
#pragma unroll 1
    for (int n = wl; n < SEQ; n += wpg) {
        const int id0 = idx[(size_t)n * 128 + lane], id1 = idx[(size_t)n * 128 + 64 + lane];
        const v4u wda = *(const v4u*)(wq + (size_t)n * 128 + rs * 32), wdb = *(const v4u*)(wq + (size_t)n * 128 + rs * 32 + 16);
        const unsigned wd[8] = {wda.x, wda.y, wda.z, wda.w, wdb.x, wdb.y, wdb.z, wdb.w};
        const float wscn = wsc[n];
        int oi[16];
#pragma unroll
        for (int k = 0; k < 16; ++k) oi[k] = 0;
#pragma unroll
        for (int b = 0; b < 2; ++b) {
            v4u w[16];
#pragma unroll
            for (int i = 0; i < 16; ++i) { const int e = __shfl(b ? id1 : id0, 4 * i + rs); w[i] = *(const v4u*)(vsl + (size_t)e * 256); }
#pragma unroll
            for (int g4 = 0; g4 < 4; ++g4) { const int wdw = (int)wd[4 * b + g4];
#pragma unroll
                for (int e = 0; e < 4; ++e) { const unsigned r0 = w[4 * g4][e], r1 = w[4 * g4 + 1][e], r2 = w[4 * g4 + 2][e], r3 = w[4 * g4 + 3][e];
                    const unsigned p01l = __builtin_amdgcn_perm(r1, r0, 0x05010400u), p01h = __builtin_amdgcn_perm(r1, r0, 0x07030602u);
                    const unsigned p23l = __builtin_amdgcn_perm(r3, r2, 0x05010400u), p23h = __builtin_amdgcn_perm(r3, r2, 0x07030602u);
                    const unsigned c0 = __builtin_amdgcn_perm(p23l, p01l, 0x05040100u), c1 = __builtin_amdgcn_perm(p23l, p01l, 0x07060302u);
                    const unsigned c2 = __builtin_amdgcn_perm(p23h, p01h, 0x05040100u), c3 = __builtin_amdgcn_perm(p23h, p01h, 0x07060302u);
                    oi[4 * e] = __builtin_amdgcn_sdot4((int)c0, wdw, oi[4 * e], false); oi[4 * e + 1] = __builtin_amdgcn_sdot4((int)c1, wdw, oi[4 * e + 1], false);
                    oi[4 * e + 2] = __builtin_amdgcn_sdot4((int)c2, wdw, oi[4 * e + 2], false); oi[4 * e + 3] = __builtin_amdgcn_sdot4((int)c3, wdw, oi[4 * e + 3], false); } }
            __builtin_amdgcn_sched_barrier(0);
        }
        float o[16];
#pragma unroll
        for (int k = 0; k < 16; ++k) o[k] = (float)oi[k] * wscn;
        float t8[8]; f32x4 t4;
        { const bool t = lane & 32;
#pragma unroll
          for (int k = 0; k < 8; ++k) t8[k] = (t ? o[k + 8] : o[k]) + __shfl_xor(t ? o[k] : o[k + 8], 32); }
        { const bool t = lane & 16;
#pragma unroll
          for (int k = 0; k < 4; ++k) t4[k] = (t ? t8[k + 4] : t8[k]) + __shfl_xor(t ? t8[k] : t8[k + 4], 16); }
        *(unsigned long long*)(opre + (size_t)n * DM + coff + 8 * (lane >> 5) + 4 * ((lane >> 4) & 1)) = (unsigned long long)pk2(t4[0], t4[1]) | ((unsigned long long)pk2(t4[2], t4[3]) << 32);
        const float ss = wave_sum((t4[0] * t4[0] + t4[1] * t4[1]) + (t4[2] * t4[2] + t4[3] * t4[3]));
        if (lane == 0) ssp[(size_t)x * SEQ + n] = ss;
    }
}
__device__ __forceinline__ void p14_cv(const Args& A, Frame& F) {
    LAS f32x4* cv = (LAS f32x4*)F.lds; const int col = 4 * F.tid; cv[F.tid] = mod4(A, F, 0, 5 * DM + col) * *(const f32x4*)(A.in[9] + col);
    cv[512 + F.tid] = mod4(A, F, 0, 2 * DM + col) * *(const f32x4*)(A.in[7] + col);
}
__device__ __forceinline__ void p14_final(const Args& A, Frame& F) {
    const bf16* opre = (const bf16*)(F.ws + WS_OPRE); const float* ssp = (const float*)(F.ws + WS_SSP);
    LAS f32x4* cv = (LAS f32x4*)F.lds;
    int n = F.gw;
    const bf16* mix = (const bf16*)(F.ws + WS_MIX);
    f32x4 gnp[8], ga[8];
#pragma unroll
    for (int j = 0; j < 8; ++j) { gnp[j] = cv[F.lane + 64 * j]; ga[j] = cv[512 + F.lane + 64 * j]; }
    for (; n < SEQ; n += F.NGW) {
        const float ss = wave_sum(F.lane < 8 ? ssp[(size_t)F.lane * SEQ + n] : 0.f);
        const float rstd = rsqrtf(ss * (1.f / DM) + EPS);
        const unsigned long long* pr = (const unsigned long long*)(opre + (size_t)n * DM) + F.lane; f32x4* orow = (f32x4*)(F.out + (size_t)n * DM) + F.lane;
        const unsigned long long* mr = (const unsigned long long*)(mix + (size_t)n * DM) + F.lane; const f32x4* xr = (const f32x4*)(A.in[0] + (size_t)n * DM) + F.lane;
        f32x4 p[8], xo[8], mv[8]; float sm = 0.f;
#pragma unroll
        for (int j = 0; j < 8; ++j) { const unsigned long long p8 = pr[64 * j]; const unsigned p0 = (unsigned)p8, p1 = (unsigned)(p8 >> 32);
            p[j][0] = blo(p0); p[j][1] = bhi(p0); p[j][2] = blo(p1); p[j][3] = bhi(p1); xo[j] = xr[64 * j];
            const unsigned long long m8 = mr[64 * j]; const unsigned m0 = (unsigned)m8, m1 = (unsigned)(m8 >> 32);
            mv[j][0] = blo(m0); mv[j][1] = bhi(m0); mv[j][2] = blo(m1); mv[j][3] = bhi(m1); }
#pragma unroll
        for (int j = 0; j < 8; ++j) sm += (mv[j][0] * mv[j][0] + mv[j][1] * mv[j][1]) + (mv[j][2] * mv[j][2] + mv[j][3] * mv[j][3]);
        const float rstdm = rsqrtf(wave_sum(sm) * (1.f / DM) + EPS);
#pragma unroll
        for (int j = 0; j < 8; ++j) orow[64 * j] = (xo[j] + mv[j] * rstdm * ga[j]) + gnp[j] * p[j] * rstd;
    }
}
constexpr int NPH = 16;
constexpr int CW_BAR = 4096;
constexpr int MAX_LAUNCHES = 3;
static_assert((CW_BAR + MAX_LAUNCHES * XCD_BAR_WORDS) * 4 <= (int)CTL_ZERO_BYTES, "barrier words inside the memset region");
__device__ __forceinline__ bool refresh_ids(Frame& F) { int t = threadIdx.x; asm volatile("" : "+v"(t)); F.tid = t; F.lane = t & 63; return true; }
__global__ void __launch_bounds__(NTHR, 2) hybrid_fwd(Args args) {
    extern __shared__ __attribute__((aligned(16))) unsigned char lds[];
    Frame F;
    F.lds = (LAS unsigned char*)lds; F.ldsg = (char*)lds;
    F.tid = threadIdx.x; F.lane = F.tid & 63; F.wave = __builtin_amdgcn_readfirstlane(F.tid >> 6);
    F.G = gridDim.x; { const int bx = blockIdx.x; F.vcu = (F.G % 8 == 0) ? (bx % 8) * (F.G / 8) + bx / 8 : bx; }
    F.gw = F.vcu * NWAVES + F.wave; F.NGW = F.G * NWAVES;
    F.out = args.out; F.ws = args.ws;
    volatile LAS unsigned* MISC = (volatile LAS unsigned*)(F.lds + MISC_OFF);
    for (int u = F.tid; u < 64; u += NTHR) MISC[u] = 0u;
    __syncthreads();
    unsigned* ctl = (unsigned*)(F.ws + WS_CTL);
    XcdBarrier bar = xcd_barrier_post(ctl + CW_BAR + args.li * XCD_BAR_WORDS, MISC + 8);
    const int lo = args.ph_lo, hi = args.ph_hi;
#define IN(k) (lo <= (k) && (k) < hi && refresh_ids(F))
#define SEAM(k) do { __builtin_amdgcn_sched_barrier(0); if (IN(k) && IN((k) + 1)) xcd_barrier(bar); __builtin_amdgcn_sched_barrier(0); } while (0)
#define SEAM_SHADOW(k, PROLOGUE) do { const bool seam_ = IN(k) && IN((k) + 1); XcdTok tk_{0u, 0u}; if (seam_) tk_ = xcd_arrive(bar); if (IN((k) + 1)) { PROLOGUE; } if (seam_) xcd_wait(bar, tk_); else __syncthreads(); } while (0)

    if (IN(0)) { p0_prologue(args, F); const XcdTok tk0 = xcd_arrive(bar); (void)refresh_ids(F); p0_prologue_b(args, F); xcd_wait(bar, tk0); }
    if (IN(1)) { p1_cv(args, F); __syncthreads(); p1_rows(args, F); } SEAM(1);
    if (IN(2)) {
        p2_ctx_unit(F);
        pg8::Gemm g{(const bf16*)(F.ws + WS_U), (const bf16*)(F.ws + WS_WIN), SEQ, INCOLS, DM}; pg8::StaticOrder S; S.init(SEQ, INCOLS, F.G, (int)blockIdx.x);
        pg8::EpiSplit1 E{(bf16*)(F.ws + WS_PHY), (long)(WS_QRAW - WS_PHY) / 2, (long)(WS_KRAW - WS_PHY) / 2, (long)(WS_V2 - WS_PHY) / 2, (long)(WS_GATES - WS_PHY) / 2};
        pg8::gemm_phase<pg8::EpiSplit1, pg8::StaticOrder, true, true>(F.lds, g, S, E);
    } SEAM(2);
    if (IN(3)) { p3_post(args, F, F.gw, F.NGW); } SEAM(3);
    if (IN(4)) {
        const int x = F.vcu >> 5, qb = F.vcu & 31;
        if (F.G == 256) {
#pragma unroll 1
            for (int i = 0; i < 2; ++i) { const int hm = 2 * x + i;
                att::attn_unit((const bf16*)(F.ws + WS_Q2) + (size_t)(qb * 256) * 1024 + hm * 64, (const bf16*)(F.ws + WS_K2) + hm * 64,
                               (const bf16*)(F.ws + WS_V2) + (hm >> 1) * 128, (float*)(F.ws + WS_O) + (size_t)(qb * 256) * 2048 + hm * 128, NKEYS, F.ldsg); }
#ifdef ATT_VAR
            { const int hm = 2 * x;
                att::attn_unit<ATT_VAR>((const bf16*)(F.ws + WS_Q2) + (size_t)(qb * 256) * 1024 + hm * 64, (const bf16*)(F.ws + WS_K2) + hm * 64,
                               (const bf16*)(F.ws + WS_V2) + (hm >> 1) * 128, (float*)(F.ws + WS_KSPEC), NKEYS, F.ldsg); }
#endif
        }
    }
    if (IN(5)) {
#pragma unroll 1
        for (int pr = F.vcu; pr < HYW / 2; pr += F.G)
            fftc::conv_pair(F.lds, F.tid, pr, (const bf16*)(F.ws + WS_TAPF), (const bf16*)(F.ws + WS_TAPB), (const bf16*)(F.ws + WS_UHT), (bf16*)(F.ws + WS_YCT));
    } SEAM(5);
    if (IN(6)) { p5_finalize(args, F); } SEAM(6);
    if (IN(7)) {
        pg8::StaticOrder S; S.init(SEQ, DM, F.G, (int)blockIdx.x);
        { pg8::Gemm g{(const bf16*)(F.ws + WS_YHY), (const bf16*)(F.ws + WS_WHY), SEQ, DM, HYW};
          pg8::EpiGate<0> E{(bf16*)(F.ws + WS_MB), DM, (const bf16*)(F.ws + WS_GATES), 4096};
          pg8::gemm_phase<pg8::EpiGate<0>, pg8::StaticOrder, true, true>(F.lds, g, S, E); }
        { pg8::Gemm g{(const bf16*)(F.ws + WS_YDA), (const bf16*)(F.ws + WS_WDA), SEQ, DM, HYW};
          pg8::EpiGate<1> E{(bf16*)(F.ws + WS_MB), DM, (const bf16*)(F.ws + WS_GATES) + 2048, 4096};
          pg8::gemm_phase<pg8::EpiGate<1>, pg8::StaticOrder, true, true>(F.lds, g, S, E); }
    } SEAM(7);
    if (IN(8)) {
        pg8::Gemm g{(const bf16*)(F.ws + WS_MB), (const bf16*)(F.ws + WS_WO), SEQ, DM, DM}; pg8::StaticOrder S; S.init(SEQ, DM, F.G, (int)blockIdx.x);
        pg8::EpiBf16 E{(bf16*)(F.ws + WS_MIX), DM};
        pg8::gemm_phase<pg8::EpiBf16, pg8::StaticOrder, true, true>(F.lds, g, S, E);
    } SEAM_SHADOW(8, p8_cv(args, F));
    if (IN(9)) { p8_rows(args, F); } SEAM(9);
    if (IN(10)) {
        pg8::Gemm g{(const bf16*)(F.ws + WS_HB), (const bf16*)(F.ws + WS_WQ), SEQ, DM, DM}; pg8::StaticOrder S; S.init(SEQ, DM, F.G, (int)blockIdx.x);
        pg8::EpiF32 E{(float*)(F.ws + WS_QP), DM};
        pg8::gemm_phase<pg8::EpiF32, pg8::StaticOrder, true, true>(F.lds, g, S, E);
    } SEAM_SHADOW(10, p11_keys(args, F, F.vcu >> 5));
    if (IN(11)) {
#pragma unroll 1
        for (int it = F.vcu; it < 256; it += F.G) p11_item(args, F, it, it == F.vcu);
    } SEAM(11);
    if (IN(12)) { p12_coldots(args, F); }
    {
        __builtin_amdgcn_sched_barrier(0);
        const bool seam_ = IN(12) && IN(13); XcdTok tk_{0u, 0u}; if (seam_) tk_ = xcd_arrive(bar);
        P13Pre pre; if (IN(13)) p12b_pre(args, F, F.gw, pre);
        if (seam_) xcd_wait(bar, tk_); else __syncthreads();
        __builtin_amdgcn_sched_barrier(0);
        if (IN(13)) { p12b_weights(args, F, pre); } }
    SEAM(13);
    if (IN(14)) { p13_colsum(args, F); } SEAM_SHADOW(14, p14_cv(args, F));
    if (IN(15)) { p14_final(args, F); }
#undef IN
#undef SEAM
}

#ifndef PROBE_PH
#define PROBE_PH -1
#endif
extern "C" void kernel_launch(void* const* d_in, const int* in_sizes, int n_in, void* d_out, int out_size, void* d_ws, size_t ws_size, hipStream_t stream) {
    static int grid = 0;
    if (grid == 0) {
        if (n_in != 31 || in_sizes[0] != SEQ * DM || out_size != SEQ * DM || ws_size < WS_END) {
            fprintf(stderr, "kernel_launch: built for 31 inputs, x/out of %d floats, >= %zu bytes of workspace; got n_in %d, in0 %d, out %d, ws %zu; nothing launched\n",
                    SEQ * DM, (size_t)WS_END, n_in, n_in > 0 ? in_sizes[0] : -1, out_size, ws_size); grid = -1; return; }
        int dev = 0, cus = 0, per_cu = 0;
        if (hipGetDevice(&dev) != hipSuccess || hipDeviceGetAttribute(&cus, hipDeviceAttributeMultiprocessorCount, dev) != hipSuccess) { fprintf(stderr, "kernel_launch: device query failed\n"); grid = -1; return; }
        if (hipFuncSetAttribute((const void*)hybrid_fwd, hipFuncAttributeMaxDynamicSharedMemorySize, LDS_BYTES) != hipSuccess) { fprintf(stderr, "kernel_launch: hipFuncSetAttribute failed\n"); grid = -1; return; }
        if (hipOccupancyMaxActiveBlocksPerMultiprocessor(&per_cu, (const void*)hybrid_fwd, NTHR, LDS_BYTES) != hipSuccess || per_cu < 1) {
            fprintf(stderr, "kernel_launch: occupancy query reports %d workgroups per CU; nothing launched\n", per_cu); (void)hipGetLastError(); grid = -1; return; }
        grid = cus;
        if (grid != 256) fprintf(stderr, "kernel_launch: note: %d CUs (tuned for 256)\n", grid);
    }
    if (grid < 0) return;
    if (hipMemsetAsync((char*)d_ws + WS_CTL, 0, CTL_ZERO_BYTES, stream) != hipSuccess) { fprintf(stderr, "kernel_launch: hipMemsetAsync failed\n"); return; }
    Args a{};
    for (int i = 0; i < 31; ++i) a.in[i] = (const float*)d_in[i];
    a.out = (float*)d_out; a.ws = (unsigned char*)d_ws;
    constexpr int NL = (PROBE_PH >= 0) ? 3 : 1;
    const int cut[4] = {0, (PROBE_PH >= 0) ? PROBE_PH + 1 : NPH, (PROBE_PH >= 0) ? PROBE_PH + 1 : NPH, NPH};
    for (int li = 0; li < NL; ++li) {
        a.ph_lo = (li == 1) ? PROBE_PH : cut[li]; a.ph_hi = cut[li + 1]; a.li = li;
        if (a.ph_lo >= a.ph_hi) continue;
        hipLaunchKernelGGL(hybrid_fwd, dim3(grid), dim3(NTHR), LDS_BYTES, stream, a);
        const hipError_t le = hipPeekAtLastError();
        if (le != hipSuccess) { fprintf(stderr, "kernel_launch: launch %d failed: %s\n", li, hipGetErrorName(le)); break; }
    }
}
```
